# Optimizing an MI355X kernel written in HIP

```python
import math
import jax, jax.numpy as jnp
from jax import lax
import numpy as np

D_MODEL = 1024
BATCH = 16
SEQ = 256
DEPTH = 2
DEC_BATCH = 8
DEC_SEQ = 1024
PAST_LEN = 256

GRID_W = 64
MIX_WIDTH = D_MODEL
ATTN_HEADS = 4
ATTN_DH = 64
ATTN_WIDTH = ATTN_HEADS * 2 * ATTN_DH
CONV_CH = MIX_WIDTH // 4
CHUNK = 128
CHUNK_GROUPS = 4
CHUNK_CH = MIX_WIDTH // 4
CHUNK_GDIM = CHUNK_CH // CHUNK_GROUPS
D_FF = 2816
N_MOD = 9
Q_BLOCK = 128
ROPE_BASE = 10000.0
ROPE_FREQS = ATTN_DH // 4
QKV_W = ATTN_HEADS * 2 * ATTN_DH
IN_SPLITS = (QKV_W, 2 * QKV_W, 3 * QKV_W,
             3 * QKV_W + CONV_CH, 3 * QKV_W + 2 * CONV_CH, 3 * QKV_W + 3 * CONV_CH,
             3 * QKV_W + 3 * CONV_CH + CHUNK_CH)
IN_WIDTH = 3 * QKV_W + 3 * CONV_CH + 2 * CHUNK_CH

kernel_name = "hybrid_diffusion_prefix_trunk_step"


def rms_norm(x, g, eps=1e-6):
    xf = x.astype(jnp.float32)
    y = xf * lax.rsqrt(jnp.mean(xf * xf, axis=-1, keepdims=True) + eps)
    return (y * g.astype(jnp.float32)).astype(x.dtype)


def swiglu(h, w_gu, w_d):
    g, u = jnp.split(h @ w_gu, 2, axis=-1)
    return (jax.nn.silu(g) * u) @ w_d


def axial_rope_tables(n_tokens):
    n_rows = n_tokens // GRID_W
    row = jnp.repeat(jnp.arange(n_rows, dtype=jnp.float32), GRID_W)
    col = jnp.tile(jnp.arange(GRID_W, dtype=jnp.float32), n_rows)
    inv = ROPE_BASE ** (-jnp.arange(ROPE_FREQS, dtype=jnp.float32) / ROPE_FREQS)
    ang = jnp.concatenate([row[:, None] * inv, col[:, None] * inv], axis=-1)
    return jnp.cos(ang), jnp.sin(ang)


def apply_rope(x, cos, sin):
    cos = cos[:, None, :].astype(x.dtype)
    sin = sin[:, None, :].astype(x.dtype)
    x1, x2 = jnp.split(x, 2, axis=-1)
    return jnp.concatenate([x1 * cos - x2 * sin, x2 * cos + x1 * sin], axis=-1)


def diff_attention(q, k, v, lam):
    B, H, Sq = q.shape[:3]
    nb = Sq // Q_BLOCK
    qb = q.reshape(B, H, nb, Q_BLOCK, 2, ATTN_DH).transpose(2, 0, 1, 3, 4, 5)
    scale = ATTN_DH ** -0.5

    def one_block(q_blk):
        s = jnp.einsum('bhqmd,bhkmd->bhmqk', q_blk, k).astype(jnp.float32) * scale
        p = jax.nn.softmax(s, axis=-1)
        a = p[:, :, 0] - lam * p[:, :, 1]
        return jnp.einsum('bhqk,bhkd->bhqd', a.astype(v.dtype), v)

    o = lax.map(one_block, qb)
    return o.transpose(1, 2, 0, 3, 4).reshape(B, H, Sq, 2 * ATTN_DH)


def token_mixers(h, p, layer_idx, rope, ctx_kv):
    B, S, _ = h.shape
    z = h @ p['w_in']
    q, k, v, gb, gc, hc, u, vc = jnp.split(z, IN_SPLITS, axis=-1)

    q = q.reshape(B, S, ATTN_HEADS, 2, ATTN_DH).transpose(0, 2, 1, 3, 4)
    k = k.reshape(B, S, ATTN_HEADS, 2, ATTN_DH).transpose(0, 2, 1, 3, 4)
    v = v.reshape(B, S, ATTN_HEADS, 2 * ATTN_DH).transpose(0, 2, 1, 3)
    if rope is None:
        keys, vals = k, v
        new_kv = (k.reshape(B, ATTN_HEADS, S, 2 * ATTN_DH), v)
    else:
        cos, sin = rope
        q = apply_rope(q, cos, sin)
        k = apply_rope(k, cos, sin)
        ck, cv = ctx_kv
        P = ck.shape[2]
        keys = jnp.concatenate([ck.reshape(B, ATTN_HEADS, P, 2, ATTN_DH).astype(k.dtype), k], axis=2)
        vals = jnp.concatenate([cv.astype(v.dtype), v], axis=2)
        new_kv = None
    lam_p = p['attn_lam'].astype(jnp.float32)
    lam_init = 0.8 - 0.6 * math.exp(-0.3 * layer_idx)
    lam = jnp.exp(jnp.sum(lam_p[0] * lam_p[1])) - jnp.exp(jnp.sum(lam_p[2] * lam_p[3])) + lam_init
    o = diff_attention(q, keys, vals, lam)
    o = rms_norm(o, p['attn_subln_g'][:, None, :]) * (1.0 - lam_init)
    y_attn = o.transpose(0, 2, 1, 3).reshape(B, S, ATTN_WIDTH)

    xc = gc * hc
    xp = jnp.pad(xc, ((0, 0), (1, 1), (0, 0)))
    w = p['conv_w']
    y_conv = gb * (w[0] * xp[:, :-2] + w[1] * xp[:, 1:-1] + w[2] * xp[:, 2:])

    nck = S // CHUNK
    vr = vc.reshape(B, nck, CHUNK, CHUNK_GROUPS, CHUNK_GDIM)
    sp = jnp.einsum('gpq,bnqgc->bnpgc', p['chunk_ws'], vr) + p['chunk_b'].T[None, None, :, :, None]
    y_chunk = u * sp.reshape(B, S, CHUNK_CH)

    y = jnp.concatenate([y_attn, y_conv, y_chunk], axis=-1) @ p['w_out']
    return y, new_kv


def trunk_layer(x, cond, p, layer_idx, rope, ctx_kv):
    m = jax.nn.silu(cond) @ p['w_mod'] + p['b_mod']
    sh1, sc1, g1, sh2, sc2, g2, sh3, sc3, g3 = jnp.split(m[:, None, :], N_MOD, axis=-1)
    h = rms_norm(x, p['norm_g'][0]) * (1.0 + sc1) + sh1
    x = x + 0.5 * g1 * swiglu(h, p['ffn1_w_gu'], p['ffn1_w_d'])
    h = rms_norm(x, p['norm_g'][1]) * (1.0 + sc2) + sh2
    y, new_kv = token_mixers(h, p, layer_idx, rope, ctx_kv)
    x = x + g2 * y
    h = rms_norm(x, p['norm_g'][2]) * (1.0 + sc3) + sh3
    x = x + 0.5 * g3 * swiglu(h, p['ffn2_w_gu'], p['ffn2_w_d'])
    return x, new_kv


def setup_inputs(seed: int = 0) -> dict:
    key = jax.random.key(seed)
    ks = jax.random.split(key, 24)
    f32 = jnp.float32

    def nrm(k, shape, scale):
        return jax.random.normal(k, shape, f32) * scale

    D, F = D_MODEL, D_FF
    return {
        "x_prompt": nrm(ks[0], (BATCH, SEQ, D), 1.0),
        "x_sample": nrm(ks[1], (DEC_BATCH, DEC_SEQ, D), 1.0),
        "cache_k": nrm(ks[2], (DEC_BATCH, DEPTH, ATTN_HEADS, PAST_LEN, 2 * ATTN_DH), 1.0),
        "cache_v": nrm(ks[3], (DEC_BATCH, DEPTH, ATTN_HEADS, PAST_LEN, 2 * ATTN_DH), 1.0),
        "c": nrm(ks[4], (DEC_BATCH, D), 1.0),
        "c_ctx": nrm(ks[5], (D,), 1.0),
        "w_mod": nrm(ks[6], (DEPTH, D, N_MOD * D), 0.5 * D ** -0.5),
        "b_mod": nrm(ks[7], (DEPTH, N_MOD * D), 0.02),
        "norm_g": 1.0 + nrm(ks[8], (DEPTH, 3, D), 0.02),
        "ffn1_w_gu": nrm(ks[9], (DEPTH, D, 2 * F), D ** -0.5),
        "ffn1_w_d": nrm(ks[10], (DEPTH, F, D), F ** -0.5),
        "ffn2_w_gu": nrm(ks[11], (DEPTH, D, 2 * F), D ** -0.5),
        "ffn2_w_d": nrm(ks[12], (DEPTH, F, D), F ** -0.5),
        "w_in": nrm(ks[13], (DEPTH, D, IN_WIDTH), D ** -0.5),
        "w_out": nrm(ks[14], (DEPTH, MIX_WIDTH, D), MIX_WIDTH ** -0.5),
        "attn_lam": nrm(ks[15], (DEPTH, 4, ATTN_DH), 0.1),
        "attn_subln_g": 1.0 + nrm(ks[16], (DEPTH, ATTN_HEADS, 2 * ATTN_DH), 0.02),
        "conv_w": nrm(ks[17], (DEPTH, 3, CONV_CH), 3 ** -0.5),
        "chunk_ws": nrm(ks[18], (DEPTH, CHUNK_GROUPS, CHUNK, CHUNK), CHUNK ** -0.5),
        "chunk_b": 1.0 + nrm(ks[19], (DEPTH, CHUNK_GROUPS, CHUNK), 0.1),
        "final_norm_g": 1.0 + nrm(ks[20], (D,), 0.02),
    }


def reference(x_prompt, x_sample, cache_k, cache_v, c, c_ctx, w_mod, b_mod, norm_g,
              ffn1_w_gu, ffn1_w_d, ffn2_w_gu, ffn2_w_d, w_in, w_out, attn_lam,
              attn_subln_g, conv_w, chunk_ws, chunk_b, final_norm_g):
    def layer_params(l):
        return dict(w_mod=w_mod[l], b_mod=b_mod[l], norm_g=norm_g[l],
                    ffn1_w_gu=ffn1_w_gu[l], ffn1_w_d=ffn1_w_d[l],
                    ffn2_w_gu=ffn2_w_gu[l], ffn2_w_d=ffn2_w_d[l],
                    w_in=w_in[l], w_out=w_out[l], attn_lam=attn_lam[l],
                    attn_subln_g=attn_subln_g[l], conv_w=conv_w[l],
                    chunk_ws=chunk_ws[l], chunk_b=chunk_b[l])

    xp = x_prompt
    ks_list, vs_list = [], []
    cond_ctx = c_ctx[None, :]
    for l in range(DEPTH):
        xp, (k_l, v_l) = trunk_layer(xp, cond_ctx, layer_params(l), l, None, None)
        ks_list.append(k_l)
        vs_list.append(v_l)
    y_prompt = rms_norm(xp, final_norm_g)
    new_k = jnp.stack(ks_list, axis=1)
    new_v = jnp.stack(vs_list, axis=1)

    xs = x_sample
    rope = axial_rope_tables(xs.shape[1])
    for l in range(DEPTH):
        xs, _ = trunk_layer(xs, c, layer_params(l), l, rope, (cache_k[:, l], cache_v[:, l]))
    y_sample = rms_norm(xs, final_norm_g)

    return (y_prompt, y_sample, new_k, new_v)
```

```cpp
#include <hip/hip_runtime.h>
#include <hip/hip_cooperative_groups.h>
#include <cstdio>
#include <cstdint>
namespace cg = cooperative_groups;
namespace pg8 {
#define PG8_LAS __attribute__((address_space(3)))
typedef unsigned short bf16_t;
typedef short bf16x8 __attribute__((ext_vector_type(8)));
typedef float f32x4 __attribute__((ext_vector_type(4)));
typedef unsigned u32x4 __attribute__((ext_vector_type(4)));
constexpr int BM = 256, BK = 64, HALF = 128, HTB = HALF * BK * 2  , STAGE_BYTES = 8 * HTB, NXCD = 8, WGM = 8;

__host__ __device__ __forceinline__ int lds_byte(int r, int c) { const int st = (r >> 4) * 2 + (c >> 5), rr = r & 15, cc = c & 31, ob = rr * 64 + cc * 2; return st * 1024 + (ob ^ (((ob >> 9) & 1) << 5)); }
__host__ __device__ __forceinline__ void stage_rc(int b, int& R, int& C) { const int st = b / 1024, sb = b % 1024, swz = sb ^ (((sb >> 9) & 1) << 5); R = (st >> 1) * 16 + swz / 64; C = (st & 1) * 32 + (swz % 64) / 2; }
__host__ __device__ __forceinline__ int perm32(int rho) { const int n = rho >> 4, i = rho & 15; return 8 * (i >> 2) + 4 * n + (i & 3); }

struct Unit { int pm, pn; };
struct Gemm { const bf16_t* A; const bf16_t* Bt; int M, N, K; };

struct StaticOrder {
    int nM, nN, nwg, G, c;
    __host__ __device__ void init(int M, int N, int G_, int c_) { nM = M / BM; nN = N / BM; nwg = nM * nN; G = G_; c = c_; }
    __host__ __device__ void initmn(int nM_, int nN_, int G_, int c_) { nM = nM_; nN = nN_; nwg = nM * nN; G = G_; c = c_; }
    __host__ __device__ bool next(int i, Unit& u) const {
        const long L = (long)i * G + c; if (L >= nwg) return false;
        int wgid = (int)L; { const int q = nwg / NXCD, r = nwg % NXCD, xcd = wgid % NXCD, off = wgid / NXCD; wgid = (xcd < r ? xcd * (q + 1) : r * (q + 1) + (xcd - r) * q) + off; }
        const int nig = WGM * nN, gid = wgid / nig, fm = gid * WGM, gsz = (nM - fm) < WGM ? (nM - fm) : WGM;
        u.pm = fm + ((wgid % nig) % gsz); u.pn = (wgid % nig) / gsz; return true;
    }
    __device__ __forceinline__ void a_ready(const Unit&) const {}
    __device__ __forceinline__ void done(const Unit&) const {}
};

__device__ __forceinline__ unsigned cvt_pk_bf16(float lo, float hi) { unsigned r; asm volatile("v_cvt_pk_bf16_f32 %0, %1, %2" : "=v"(r) : "v"(lo), "v"(hi)); return r; }
typedef float f32x2 __attribute__((ext_vector_type(2)));
template <class Epi, class Sched, bool ALIGN_EPI = false, bool SP2 = false, int MB = 4>
__device__ __forceinline__ void gemm_phase(PG8_LAS unsigned char* lds, const Gemm g, const Sched& S, const Epi& E, int tid) {
    asm volatile("" : "+v"(tid));
    const int wid = __builtin_amdgcn_readfirstlane(tid >> 6), lane = tid & 63, wr = wid >> 2, wc = wid & 3, fr = lane & 15, fq = lane >> 4;
    const int K = g.K, nt = K / BK;
    unsigned voffA[2], voffB[2];
#pragma unroll
    for (int i = 0; i < 2; ++i) { int R, C; stage_rc(tid * 16 + i * 8192, R, C); const int Rb = Epi::PERM ? ((R & ~31) + perm32(R & 31)) : R;
        const int Ra = MB == 4 ? R : R - 16 * (R >> 6);
        voffA[i] = (unsigned)(Ra * K + C) * 2u; voffB[i] = (unsigned)(Rb * K + C) * 2u; }
    const size_t kstep = (size_t)(BK * 2);
    const size_t hstep = (size_t)HALF * K * 2;
    const size_t tstep = 2 * hstep;
    const size_t hstepA = (size_t)(32 * MB) * K * 2, tstepA = 2 * hstepA;
    const unsigned ldsw = (unsigned)wid * 1024u;
    const int aoff = lds_byte(wr * 64 + fr, fq * 8), boff = lds_byte(wc * 32 + fr, fq * 8);
#define PG8_SA(b, h) (((b) * 2 + (h)) * HTB)
#define PG8_SB(b, h) ((4 + (b) * 2 + (h)) * HTB)
#define PG8_STAGE(bufoff, gbase, voff) do { _Pragma("unroll") for (int _i = 0; _i < 2; ++_i) \
        __builtin_amdgcn_global_load_lds((const unsigned*)((const char*)(gbase) + (voff)[_i]), (PG8_LAS unsigned*)(lds + (bufoff) + ldsw + _i * 8192), 16, 0, 0); } while (0)
#define PG8_LDA(dst, b, h) do { _Pragma("unroll") for (int m = 0; m < MB; ++m) _Pragma("unroll") for (int k = 0; k < 2; ++k) dst[m][k] = *(const PG8_LAS bf16x8*)(lds + PG8_SA(b, h) + aoff + m * 2048 + k * 1024); } while (0)
#define PG8_LDB(dst, b, h) do { _Pragma("unroll") for (int n = 0; n < 2; ++n) _Pragma("unroll") for (int k = 0; k < 2; ++k) dst[n][k] = *(const PG8_LAS bf16x8*)(lds + PG8_SB(b, h) + boff + n * 2048 + k * 1024); } while (0)
#define PG8_MMA(ai, bj, At, Bt) do { __builtin_amdgcn_s_setprio(1); _Pragma("unroll") for (int m = 0; m < MB; ++m) _Pragma("unroll") for (int n = 0; n < 2; ++n) _Pragma("unroll") for (int k = 0; k < 2; ++k) \
        acc[ai][bj][m][n] = __builtin_amdgcn_mfma_f32_16x16x32_bf16(Bt[n][k], At[m][k], acc[ai][bj][m][n], 0, 0, 0); __builtin_amdgcn_s_setprio(0); } while (0)
#define PG8_WAIT_V(n) asm volatile("s_waitcnt vmcnt(" #n ")" ::: "memory")
#define PG8_WAIT_L(n) asm volatile("s_waitcnt lgkmcnt(" #n ")" ::: "memory")
#define PG8_BAR __builtin_amdgcn_s_barrier()
#define PG8_SCHED __builtin_amdgcn_sched_barrier(0)
    Unit cur, nxt; int ui = 0;
    if (!S.next(0, cur)) return;
    PG8_LAS float* tabs = (PG8_LAS float*)(lds + STAGE_BYTES + 1024);
    if constexpr (Epi::HAS_TAB) { typename Epi::Pre p0_ = E.pre_load(cur, tid); E.pre_store(p0_, tabs, tid); }
    f32x4 acc[2][2][4][2];
#pragma unroll
    for (int a = 0; a < 2; ++a)
#pragma unroll
        for (int b = 0; b < 2; ++b)
#pragma unroll
            for (int m = 0; m < 4; ++m)
#pragma unroll
                for (int n = 0; n < 2; ++n) acc[a][b][m][n] = (f32x4){0.f, 0.f, 0.f, 0.f};
    bf16x8 At[4][2], B0[2][2], B1[2][2];
    const char* cA = (const char*)g.A + (size_t)cur.pm * tstepA; const char* cB = (const char*)g.Bt + (size_t)cur.pn * tstep;
    S.a_ready(cur);
    if constexpr (SP2) {
        PG8_STAGE(PG8_SB(0, 0), cB, voffB); PG8_STAGE(PG8_SB(0, 1), cB + hstep, voffB); PG8_STAGE(PG8_SA(0, 0), cA, voffA); PG8_STAGE(PG8_SA(0, 1), cA + hstepA, voffA);
        if (wr == 1) PG8_BAR;
        PG8_WAIT_V(2); PG8_BAR;
        PG8_STAGE(PG8_SB(1, 0), cB + kstep, voffB); PG8_STAGE(PG8_SA(1, 0), cA + kstep, voffA); PG8_STAGE(PG8_SB(1, 1), cB + hstep + kstep, voffB);
        PG8_WAIT_V(6); PG8_BAR;
    } else {
        PG8_STAGE(PG8_SB(0, 0), cB, voffB); PG8_STAGE(PG8_SA(0, 0), cA, voffA); PG8_STAGE(PG8_SB(0, 1), cB + hstep, voffB); PG8_STAGE(PG8_SA(0, 1), cA + hstepA, voffA);
        if (wr == 1) PG8_BAR;
        PG8_WAIT_V(4); PG8_BAR;
        PG8_STAGE(PG8_SB(1, 0), cB + kstep, voffB); PG8_STAGE(PG8_SA(1, 0), cA + kstep, voffA); PG8_STAGE(PG8_SB(1, 1), cB + hstep + kstep, voffB);
        PG8_WAIT_V(6); PG8_BAR;
    }
    for (;;) {
        const bool has_next = S.next(ui + 1, nxt);
        const char* nA = has_next ? (const char*)g.A + (size_t)nxt.pm * tstepA : cA; const char* nB = has_next ? (const char*)g.Bt + (size_t)nxt.pn * tstep : cB;
        for (int t = 0; t < nt; t += 2) {
            const bool last = (t == nt - 2);
            const char* a1 = cA + (size_t)(t + 1) * kstep;
            const char* a2 = last ? nA : cA + (size_t)(t + 2) * kstep; const char* b2 = last ? nB : cB + (size_t)(t + 2) * kstep;
            const char* a3 = a2 + kstep; const char* b3 = b2 + kstep;
            if (last && has_next) S.a_ready(nxt);
            if constexpr (SP2) {
            PG8_LDB(B0, 0, 0); PG8_LDB(B1, 0, 1); PG8_SCHED; PG8_LDA(At, 0, 0); PG8_STAGE(PG8_SA(1, 1), a1 + hstepA, voffA);
            PG8_WAIT_V(8); PG8_WAIT_L(0); PG8_BAR; PG8_MMA(0, 0, At, B0); PG8_MMA(0, 1, At, B1); PG8_BAR; PG8_SCHED;
            PG8_LDA(At, 0, 1); PG8_STAGE(PG8_SB(0, 0), b2, voffB); PG8_STAGE(PG8_SB(0, 1), b2 + hstep, voffB); PG8_STAGE(PG8_SA(0, 0), a2, voffA);
            PG8_WAIT_V(8); PG8_WAIT_L(0); PG8_BAR; PG8_MMA(1, 0, At, B0); PG8_MMA(1, 1, At, B1); PG8_BAR; PG8_SCHED;
            PG8_LDB(B0, 1, 0); PG8_LDB(B1, 1, 1); PG8_SCHED; PG8_LDA(At, 1, 0); PG8_STAGE(PG8_SA(0, 1), a2 + hstepA, voffA);
            PG8_WAIT_V(8); PG8_WAIT_L(0); PG8_BAR; PG8_MMA(0, 0, At, B0); PG8_MMA(0, 1, At, B1); PG8_BAR; PG8_SCHED;
            PG8_LDA(At, 1, 1); PG8_STAGE(PG8_SB(1, 0), b3, voffB); PG8_STAGE(PG8_SB(1, 1), b3 + hstep, voffB); PG8_STAGE(PG8_SA(1, 0), a3, voffA);
            PG8_WAIT_V(8); PG8_WAIT_L(0); PG8_BAR; PG8_MMA(1, 0, At, B0); PG8_MMA(1, 1, At, B1); PG8_BAR; PG8_SCHED;
            } else {
            PG8_LDB(B0, 0, 0); PG8_SCHED; PG8_LDA(At, 0, 0); PG8_STAGE(PG8_SA(1, 1), a1 + hstepA, voffA);
            PG8_WAIT_L(8); PG8_BAR; PG8_WAIT_L(0); PG8_MMA(0, 0, At, B0); PG8_BAR; PG8_SCHED;
            PG8_LDB(B1, 0, 1); PG8_STAGE(PG8_SB(0, 0), b2, voffB);
            PG8_BAR; PG8_WAIT_L(0); PG8_MMA(0, 1, At, B1); PG8_BAR;
            PG8_LDA(At, 0, 1); PG8_STAGE(PG8_SA(0, 0), a2, voffA);
            PG8_BAR; PG8_WAIT_L(0); PG8_MMA(1, 0, At, B0); PG8_BAR; PG8_SCHED;
            PG8_STAGE(PG8_SB(0, 1), b2 + hstep, voffB);
            PG8_WAIT_V(6); PG8_BAR; PG8_MMA(1, 1, At, B1); PG8_BAR;
            PG8_LDB(B0, 1, 0); PG8_SCHED; PG8_LDA(At, 1, 0); PG8_STAGE(PG8_SA(0, 1), a2 + hstepA, voffA);
            PG8_WAIT_L(8); PG8_BAR; PG8_WAIT_L(0); PG8_MMA(0, 0, At, B0); PG8_BAR; PG8_SCHED;
            PG8_LDB(B1, 1, 1); PG8_STAGE(PG8_SB(1, 0), b3, voffB);
            PG8_BAR; PG8_WAIT_L(0); PG8_MMA(0, 1, At, B1); PG8_BAR;
            PG8_LDA(At, 1, 1); PG8_STAGE(PG8_SA(1, 0), a3, voffA);
            PG8_BAR; PG8_WAIT_L(0); PG8_MMA(1, 0, At, B0); PG8_BAR; PG8_SCHED;
            PG8_STAGE(PG8_SB(1, 1), b3 + hstep, voffB);
            PG8_WAIT_V(6); PG8_BAR; PG8_MMA(1, 1, At, B1); PG8_BAR;
            }
        }
        if constexpr (ALIGN_EPI) { if (wr == 0) PG8_BAR; }
        if constexpr (Epi::HAS_TAB) {
            typename Epi::Pre pn_; if (has_next) pn_ = E.pre_load(nxt, tid);
            E(acc, cur, wr, wc, fr, fq, tabs + (ui & 1) * Epi::TABSZ);
            if (has_next) E.pre_store(pn_, tabs + ((ui + 1) & 1) * Epi::TABSZ, tid);
            S.done(cur);
        } else
        if constexpr (!Epi::AFTER_DRAIN) { E(acc, cur, wr, wc, fr, fq); S.done(cur); }
        if (!has_next) break;
#pragma unroll
        for (int a = 0; a < 2; ++a)
#pragma unroll
            for (int b = 0; b < 2; ++b)
#pragma unroll
                for (int m = 0; m < 4; ++m)
#pragma unroll
                    for (int n = 0; n < 2; ++n) acc[a][b][m][n] = (f32x4){0.f, 0.f, 0.f, 0.f};
        cur = nxt; cA = nA; cB = nB; ++ui;
        if constexpr (ALIGN_EPI) { if (wr == 1) PG8_BAR; }
    }
    PG8_WAIT_V(0);
    if constexpr (!ALIGN_EPI) { if (wr == 0) PG8_BAR; }
    PG8_BAR;
    if constexpr (Epi::AFTER_DRAIN) { E.fused(acc, cur, wr, wc, fr, fq, lds, wid, lane); S.done(cur); }
#undef PG8_SA
#undef PG8_SB
#undef PG8_STAGE
#undef PG8_LDA
#undef PG8_LDB
#undef PG8_MMA
#undef PG8_WAIT_V
#undef PG8_WAIT_L
#undef PG8_BAR
#undef PG8_SCHED
}
}

constexpr int D = 1024, FF = 2816, NGU = 5632, NIN = 2816;
constexpr int M_CTX = 4096, M = 12288;
constexpr int NMOD = 9216;
constexpr size_t MiB = 1u << 20;
constexpr size_t WS_MOD = 1 * MiB, WS_ROPE = 1 * MiB + 768 * 1024, WS_W = 2 * MiB;
constexpr size_t W_GU1 = 0, W_D1 = 11534336, W_IN = 17301504, W_OUT = 23068672, W_GU2 = 25165824, W_D2 = 36700160, W_LAYER = 42467328;
constexpr size_t WS_X = WS_W + 2 * W_LAYER;
constexpr size_t WS_H = WS_X + (size_t)M * D * 4;
constexpr size_t WS_Y = WS_H + (size_t)M * D * 2;
constexpr size_t WS_ACT = WS_Y + (size_t)M * D * 2;
constexpr size_t WS_END = WS_ACT + (size_t)M * FF * 2;
constexpr size_t WS_BIAS = WS_END;
constexpr int NBIAS = NGU + NIN + NGU, BOFF_GU1 = 0, BOFF_IN = NGU, BOFF_GU2 = NGU + NIN;
constexpr size_t WS_PSS = WS_BIAS + (size_t)2 * 9 * NBIAS * 4;
constexpr size_t WS_END2 = WS_PSS + (size_t)M * 16 * 4;
constexpr int LDS_BYTES = 147456;
constexpr int NTHREADS = 512;

#define LAS __attribute__((address_space(3)))
typedef unsigned short bf16;
typedef unsigned v4u __attribute__((ext_vector_type(4)));
typedef unsigned v2u __attribute__((ext_vector_type(2)));
typedef float f32x4 __attribute__((ext_vector_type(4)));
typedef short bf16x8 __attribute__((ext_vector_type(8)));
typedef short s16x4 __attribute__((ext_vector_type(4)));

struct Args { const float* in[21]; float* out; unsigned char* ws; };
typedef const __attribute__((address_space(4))) Args* KArgs;
__device__ __forceinline__ int lane_id_fresh() { int l; asm volatile("v_mbcnt_lo_u32_b32 %0, -1, 0\n\tv_mbcnt_hi_u32_b32 %0, -1, %0" : "=v"(l)); return l; }
__device__ __forceinline__ KArgs kargs() { KArgs p = (KArgs)__builtin_amdgcn_kernarg_segment_ptr(); asm volatile("" : "+s"(p)); return p; }

__device__ __forceinline__ unsigned pk2(float lo, float hi) { return pg8::cvt_pk_bf16(lo, hi); }
__device__ __forceinline__ v4u pack8(f32x4 a, f32x4 b) { v4u w; w.x = pk2(a[0], a[1]); w.y = pk2(a[2], a[3]); w.z = pk2(b[0], b[1]); w.w = pk2(b[2], b[3]); return w; }
__device__ __forceinline__ float bflo(unsigned u) { return __uint_as_float(u << 16); }
__device__ __forceinline__ float bfhi(unsigned u) { return __uint_as_float(u & 0xffff0000u); }
__device__ __forceinline__ float wave_sum(float v) {
#pragma unroll
    for (int o = 1; o < 64; o <<= 1) v += __shfl_xor(v, o);
    return v;
}
__device__ __forceinline__ float xmax16_32(float v) {
    auto a = __builtin_amdgcn_permlane16_swap(__float_as_uint(v), __float_as_uint(v), false, false); v = fmaxf(__uint_as_float(a[0]), __uint_as_float(a[1]));
    auto b = __builtin_amdgcn_permlane32_swap(__float_as_uint(v), __float_as_uint(v), false, false); return fmaxf(__uint_as_float(b[0]), __uint_as_float(b[1]));
}
__device__ __forceinline__ float xsum16_32(float v) {
    auto a = __builtin_amdgcn_permlane16_swap(__float_as_uint(v), __float_as_uint(v), false, false); v = __uint_as_float(a[0]) + __uint_as_float(a[1]);
    auto b = __builtin_amdgcn_permlane32_swap(__float_as_uint(v), __float_as_uint(v), false, false); return __uint_as_float(b[0]) + __uint_as_float(b[1]);
}
__device__ __forceinline__ float silu_f(float x) { return x * __builtin_amdgcn_rcpf(1.f + __builtin_amdgcn_exp2f(-1.4426950408889634f * x)); }

__device__ __forceinline__ void load_rstd(const float* PSS, int row0, int fq, float (&rstd)[2][4]) {
#pragma unroll
    for (int ai = 0; ai < 2; ++ai)
#pragma unroll
        for (int m = 0; m < 4; ++m) {
            const f32x4 t = *((const f32x4*)(PSS + (unsigned)(row0 + ai * 128 + m * 16) * 16) + fq);
            rstd[ai][m] = (t[0] + t[1]) + (t[2] + t[3]);
        }
#pragma unroll
    for (int ai = 0; ai < 2; ++ai)
#pragma unroll
        for (int m = 0; m < 4; ++m) {
            float q = rstd[ai][m]; q += __shfl_xor(q, 16); q += __shfl_xor(q, 32);
            rstd[ai][m] = 1.f / sqrtf(q * (1.f / D) + 1e-6f);
        }
}
struct TabPre { f32x4 a, b, c, d; };
__device__ __forceinline__ TabPre tab_pre_load(const unsigned char* ws, int bias_off, const pg8::Unit& u, int tid) {
    TabPre p;
    if (tid < 256) { const f32x4* pp = (const f32x4*)((const float*)(ws + WS_PSS) + (unsigned)(u.pm * 256 + tid) * 16); p.a = pp[0]; p.b = pp[1]; p.c = pp[2]; p.d = pp[3]; }
    else { const int cond = u.pm < 16 ? 0 : 1 + ((u.pm - 16) >> 2);
        p.a[0] = ((const float*)(ws + WS_BIAS))[(unsigned)(bias_off + cond * NBIAS + u.pn * 256 + (tid - 256))]; p.b = p.a; p.c = p.a; p.d = p.a; }
    return p;
}
__device__ __forceinline__ void tab_pre_store(const TabPre& p, LAS float* tab, int tid) {
    if (tid < 256) { const f32x4 t = (p.a + p.b) + (p.c + p.d); tab[tid] = 1.f / sqrtf(((t[0] + t[1]) + (t[2] + t[3])) * (1.f / D) + 1e-6f); }
    else tab[tid] = p.a[0];
}
struct EpiSwiglu {
    static constexpr bool PERM = true, AFTER_DRAIN = false, HAS_TAB = true; static constexpr int TABSZ = 512;
    typedef TabPre Pre;
    unsigned char* ws; int bias_off;
    __device__ __forceinline__ Pre pre_load(const pg8::Unit& u, int tid) const { return tab_pre_load(ws, bias_off, u, tid); }
    __device__ __forceinline__ void pre_store(const Pre& p, LAS float* tab, int tid) const { tab_pre_store(p, tab, tid); }
    __device__ __forceinline__ void operator()(const f32x4 (&acc)[2][2][4][2], const pg8::Unit& u, int wr, int wc, int fr, int fq, const LAS float* tab) const {
        bf16* ACT = (bf16*)(ws + WS_ACT);
        const int row0 = u.pm * 256 + wr * 64 + fr, j0 = u.pn * 128 + wc * 32 + 8 * fq;
        const LAS float* bp = tab + 256 + wc * 32 + 8 * fq;
        const f32x4 bg0 = *(const LAS f32x4*)bp, bg1 = *(const LAS f32x4*)(bp + 4), bu0 = *(const LAS f32x4*)(bp + 128), bu1 = *(const LAS f32x4*)(bp + 132);
#pragma unroll
        for (int ai = 0; ai < 2; ++ai)
#pragma unroll
            for (int m = 0; m < 4; ++m) {
                bf16* p = ACT + (unsigned)((row0 + ai * 128 + m * 16) * FF + j0);
                const float r = tab[wr * 64 + ai * 128 + m * 16 + fr];
                const f32x4 g0 = acc[ai][0][m][0] * r + bg0, g1 = acc[ai][0][m][1] * r + bg1, u0 = acc[ai][1][m][0] * r + bu0, u1 = acc[ai][1][m][1] * r + bu1;
                f32x4 o0, o1;
#pragma unroll
                for (int e = 0; e < 4; ++e) { o0[e] = g0[e] * u0[e] * __builtin_amdgcn_rcpf(1.f + __builtin_amdgcn_exp2f(-g0[e])); o1[e] = g1[e] * u1[e] * __builtin_amdgcn_rcpf(1.f + __builtin_amdgcn_exp2f(-g1[e])); }
                *(v4u*)p = pack8(o0, o1);
            }
    }
};
struct EpiRes {
    static constexpr bool PERM = true, AFTER_DRAIN = false, HAS_TAB = false;
    const float* in_ctx; const float* in_lat; unsigned char* ws; const float* gnext; int gate_off, sc_off; float gs;
    __device__ __forceinline__ void operator()(const f32x4 (&acc)[2][2][4][2], const pg8::Unit& u, int wr, int wc, int fr, int fq) const {
        const int cond = u.pm < 16 ? 0 : 1 + ((u.pm - 16) >> 2);
        float* out = (float*)(ws + WS_X); bf16* XA = (bf16*)(ws + WS_H); float* PSS = (float*)(ws + WS_PSS);
        const float* gp = (const float*)(ws + WS_MOD) + gate_off + (unsigned)cond * NMOD;
        const float* scp = (const float*)(ws + WS_MOD) + sc_off + (unsigned)cond * NMOD;
        const float* base = u.pm < 16 ? in_ctx : in_lat;
        const int row0 = u.pm * 256 + wr * 64 + fr, col0 = u.pn * 256 + wc * 32 + 8 * fq;
        float ss[2][4];
#pragma unroll
        for (int bj = 0; bj < 2; ++bj) {
            const int cb = col0 + bj * 128;
            const f32x4 gv0 = *(const f32x4*)(gp + cb) * gs, gv1 = *(const f32x4*)(gp + cb + 4) * gs;
            f32x4 an0 = (f32x4){0.f, 0.f, 0.f, 0.f}, an1 = an0;
            if (gnext) { an0 = *(const f32x4*)(gnext + cb) * (*(const f32x4*)(scp + cb) + 1.f); an1 = *(const f32x4*)(gnext + cb + 4) * (*(const f32x4*)(scp + cb + 4) + 1.f); }
#pragma unroll
            for (int ai = 0; ai < 2; ++ai)
#pragma unroll
                for (int m = 0; m < 4; ++m) {
                    const unsigned off = (unsigned)(row0 + ai * 128 + m * 16) * D + cb;
                    const f32x4 b0 = *(const f32x4*)(base + off), b1 = *(const f32x4*)(base + off + 4);
                    const f32x4 o0 = b0 + gv0 * acc[ai][bj][m][0], o1 = b1 + gv1 * acc[ai][bj][m][1];
                    *(f32x4*)(out + off) = o0; *(f32x4*)(out + off + 4) = o1;
                    if (gnext) {
                        const float q = ((o0[0] * o0[0] + o0[1] * o0[1]) + (o0[2] * o0[2] + o0[3] * o0[3])) + ((o1[0] * o1[0] + o1[1] * o1[1]) + (o1[2] * o1[2] + o1[3] * o1[3]));
                        ss[ai][m] = bj == 0 ? q : ss[ai][m] + q;
                        *(v4u*)(XA + off) = pack8(o0 * an0, o1 * an1);
                    }
                    if (m & 1) asm volatile("" ::: "memory");
                }
        }
        if (gnext) {
#pragma unroll
            for (int ai = 0; ai < 2; ++ai)
#pragma unroll
                for (int m = 0; m < 4; ++m) {
                    const float q = xsum16_32(ss[ai][m]);
                    if (fq == 0) PSS[(unsigned)(row0 + ai * 128 + m * 16) * 16 + u.pn * 4 + wc] = q;
                }
        }
    }
};
struct EpiRes3 {
    static constexpr bool PERM = true, AFTER_DRAIN = false, HAS_TAB = false;
    const float* in_ctx; const float* in_lat; unsigned char* ws; const float* gnext; int gate_off, sc_off; float gs;
    __device__ __forceinline__ void operator()(const f32x4 (&acc)[2][2][4][2], const pg8::Unit& u, int wr, int wc, int fr, int fq) const {
        float* out = (float*)(ws + WS_X); bf16* XA = (bf16*)(ws + WS_H); float* PSS = (float*)(ws + WS_PSS);
        const float* gp0 = (const float*)(ws + WS_MOD) + gate_off;
        const float* scp0 = (const float*)(ws + WS_MOD) + sc_off;
        const int rb0 = u.pm * 192 + wr * 48, col0 = u.pn * 256 + wc * 32 + 8 * fq;
        float ss[2][3];
#pragma unroll
        for (int bj = 0; bj < 2; ++bj) {
            const int cb = col0 + bj * 128;
            f32x4 gn0 = (f32x4){0.f, 0.f, 0.f, 0.f}, gn1 = gn0;
            if (gnext) { gn0 = *(const f32x4*)(gnext + cb); gn1 = *(const f32x4*)(gnext + cb + 4); }
#pragma unroll
            for (int ai = 0; ai < 2; ++ai)
#pragma unroll
                for (int m = 0; m < 3; ++m) {
                    const int rb = rb0 + ai * 96 + m * 16;
                    const int cond = rb < M_CTX ? 0 : 1 + ((rb - M_CTX) >> 10);
                    const float* base = rb < M_CTX ? in_ctx : in_lat;
                    const float* gp = gp0 + (unsigned)(cond * NMOD + cb);
                    const f32x4 gv0 = *(const f32x4*)gp * gs, gv1 = *(const f32x4*)(gp + 4) * gs;
                    const unsigned off = (unsigned)((rb + fr) * D + cb);
                    const f32x4 b0 = *(const f32x4*)(base + off), b1 = *(const f32x4*)(base + off + 4);
                    const f32x4 o0 = b0 + gv0 * acc[ai][bj][m][0], o1 = b1 + gv1 * acc[ai][bj][m][1];
                    *(f32x4*)(out + off) = o0; *(f32x4*)(out + off + 4) = o1;
                    if (gnext) {
                        const float* sp = scp0 + (unsigned)(cond * NMOD + cb);
                        const f32x4 an0 = gn0 * (*(const f32x4*)sp + 1.f), an1 = gn1 * (*(const f32x4*)(sp + 4) + 1.f);
                        const float q = ((o0[0] * o0[0] + o0[1] * o0[1]) + (o0[2] * o0[2] + o0[3] * o0[3])) + ((o1[0] * o1[0] + o1[1] * o1[1]) + (o1[2] * o1[2] + o1[3] * o1[3]));
                        ss[ai][m] = bj == 0 ? q : ss[ai][m] + q;
                        *(v4u*)(XA + off) = pack8(o0 * an0, o1 * an1);
                    }
                }
        }
        if (gnext) {
#pragma unroll
            for (int ai = 0; ai < 2; ++ai)
#pragma unroll
                for (int m = 0; m < 3; ++m) {
                    const float q = xsum16_32(ss[ai][m]);
                    if (fq == 0) PSS[(unsigned)(rb0 + ai * 96 + m * 16 + fr) * 16 + u.pn * 4 + wc] = q;
                }
        }
    }
};
struct EpiWin {
    static constexpr bool PERM = true, AFTER_DRAIN = false, HAS_TAB = true; static constexpr int TABSZ = 512;
    typedef TabPre Pre;
    unsigned char* ws; float* newk; int layer;
    __device__ __forceinline__ Pre pre_load(const pg8::Unit& u, int tid) const { return tab_pre_load(ws, layer * 9 * NBIAS + BOFF_IN, u, tid); }
    __device__ __forceinline__ void pre_store(const Pre& p, LAS float* tab, int tid) const { tab_pre_store(p, tab, tid); }
    __device__ __forceinline__ void operator()(const f32x4 (&acc)[2][2][4][2], const pg8::Unit& u, int wr, int wc, int fr, int fq, const LAS float* tab) const {
        bf16* Z = (bf16*)(ws + WS_ACT); float* newv = newk + 16 * 2 * 4 * 256 * 128;
        const float* rc = (const float*)(ws + WS_ROPE); const float* rs = rc + 1024;
        const int pn = u.pn, pm = u.pm; const bool lat = pm >= 16;
        const int row0 = pm * 256 + wr * 64 + fr;
        const LAS float* bp = tab + 256 + wc * 32 + 8 * fq;
        const LAS float* rp = tab + wr * 64 + fr;
#define WIN_BV() const f32x4 bv00 = *(const LAS f32x4*)bp, bv01 = *(const LAS f32x4*)(bp + 4), bv10 = *(const LAS f32x4*)(bp + 128), bv11 = *(const LAS f32x4*)(bp + 132)
        if (pn < 4) {
            const int lc = 256 * pn + 64 * wc + 8 * fq;
#pragma unroll
            for (int ai = 0; ai < 2; ++ai)
#pragma unroll
                for (int m = 0; m < 4; ++m) {
                    const int row = row0 + ai * 128 + m * 16; const float r = rp[ai * 128 + m * 16]; WIN_BV();
                    f32x4 a0 = acc[ai][0][m][0] * r + bv00, a1 = acc[ai][0][m][1] * r + bv01, b0 = acc[ai][1][m][0] * r + bv10, b1 = acc[ai][1][m][1] * r + bv11;
                    if (lat) {
                        const int t = (row - M_CTX) & 1023; const int pos = fq < 2 ? (t >> 6) : (t & 63);
                        const float* cp = rc + pos * 16 + 8 * (fq & 1); const float* sp = rs + pos * 16 + 8 * (fq & 1);
                        const f32x4 c0 = *(const f32x4*)cp, c1 = *(const f32x4*)(cp + 4), s0 = *(const f32x4*)sp, s1 = *(const f32x4*)(sp + 4);
                        const f32x4 na0 = a0 * c0 - b0 * s0, na1 = a1 * c1 - b1 * s1, nb0 = b0 * c0 + a0 * s0, nb1 = b1 * c1 + a1 * s1;
                        a0 = na0; a1 = na1; b0 = nb0; b1 = nb1;
                    }
                    bf16* zp = Z + (unsigned)(row * NIN + lc);
                    *(v4u*)zp = pack8(a0, a1); *(v4u*)(zp + 32) = pack8(b0, b1);
                    if (!lat && pn >= 2) {
                        const int kc = lc - 512, hh = kc >> 7, dd = kc & 127;
                        float* kp = newk + (unsigned)((((pm * 2 + layer) * 4 + hh) * 256 + (row & 255)) * 128 + dd);
                        *(f32x4*)kp = a0; *(f32x4*)(kp + 4) = a1; *(f32x4*)(kp + 32) = b0; *(f32x4*)(kp + 36) = b1;
                    }
                    asm volatile("" ::: "memory");
                }
        } else {
            const int col = 256 * pn + 32 * wc + 8 * fq;
#pragma unroll
            for (int ai = 0; ai < 2; ++ai)
#pragma unroll
                for (int m = 0; m < 4; ++m) {
                    const int row = row0 + ai * 128 + m * 16; const float r = rp[ai * 128 + m * 16]; WIN_BV();
                    const f32x4 a0 = acc[ai][0][m][0] * r + bv00, a1 = acc[ai][0][m][1] * r + bv01, b0 = acc[ai][1][m][0] * r + bv10, b1 = acc[ai][1][m][1] * r + bv11;
                    bf16* zp = Z + (unsigned)(row * NIN + col);
                    *(v4u*)zp = pack8(a0, a1); *(v4u*)(zp + 128) = pack8(b0, b1);
                    if (!lat && pn < 6) {
                        const int vc = col - 1024, hh = vc >> 7, dd = vc & 127;
                        float* vp = newv + (unsigned)((((pm * 2 + layer) * 4 + hh) * 256 + (row & 255)) * 128 + dd);
                        *(f32x4*)vp = a0; *(f32x4*)(vp + 4) = a1; *(f32x4*)(vp + 256 * 128) = b0; *(f32x4*)(vp + 256 * 128 + 4) = b1;
                    }
                    asm volatile("" ::: "memory");
                }
        }
    }
};

__device__ __forceinline__ int cond_of_row(int r) { return r < M_CTX ? 0 : 1 + ((r - M_CTX) >> 10); }
__device__ __forceinline__ TabPre tab_pre_load3(const unsigned char* ws, int bias_off, const pg8::Unit& u, int tid) {
    TabPre p;
    if (tid < 256) { const int t = tid < 192 ? tid : 191; const f32x4* pp = (const f32x4*)((const float*)(ws + WS_PSS) + (unsigned)(u.pm * 192 + t) * 16); p.a = pp[0]; p.b = pp[1]; p.c = pp[2]; p.d = pp[3]; }
    else { const float* bb = (const float*)(ws + WS_BIAS) + (unsigned)(bias_off + u.pn * 256 + (tid - 256));
        p.a[0] = bb[(unsigned)(cond_of_row(u.pm * 192) * NBIAS)]; p.b = p.a; p.b[0] = bb[(unsigned)(cond_of_row(u.pm * 192 + 191) * NBIAS)]; p.c = p.a; p.d = p.a; }
    return p;
}
__device__ __forceinline__ void tab_pre_store3(const TabPre& p, LAS float* tab, int tid) {
    if (tid < 256) { if (tid < 192) { const f32x4 t = (p.a + p.b) + (p.c + p.d); tab[tid] = 1.f / sqrtf(((t[0] + t[1]) + (t[2] + t[3])) * (1.f / D) + 1e-6f); } }
    else { tab[tid] = p.a[0]; tab[tid + 256] = p.b[0]; }
}
struct EpiWin3 {
    static constexpr bool PERM = true, AFTER_DRAIN = false, HAS_TAB = true; static constexpr int TABSZ = 768;
    typedef TabPre Pre;
    unsigned char* ws; float* newk; int layer;
    __device__ __forceinline__ Pre pre_load(const pg8::Unit& u, int tid) const { return tab_pre_load3(ws, layer * 9 * NBIAS + BOFF_IN, u, tid); }
    __device__ __forceinline__ void pre_store(const Pre& p, LAS float* tab, int tid) const { tab_pre_store3(p, tab, tid); }
    __device__ __forceinline__ void operator()(const f32x4 (&acc)[2][2][4][2], const pg8::Unit& u, int wr, int wc, int fr, int fq, const LAS float* tab) const {
        bf16* Z = (bf16*)(ws + WS_ACT); float* newv = newk + 16 * 2 * 4 * 256 * 128;
        const float* rc = (const float*)(ws + WS_ROPE); const float* rs = rc + 1024;
        const int pn = u.pn;
        const int rb0 = u.pm * 192 + wr * 48, cond_lo = cond_of_row(u.pm * 192);
        const LAS float* bp0 = tab + 256 + wc * 32 + 8 * fq;
        const LAS float* rp = tab + wr * 48 + fr;
#define WIN3_BV() const LAS float* bp = bp0 + (cond_of_row(rb) != cond_lo ? 256 : 0); const f32x4 bv00 = *(const LAS f32x4*)bp, bv01 = *(const LAS f32x4*)(bp + 4), bv10 = *(const LAS f32x4*)(bp + 128), bv11 = *(const LAS f32x4*)(bp + 132)
        if (pn < 4) {
            const int lc = 256 * pn + 64 * wc + 8 * fq;
#pragma unroll
            for (int ai = 0; ai < 2; ++ai)
#pragma unroll
                for (int m = 0; m < 3; ++m) {
                    const int rb = rb0 + ai * 96 + m * 16, row = rb + fr; const bool lat = rb >= M_CTX;
                    const float r = rp[ai * 96 + m * 16]; WIN3_BV();
                    f32x4 a0 = acc[ai][0][m][0] * r + bv00, a1 = acc[ai][0][m][1] * r + bv01, b0 = acc[ai][1][m][0] * r + bv10, b1 = acc[ai][1][m][1] * r + bv11;
                    if (lat) {
                        const int t = (row - M_CTX) & 1023; const int pos = fq < 2 ? (t >> 6) : (t & 63);
                        const float* cp = rc + pos * 16 + 8 * (fq & 1); const float* sp = rs + pos * 16 + 8 * (fq & 1);
                        const f32x4 c0 = *(const f32x4*)cp, c1 = *(const f32x4*)(cp + 4), s0 = *(const f32x4*)sp, s1 = *(const f32x4*)(sp + 4);
                        const f32x4 na0 = a0 * c0 - b0 * s0, na1 = a1 * c1 - b1 * s1, nb0 = b0 * c0 + a0 * s0, nb1 = b1 * c1 + a1 * s1;
                        a0 = na0; a1 = na1; b0 = nb0; b1 = nb1;
                    }
                    bf16* zp = Z + (unsigned)(row * NIN + lc);
                    *(v4u*)zp = pack8(a0, a1); *(v4u*)(zp + 32) = pack8(b0, b1);
                    if (!lat && pn >= 2) {
                        const int kc = lc - 512, hh = kc >> 7, dd = kc & 127;
                        float* kp = newk + (unsigned)(((((row >> 8) * 2 + layer) * 4 + hh) * 256 + (row & 255)) * 128 + dd);
                        *(f32x4*)kp = a0; *(f32x4*)(kp + 4) = a1; *(f32x4*)(kp + 32) = b0; *(f32x4*)(kp + 36) = b1;
                    }
                    asm volatile("" ::: "memory");
                }
        } else {
            const int col = 256 * pn + 32 * wc + 8 * fq;
#pragma unroll
            for (int ai = 0; ai < 2; ++ai)
#pragma unroll
                for (int m = 0; m < 3; ++m) {
                    const int rb = rb0 + ai * 96 + m * 16, row = rb + fr; const bool lat = rb >= M_CTX;
                    const float r = rp[ai * 96 + m * 16]; WIN3_BV();
                    const f32x4 a0 = acc[ai][0][m][0] * r + bv00, a1 = acc[ai][0][m][1] * r + bv01, b0 = acc[ai][1][m][0] * r + bv10, b1 = acc[ai][1][m][1] * r + bv11;
                    bf16* zp = Z + (unsigned)(row * NIN + col);
                    *(v4u*)zp = pack8(a0, a1); *(v4u*)(zp + 128) = pack8(b0, b1);
                    if (!lat && pn < 6) {
                        const int vc = col - 1024, hh = vc >> 7, dd = vc & 127;
                        float* vp = newv + (unsigned)(((((row >> 8) * 2 + layer) * 4 + hh) * 256 + (row & 255)) * 128 + dd);
                        *(f32x4*)vp = a0; *(f32x4*)(vp + 4) = a1; *(f32x4*)(vp + 256 * 128) = b0; *(f32x4*)(vp + 256 * 128 + 4) = b1;
                    }
                    asm volatile("" ::: "memory");
                }
        }
#undef WIN3_BV
    }
};

__device__ __forceinline__ void p0_mod(LAS unsigned char* lds, KArgs A, int tid) {
    LAS float* sc = (LAS float*)lds;
    LAS float* red = (LAS float*)(lds + 36864);
    for (int idx = tid; idx < 9 * 1024; idx += NTHREADS) { const int c = idx >> 10, k = idx & 1023; const float x = c == 0 ? A->in[5][k] : A->in[4][(c - 1) * 1024 + k]; sc[idx] = x / (1.f + __expf(-x)); }
    __syncthreads();
    float* MOD = (float*)(A->ws + WS_MOD);
    for (int it = blockIdx.x; it < 256; it += gridDim.x) {
        const int l = it >> 7, col0 = (it & 127) * 72;
        if (tid < 504) {
            const int kg = tid / 18, c4 = tid % 18;
            f32x4 acc[9];
#pragma unroll
            for (int c = 0; c < 9; ++c) acc[c] = (f32x4){0.f, 0.f, 0.f, 0.f};
            const float* wp = A->in[6] + (size_t)l * 1024 * NMOD + col0 + 4 * c4;
#pragma unroll 4
            for (int k = kg; k < 1024; k += 28) {
                const f32x4 w = *(const f32x4*)(wp + (size_t)k * NMOD);
#pragma unroll
                for (int c = 0; c < 9; ++c) acc[c] += w * sc[c * 1024 + k];
            }
#pragma unroll
            for (int c = 0; c < 9; ++c)
#pragma unroll
                for (int e = 0; e < 4; ++e) red[(kg * 9 + c) * 72 + 4 * c4 + e] = acc[c][e];
        }
        __syncthreads();
        for (int idx = tid; idx < 648; idx += NTHREADS) {
            const int c = idx / 72, j = idx % 72; float s = A->in[7][l * NMOD + col0 + j];
            for (int kg = 0; kg < 28; ++kg) s += red[(kg * 9 + c) * 72 + j];
            MOD[(size_t)(l * 9 + c) * NMOD + col0 + j] = s;
        }
        __syncthreads();
    }
}
__device__ __forceinline__ void transpose_item(const float* W, int K, int N, bf16* WT, LAS float* scr, int item, int lane, int kind) {
    const int nblk = N / 32, kb = item / nblk, nb = item % nblk, k0 = 64 * kb, n0 = 32 * nb;
    int ln0 = n0;
    if (kind == 1) { const int pn = n0 >> 8, w = n0 & 255; ln0 = (w >> 7) * FF + 128 * pn + (w & 127); }
    else if (kind == 2 && n0 < 1024) { const int pn = n0 >> 8, w = n0 & 255; ln0 = 256 * pn + 64 * ((w & 127) >> 5) + 32 * (w >> 7); }
#pragma unroll 8
    for (int i = 0; i < 32; ++i) { const int kk = 2 * i + (lane >> 5); scr[kk * 33 + (lane & 31)] = W[(size_t)(k0 + kk) * N + ln0 + (lane & 31)]; }
    asm volatile("s_waitcnt lgkmcnt(0)" ::: "memory");
    const float wsc = kind == 1 ? (((n0 & 255) < 128) ? 1.4426950408889634f : 0.6931471805599453f) : 1.f;
    const int c = lane & 7;
#pragma unroll
    for (int j = 0; j < 4; ++j) { const int n = (lane >> 3) + 8 * j; const LAS float* s = scr + (8 * c) * 33 + n;
        v4u o; o.x = pk2(s[0 * 33] * wsc, s[1 * 33] * wsc); o.y = pk2(s[2 * 33] * wsc, s[3 * 33] * wsc); o.z = pk2(s[4 * 33] * wsc, s[5 * 33] * wsc); o.w = pk2(s[6 * 33] * wsc, s[7 * 33] * wsc);
        *(v4u*)(WT + (size_t)(n0 + n) * K + k0 + 8 * c) = o; }
    asm volatile("s_waitcnt lgkmcnt(0)" ::: "memory");
}
__device__ __forceinline__ void p0_weights(LAS unsigned char* lds, KArgs A, int gw, int NGW, int wave, int lane) {
    LAS float* scr = (LAS float*)(lds + wave * 16384);
    constexpr int I_GU = 16 * 176, I_D = 44 * 32, I_IN = 16 * 88, I_OUT = 16 * 32, I_LAYER = 2 * I_GU + 2 * I_D + I_IN + I_OUT;
    for (int it = gw; it < 2 * I_LAYER; it += NGW) {
        const int l = it / I_LAYER; int r = it % I_LAYER;
        unsigned char* wl = A->ws + WS_W + (size_t)l * W_LAYER;
        if (r < I_GU) { transpose_item(A->in[9] + (size_t)l * D * NGU, D, NGU, (bf16*)(wl + W_GU1), scr, r, lane, 1); continue; } r -= I_GU;
        if (r < I_D) { transpose_item(A->in[10] + (size_t)l * FF * D, FF, D, (bf16*)(wl + W_D1), scr, r, lane, 0); continue; } r -= I_D;
        if (r < I_IN) { transpose_item(A->in[13] + (size_t)l * D * NIN, D, NIN, (bf16*)(wl + W_IN), scr, r, lane, 2); continue; } r -= I_IN;
        if (r < I_OUT) { transpose_item(A->in[14] + (size_t)l * D * D, D, D, (bf16*)(wl + W_OUT), scr, r, lane, 0); continue; } r -= I_OUT;
        if (r < I_GU) { transpose_item(A->in[11] + (size_t)l * D * NGU, D, NGU, (bf16*)(wl + W_GU2), scr, r, lane, 1); continue; } r -= I_GU;
        transpose_item(A->in[12] + (size_t)l * FF * D, FF, D, (bf16*)(wl + W_D2), scr, r, lane, 0);
    }
}

__device__ __forceinline__ void xa_phase(const float* in_ctx, const float* in_lat, const float* g, const float* modl, int isc, bf16* XA, float* PSS, int gw, int NGW, int lane) {
    asm volatile("" : "+v"(lane));
    for (int m = gw; m < M; m += NGW) {
        const float* xrow = (m < M_CTX ? in_ctx : in_lat) + (size_t)m * D;
        const int cond = m < M_CTX ? 0 : 1 + ((m - M_CTX) >> 10);
        const f32x4* sc4 = (const f32x4*)(modl + (size_t)cond * NMOD + isc * 1024);
        const f32x4* g4 = (const f32x4*)g; const f32x4* x4 = (const f32x4*)xrow;
        f32x4 v[4]; float ss = 0.f;
#pragma unroll
        for (int j = 0; j < 4; ++j) { v[j] = x4[lane + 64 * j]; ss += (v[j].x * v[j].x + v[j].y * v[j].y) + (v[j].z * v[j].z + v[j].w * v[j].w); }
        ss = wave_sum(ss);
        if (lane < 16) PSS[(size_t)m * 16 + lane] = lane == 0 ? ss : 0.f;
        v2u* o = (v2u*)(XA + (size_t)m * D);
#pragma unroll
        for (int j = 0; j < 4; ++j) {
            const int k4 = lane + 64 * j;
            const f32x4 r = v[j] * g4[k4] * (sc4[k4] + 1.f);
            v2u w; w.x = pk2(r.x, r.y); w.y = pk2(r.z, r.w); o[k4] = w;
        }
    }
}
__device__ __forceinline__ void bias_phase(LAS unsigned char* lds, KArgs A, int bxv, int G, int tid, int wave, int lane) {
    const int combo = bxv % 6, l = combo / 3, sidx = combo % 3;
    const int N = sidx == 1 ? NIN : NGU;
    const int boff = sidx == 0 ? BOFF_GU1 : (sidx == 1 ? BOFF_IN : BOFF_GU2);
    const bf16* Wt = (const bf16*)(A->ws + WS_W + (size_t)l * W_LAYER + (sidx == 0 ? W_GU1 : (sidx == 1 ? W_IN : W_GU2)));
    const float* MOD = (const float*)(A->ws + WS_MOD) + (size_t)l * 9 * NMOD + sidx * 3 * 1024;
    float* BIAS = (float*)(A->ws + WS_BIAS) + (size_t)l * 9 * NBIAS + boff;
    LAS bf16* shh = (LAS bf16*)lds;
    LAS bf16* shl = (LAS bf16*)(lds + 32768);
    __syncthreads();
    for (int idx = tid; idx < 16 * 1024; idx += NTHREADS) {
        const int c = idx >> 10, k = idx & 1023;
        const float v = c < 9 ? MOD[(size_t)c * NMOD + k] : 0.f;
        const unsigned hi = pk2(v, 0.f) & 0xffffu; const float r = v - __uint_as_float(hi << 16);
        shh[idx] = (bf16)hi; shl[idx] = (bf16)(pk2(r, 0.f) & 0xffffu);
    }
    __syncthreads();
    const int i16 = lane & 15, kg = lane >> 4;
    const int nwg = (G - combo + 5) / 6;
    const int wslot = (bxv / 6) * 8 + wave, nslots = nwg * 8;
    for (int task = wslot; task < N / 16; task += nslots) {
        const bf16* wp = Wt + (size_t)(task * 16 + i16) * D + 8 * kg;
        f32x4 acc = (f32x4){0.f, 0.f, 0.f, 0.f};
#pragma unroll 8
        for (int ks = 0; ks < 32; ++ks) {
            const bf16x8 a = *(const bf16x8*)(wp + 32 * ks);
            const bf16x8 bh = *(const LAS bf16x8*)(shh + i16 * 1024 + 32 * ks + 8 * kg), bl = *(const LAS bf16x8*)(shl + i16 * 1024 + 32 * ks + 8 * kg);
            acc = __builtin_amdgcn_mfma_f32_16x16x32_bf16(a, bh, acc, 0, 0, 0);
            acc = __builtin_amdgcn_mfma_f32_16x16x32_bf16(a, bl, acc, 0, 0, 0);
        }
        if (i16 < 9) *(f32x4*)(BIAS + (size_t)i16 * NBIAS + task * 16 + 4 * kg) = acc;
    }
    __syncthreads();
}
__device__ __forceinline__ void final_norm(const float* X, const float* g, float* out, int gw, int NGW, int lane) {
    for (int m = gw; m < M; m += NGW) {
        const f32x4* x4 = (const f32x4*)(X + (size_t)m * D); const f32x4* g4 = (const f32x4*)g;
        f32x4 v[4]; float ss = 0.f;
#pragma unroll
        for (int j = 0; j < 4; ++j) { v[j] = x4[lane + 64 * j]; ss += (v[j].x * v[j].x + v[j].y * v[j].y) + (v[j].z * v[j].z + v[j].w * v[j].w); }
        const float rstd = 1.f / sqrtf(wave_sum(ss) * (1.f / D) + 1e-6f);
        f32x4* o = (f32x4*)(out + (size_t)m * D);
#pragma unroll
        for (int j = 0; j < 4; ++j) o[lane + 64 * j] = v[j] * rstd * g4[lane + 64 * j];
    }
}

__device__ __forceinline__ unsigned off_b(unsigned row, unsigned ch) { return 256u * row + 16u * (ch ^ (((row & 3u) << 2) | ((0u - (row >> 2)) & 3u))); }
__device__ __forceinline__ s16x4 vtr(const LAS unsigned char* p) { return __builtin_bit_cast(s16x4, __builtin_amdgcn_ds_read_tr16_b64_v4i16((LAS s16x4*)p)); }

__device__ __forceinline__ void attn_item(LAS unsigned char* lds, KArgs A, int l, bool isLat, int b, int h, int qb, float lam, float oml, int tid, int wave, int lane) {
    const bf16* Z = (const bf16*)(A->ws + WS_ACT);
    bf16* Y = (bf16*)(A->ws + WS_Y);
    const int i16 = lane & 15, kg = lane >> 4;
    const int seq0 = isLat ? M_CTX + b * 1024 : b * 256;
    const int qrow = seq0 + qb * 128 + wave * 16 + i16;
    bf16x8 qf[4];
#pragma unroll
    for (int s = 0; s < 4; ++s) qf[s] = *(const bf16x8*)(Z + (size_t)qrow * NIN + h * 128 + 32 * s + 8 * kg);
    const int NT = isLat ? 20 : 4;
    const size_t coff = (size_t)((b * 2 + l) * 4 + h) * 256 * 128;
    const float* ck = A->in[2] + coff; const float* cv = A->in[3] + coff;
    const int sr = tid >> 4, sch = tid & 15;
    const unsigned sd0 = off_b(sr, sch), sd1 = off_b(sr + 32, sch);
    unsigned koff[4], voff[8];
#pragma unroll
    for (int s = 0; s < 4; ++s) koff[s] = off_b(i16, 4 * s + kg);
    { const int q_ = i16 >> 2, p = lane & 3;
#pragma unroll
      for (int c = 0; c < 8; ++c) voff[c] = 32768u + off_b(4 * kg + q_, 2 * c + (p >> 1)) + 8 * (p & 1); }
    v4u kreg[2], vreg[2];
#define ATT_LOAD(t) do { \
        if (isLat && (t) < 4) { \
            _Pragma("unroll") for (int i_ = 0; i_ < 2; ++i_) { const int key = 64 * (t) + sr + 32 * i_; \
                const float* pk = ck + key * 128 + sch * 8; const float* pv = cv + key * 128 + sch * 8; \
                kreg[i_] = pack8(*(const f32x4*)pk, *(const f32x4*)(pk + 4)); vreg[i_] = pack8(*(const f32x4*)pv, *(const f32x4*)(pv + 4)); } \
        } else { \
            _Pragma("unroll") for (int i_ = 0; i_ < 2; ++i_) { const size_t row = seq0 + 64 * (isLat ? (t) - 4 : (t)) + sr + 32 * i_; \
                kreg[i_] = *(const v4u*)(Z + row * NIN + 512 + h * 128 + sch * 8); vreg[i_] = *(const v4u*)(Z + row * NIN + 1024 + h * 128 + sch * 8); } \
        } } while (0)
#define ATT_STORE(bi) do { \
        *(LAS v4u*)(lds + (bi) * 16384 + sd0) = kreg[0]; *(LAS v4u*)(lds + (bi) * 16384 + sd1) = kreg[1]; \
        *(LAS v4u*)(lds + 32768 + (bi) * 16384 + sd0) = vreg[0]; *(LAS v4u*)(lds + 32768 + (bi) * 16384 + sd1) = vreg[1]; } while (0)
    f32x4 O[2][8];
#pragma unroll
    for (int mp = 0; mp < 2; ++mp)
#pragma unroll
        for (int c = 0; c < 8; ++c) O[mp][c] = (f32x4){0.f, 0.f, 0.f, 0.f};
    float mrun[2] = {-INFINITY, -INFINITY}, lsum[2] = {0.f, 0.f};
    const float c2 = 0.125f * 1.4426950408889634f;
    ATT_LOAD(0); ATT_STORE(0); __syncthreads();
    for (int t = 0; t < NT; ++t) {
        const int bi = t & 1;
        if (t + 1 < NT) ATT_LOAD(t + 1);
        const LAS unsigned char* kb_ = lds + bi * 16384;
        const LAS unsigned char* vb_ = lds + bi * 16384;
        bf16x8 kf[4][4];
#pragma unroll
        for (int kb = 0; kb < 4; ++kb)
#pragma unroll
            for (int s = 0; s < 4; ++s) kf[kb][s] = *(const LAS bf16x8*)(kb_ + kb * 4096 + koff[s]);
        __builtin_amdgcn_sched_barrier(0);
        f32x4 S[2][4];
#pragma unroll
        for (int mp = 0; mp < 2; ++mp)
#pragma unroll
            for (int kb = 0; kb < 4; ++kb) {
                S[mp][kb] = __builtin_amdgcn_mfma_f32_16x16x32_bf16(kf[kb][2 * mp], qf[2 * mp], (f32x4){0.f, 0.f, 0.f, 0.f}, 0, 0, 0);
                S[mp][kb] = __builtin_amdgcn_mfma_f32_16x16x32_bf16(kf[kb][2 * mp + 1], qf[2 * mp + 1], S[mp][kb], 0, 0, 0);
            }
        s16x4 va[8][2], vc[8][2];
#pragma unroll
        for (int c = 0; c < 8; ++c) { va[c][0] = vtr(vb_ + voff[c]); va[c][1] = vtr(vb_ + 256 * 16 + voff[c]); }
        __builtin_amdgcn_sched_barrier(0);
        bf16x8 pb[2][2];
#pragma unroll
        for (int mp = 0; mp < 2; ++mp) {
            float mx = fmaxf(fmaxf(S[mp][0][0], S[mp][0][1]), fmaxf(S[mp][0][2], S[mp][0][3]));
#pragma unroll
            for (int kb = 1; kb < 4; ++kb) mx = fmaxf(mx, fmaxf(fmaxf(S[mp][kb][0], S[mp][kb][1]), fmaxf(S[mp][kb][2], S[mp][kb][3])));
            mx = xmax16_32(mx);
            const float tm = mx * c2;
            if (__builtin_amdgcn_ballot_w64(tm > mrun[mp] + 8.f) != 0ull) {
                const float mnew = fmaxf(mrun[mp], tm);
                const float alpha = __builtin_amdgcn_exp2f(mrun[mp] - mnew);
                mrun[mp] = mnew; lsum[mp] *= alpha;
#pragma unroll
                for (int c = 0; c < 8; ++c) O[mp][c] *= alpha;
            }
            const float mref = mrun[mp];
            float ps = 0.f;
#pragma unroll
            for (int kb = 0; kb < 4; ++kb)
#pragma unroll
                for (int e = 0; e < 4; ++e) { S[mp][kb][e] = __builtin_amdgcn_exp2f(S[mp][kb][e] * c2 - mref); ps += S[mp][kb][e]; }
            lsum[mp] += ps;
#pragma unroll
            for (int ks = 0; ks < 2; ++ks) { const v4u w = pack8(S[mp][2 * ks], S[mp][2 * ks + 1]); pb[mp][ks] = __builtin_bit_cast(bf16x8, w); }
        }
        __builtin_amdgcn_sched_barrier(0);
#pragma unroll
        for (int c = 0; c < 8; ++c) { vc[c][0] = vtr(vb_ + 256 * 32 + voff[c]); vc[c][1] = vtr(vb_ + 256 * 48 + voff[c]); }
#pragma unroll
        for (int c = 0; c < 8; ++c) {
            const bf16x8 vf = (bf16x8){va[c][0][0], va[c][0][1], va[c][0][2], va[c][0][3], va[c][1][0], va[c][1][1], va[c][1][2], va[c][1][3]};
            O[0][c] = __builtin_amdgcn_mfma_f32_16x16x32_bf16(vf, pb[0][0], O[0][c], 0, 0, 0);
            O[1][c] = __builtin_amdgcn_mfma_f32_16x16x32_bf16(vf, pb[1][0], O[1][c], 0, 0, 0);
        }
        __builtin_amdgcn_sched_barrier(0);
#pragma unroll
        for (int c = 0; c < 8; ++c) {
            const bf16x8 vf = (bf16x8){vc[c][0][0], vc[c][0][1], vc[c][0][2], vc[c][0][3], vc[c][1][0], vc[c][1][1], vc[c][1][2], vc[c][1][3]};
            O[0][c] = __builtin_amdgcn_mfma_f32_16x16x32_bf16(vf, pb[0][1], O[0][c], 0, 0, 0);
            O[1][c] = __builtin_amdgcn_mfma_f32_16x16x32_bf16(vf, pb[1][1], O[1][c], 0, 0, 0);
        }
        __builtin_amdgcn_sched_barrier(0);
        if (t + 1 < NT) ATT_STORE(bi ^ 1);
        __syncthreads();
    }
#undef ATT_LOAD
#undef ATT_STORE
    float l1 = lsum[0], l2 = lsum[1];
    l1 += __shfl_xor(l1, 16); l1 += __shfl_xor(l1, 32); l2 += __shfl_xor(l2, 16); l2 += __shfl_xor(l2, 32);
    const float r1 = 1.f / l1, r2 = lam / l2;
    float ss = 0.f;
#pragma unroll
    for (int c = 0; c < 8; ++c) { O[0][c] = O[0][c] * r1 - O[1][c] * r2; ss += (O[0][c][0] * O[0][c][0] + O[0][c][1] * O[0][c][1]) + (O[0][c][2] * O[0][c][2] + O[0][c][3] * O[0][c][3]); }
    ss += __shfl_xor(ss, 16); ss += __shfl_xor(ss, 32);
    const float rstd = oml / sqrtf(ss * (1.f / 128.f) + 1e-6f);
    const float* gsub = A->in[16] + (size_t)(l * 4 + h) * 128;
    bf16* yp = Y + (size_t)qrow * D + h * 128 + 4 * kg;
#pragma unroll
    for (int c = 0; c < 8; ++c) {
        const f32x4 gv = *(const f32x4*)(gsub + 16 * c + 4 * kg);
        const f32x4 o = O[0][c] * rstd * gv;
        v2u w; w.x = pk2(o[0], o[1]); w.y = pk2(o[2], o[3]);
        *(v2u*)(yp + 16 * c) = w;
    }
}

__device__ __forceinline__ void bc_item(LAS unsigned char* lds, KArgs A, int l, int n, int g, int tid, int wave, int lane) {
    asm volatile("" : "+v"(tid)); asm volatile("" : "+v"(lane));
    const bf16* Z = (const bf16*)(A->ws + WS_ACT);
    bf16* Y = (bf16*)(A->ws + WS_Y);
    LAS unsigned char* VC = lds;
    const int r0 = n * 128;
    const int i16 = lane & 15, kg = lane >> 4;
    v4u vcr[2];
#pragma unroll
    for (int i = 0; i < 2; ++i) { const int idx = tid + NTHREADS * i, q = idx >> 3, ch = idx & 7; vcr[i] = *(const v4u*)(Z + (unsigned)((r0 + q) * NIN + 2560 + g * 64 + ch * 8)); }
    const float* wrow = A->in[18] + (unsigned)(((l * 4 + g) * 128 + 16 * wave + i16) * 128 + 8 * kg);
    f32x4 wr_[4][2];
#pragma unroll
    for (int ks = 0; ks < 4; ++ks) { wr_[ks][0] = *(const f32x4*)(wrow + 32 * ks); wr_[ks][1] = *(const f32x4*)(wrow + 32 * ks + 4); }
    const int rowm = r0 + 16 * wave + i16;
    const float bias = A->in[19][(l * 4 + g) * 128 + 16 * wave + i16];
    v2u uu[4];
#pragma unroll
    for (int cb = 0; cb < 4; ++cb) uu[cb] = *(const v2u*)(Z + (unsigned)(rowm * NIN + 2304 + g * 64 + 16 * cb + 4 * kg));
    const int p = tid >> 2, cq = tid & 3;
    const int rowc = r0 + p; const int cc = g * 64 + cq * 16;
    const int seqlen = n < 32 ? 256 : 1024; const int tpos = n < 32 ? (rowc & 255) : ((rowc - M_CTX) & 1023);
    const bool hasp = tpos > 0, hasn = tpos < seqlen - 1;
    const bf16* zr = Z + (unsigned)(rowc * NIN + cc);
    const bf16* zp = hasp ? zr - NIN : zr; const bf16* zn = hasn ? zr + NIN : zr;
    v4u gb[2], gc0[2], hc0[2], gc1[2], hc1[2], gc2[2], hc2[2];
#pragma unroll
    for (int hf = 0; hf < 2; ++hf) {
        gb[hf] = *(const v4u*)(zr + 1536 + 8 * hf);
        gc1[hf] = *(const v4u*)(zr + 1792 + 8 * hf); hc1[hf] = *(const v4u*)(zr + 2048 + 8 * hf);
        gc0[hf] = *(const v4u*)(zp + 1792 + 8 * hf); hc0[hf] = *(const v4u*)(zp + 2048 + 8 * hf);
        gc2[hf] = *(const v4u*)(zn + 1792 + 8 * hf); hc2[hf] = *(const v4u*)(zn + 2048 + 8 * hf);
    }
#pragma unroll
    for (int i = 0; i < 2; ++i) { const int idx = tid + NTHREADS * i, q = idx >> 3, ch = idx & 7; *(LAS v4u*)(VC + q * 128 + ch * 16) = vcr[i]; }
    bf16x8 wf[4];
#pragma unroll
    for (int ks = 0; ks < 4; ++ks) { const v4u w = pack8(wr_[ks][0], wr_[ks][1]); wf[ks] = __builtin_bit_cast(bf16x8, w); }
    __syncthreads();
    f32x4 acc[4];
#pragma unroll
    for (int cb = 0; cb < 4; ++cb) acc[cb] = (f32x4){0.f, 0.f, 0.f, 0.f};
    const LAS unsigned char* vb = VC + (8 * kg + (i16 >> 2)) * 128 + 8 * (lane & 3);
#pragma unroll
    for (int ks = 0; ks < 4; ++ks)
#pragma unroll
        for (int cb = 0; cb < 4; ++cb) {
            const s16x4 lo = vtr(vb + (32 * ks) * 128 + 32 * cb), hi = vtr(vb + (32 * ks + 4) * 128 + 32 * cb);
            const bf16x8 vf = (bf16x8){lo[0], lo[1], lo[2], lo[3], hi[0], hi[1], hi[2], hi[3]};
            acc[cb] = __builtin_amdgcn_mfma_f32_16x16x32_bf16(vf, wf[ks], acc[cb], 0, 0, 0);
        }
#pragma unroll
    for (int cb = 0; cb < 4; ++cb) {
        v2u o; o.x = pk2(bflo(uu[cb].x) * (acc[cb][0] + bias), bfhi(uu[cb].x) * (acc[cb][1] + bias)); o.y = pk2(bflo(uu[cb].y) * (acc[cb][2] + bias), bfhi(uu[cb].y) * (acc[cb][3] + bias));
        *(v2u*)(Y + (unsigned)(rowm * D + 768 + g * 64 + 16 * cb + 4 * kg)) = o;
    }
    {
        const float* cw = A->in[17] + (unsigned)(l * 3 * 256 + cc);
        const float mp_ = hasp ? 1.f : 0.f, mn_ = hasn ? 1.f : 0.f;
#pragma unroll
        for (int hf = 0; hf < 2; ++hf) {
            const f32x4 w0a = *(const f32x4*)(cw + 8 * hf) * mp_, w0b = *(const f32x4*)(cw + 8 * hf + 4) * mp_;
            const f32x4 w1a = *(const f32x4*)(cw + 256 + 8 * hf), w1b = *(const f32x4*)(cw + 256 + 8 * hf + 4);
            const f32x4 w2a = *(const f32x4*)(cw + 512 + 8 * hf) * mn_, w2b = *(const f32x4*)(cw + 512 + 8 * hf + 4) * mn_;
            v4u o;
#pragma unroll
            for (int e = 0; e < 4; ++e) {
                const float wl0 = e < 2 ? w0a[2 * e] : w0b[2 * e - 4], wh0 = e < 2 ? w0a[2 * e + 1] : w0b[2 * e - 3];
                const float wl1 = e < 2 ? w1a[2 * e] : w1b[2 * e - 4], wh1 = e < 2 ? w1a[2 * e + 1] : w1b[2 * e - 3];
                const float wl2 = e < 2 ? w2a[2 * e] : w2b[2 * e - 4], wh2 = e < 2 ? w2a[2 * e + 1] : w2b[2 * e - 3];
                const float lo = bflo(gb[hf][e]) * (wl0 * bflo(gc0[hf][e]) * bflo(hc0[hf][e]) + wl1 * bflo(gc1[hf][e]) * bflo(hc1[hf][e]) + wl2 * bflo(gc2[hf][e]) * bflo(hc2[hf][e]));
                const float hi = bfhi(gb[hf][e]) * (wh0 * bfhi(gc0[hf][e]) * bfhi(hc0[hf][e]) + wh1 * bfhi(gc1[hf][e]) * bfhi(hc1[hf][e]) + wh2 * bfhi(gc2[hf][e]) * bfhi(hc2[hf][e]));
                o[e] = pk2(lo, hi);
            }
            *(v4u*)(Y + (unsigned)(rowc * D + 512 + cc + 8 * hf)) = o;
        }
    }
    __syncthreads();
}

__device__ __forceinline__ void mixer_phase(LAS unsigned char* lds, KArgs A, int l, int vcu, int G, int tid, int wave, int lane) {
    asm volatile("" : "+v"(tid)); lane = tid & 63; wave = __builtin_amdgcn_readfirstlane(tid >> 6);
    const float lam_init = __uint_as_float(__builtin_amdgcn_readfirstlane(l == 0 ? 0x3e4ccccdu : 0x3eb60549u));
    const float* lp = A->in[15] + (size_t)l * 256;
    const float s01 = wave_sum(lp[lane] * lp[64 + lane]), s23 = wave_sum(lp[128 + lane] * lp[192 + lane]);
    const float lam = __uint_as_float(__builtin_amdgcn_readfirstlane(__float_as_uint(__expf(s01) - __expf(s23) + lam_init)));
    const float oml = __uint_as_float(__builtin_amdgcn_readfirstlane(l == 0 ? 0x3f4ccccdu : 0x3f24fd5cu));
    for (int it = vcu; it < 768; it += G) {
        if (it < 256) attn_item(lds, A, l, true, it >> 5, (it >> 3) & 3, it & 7, lam, oml, tid, wave, lane);
        else if (it < 384) { const int j = it - 256; attn_item(lds, A, l, false, j >> 3, (j >> 1) & 3, j & 1, lam, oml, tid, wave, lane); }
        else { const int j = it - 384; bc_item(lds, A, l, j >> 2, j & 3, tid, wave, lane); }
    }
}

#define XB_TMO      128
#define XB_XCNT(j)  (256  + 64 * (j))
#define XB_XSUB(j)  (1280 + 64 * (j))
#define XB_XGEN(j)  (2304 + 64 * (j))
#define XB_TOP      3328
#define XB_TOPGEN   3392
#define XCD_BAR_WORDS 3456
#define XB_SPIN_CAP (1u << 18)

__device__ __forceinline__ unsigned xb_ld(unsigned* p)              { return __hip_atomic_load(p, __ATOMIC_RELAXED, __HIP_MEMORY_SCOPE_AGENT); }
__device__ __forceinline__ unsigned xb_add(unsigned* p, unsigned v) { return __hip_atomic_fetch_add(p, v, __ATOMIC_RELAXED, __HIP_MEMORY_SCOPE_AGENT); }
__device__ __forceinline__ unsigned xb_xcc_id() { return (unsigned)__builtin_amdgcn_s_getreg((3 << 11) | 20) & 0xFu; }
#define XB_SPIN(cond, bar) do { unsigned _sp = 0; while (cond) { __builtin_amdgcn_s_sleep(1); \
    if ((++_sp & 255u) == 0u) { if (xb_ld(&(bar)[XB_TMO])) break; if (_sp > XB_SPIN_CAP) { atomicAdd(&(bar)[XB_TMO], 1u); break; } } } } while (0)

struct XcdBarrier {
    unsigned* bar; unsigned x;
    volatile LAS unsigned* st;
};

__device__ __forceinline__ XcdBarrier xcd_barrier_post(unsigned* bar, volatile LAS unsigned* st, bool leader) {
    XcdBarrier b; b.bar = bar; b.x = xb_xcc_id(); b.st = st;
    if (leader) (void)xb_add(&bar[XB_XCNT(b.x)], 1u);
    return b;
}
__device__ __forceinline__ void xcd_barrier_complete(unsigned* bar, unsigned x, unsigned& nloc, unsigned& nx) {
    const unsigned G = gridDim.x * gridDim.y * gridDim.z;
    unsigned sum, cnt, mine, sp = 0u;
    for (;;) {
        sum = 0u; cnt = 0u; mine = 0u;
#pragma unroll
        for (unsigned j = 0; j < 16; ++j) { const unsigned c = xb_ld(&bar[XB_XCNT(j)]); sum += c; cnt += (c > 0u) ? 1u : 0u; mine = (j == x) ? c : mine; }
        if (sum == G) break;
        __builtin_amdgcn_s_sleep(1);
        if ((++sp & 255u) == 0u) { if (xb_ld(&bar[XB_TMO])) break; if (sp > XB_SPIN_CAP) { atomicAdd(&bar[XB_TMO], 1u); break; } }
    }
    nloc = mine > 0u ? mine : 1u; nx = cnt > 0u ? cnt : 1u;
}

__device__ __forceinline__ void xcd_barrier(const XcdBarrier& b, bool leader) {
    asm volatile("s_waitcnt vmcnt(0)" ::: "memory");
    __syncthreads();
    if (leader) {
        unsigned* bar = b.bar;
        __builtin_amdgcn_s_waitcnt(0);
        unsigned nloc = b.st[0], nx = b.st[1];
        if (nloc == 0u) { xcd_barrier_complete(bar, b.x, nloc, nx); b.st[0] = nloc; b.st[1] = nx; }
        const unsigned old = xb_add(&bar[XB_XSUB(b.x)], 1u);
        const unsigned gen = old / nloc;
        if (old + 1u == (gen + 1u) * nloc) {
            __builtin_amdgcn_fence(__ATOMIC_RELEASE, "agent");
            asm volatile("s_waitcnt vmcnt(0)" ::: "memory");
            const unsigned og = xb_add(&bar[XB_TOP], 1u);
            const unsigned tg = og / nx;
            if (og + 1u == (tg + 1u) * nx) xb_add(&bar[XB_TOPGEN], 1u);
            else XB_SPIN(xb_ld(&bar[XB_TOPGEN]) == tg, bar);
            __builtin_amdgcn_fence(__ATOMIC_ACQUIRE, "agent");
            xb_add(&bar[XB_XGEN(b.x)], 1u);
            asm volatile("s_waitcnt vmcnt(0)" ::: "memory");
        } else {
            XB_SPIN(xb_ld(&bar[XB_XGEN(b.x)]) == gen, bar);
            __builtin_amdgcn_fence(__ATOMIC_ACQUIRE, "agent");
            asm volatile("s_waitcnt vmcnt(0)" ::: "memory");
        }
    }
    __syncthreads();
}

#ifndef PHMASK
#define PHMASK 0xffff
#endif
#define PH(k) ((PHMASK >> (k)) & 1)
#ifndef PROBE
#define PROBE 0
#endif
#define GSYNC() do { XcdBarrier b_; b_.bar = (unsigned*)kargs()->ws; { unsigned x_ = bar_x; asm volatile("" : "+s"(x_)); b_.x = x_; } b_.st = (volatile LAS unsigned*)(lds + 131072); xcd_barrier(b_, TID() == 0); } while (0)
__global__ void __launch_bounds__(NTHREADS, 2) fwd_megakernel(Args A_byval) {
    extern __shared__ __attribute__((aligned(16))) unsigned char lds_raw[];
    LAS unsigned char* lds = (LAS unsigned char*)lds_raw;
    cg::grid_group grid = cg::this_grid();
    const int wid_s = __builtin_amdgcn_readfirstlane((int)threadIdx.x >> 6);
#define TID() (wid_s * 64 + lane_id_fresh())
    const int G = gridDim.x, bx = blockIdx.x;
    const int vcu = (G % 8 == 0) ? (bx % 8) * (G / 8) + bx / 8 : bx;
#define WAVE() wid_s
#define WSP(off) (kargs()->ws + (off))
#define INP(i) (kargs()->in[i])

    { const int t_ = TID(); if (t_ < 64) ((LAS unsigned*)(lds + 131072))[t_] = 0u; }
    __syncthreads();
    const unsigned bar_x = xcd_barrier_post((unsigned*)WSP(0), (volatile LAS unsigned*)(lds + 131072), TID() == 0).x;
    if (kargs()->ws == nullptr) grid.sync();

    if (PH(0)) p0_mod(lds, kargs(), TID());
    if (bx == G - 1) {
        float* RC = (float*)WSP(WS_ROPE);
        for (int idx = TID(); idx < 1024; idx += NTHREADS) {
            const int pos = idx >> 4, i = idx & 15;
            const float inv = exp2f(-(float)i * (13.287712379549449f / 16.f));
            float rev = (float)pos * inv * 0.15915494309189535f; rev -= floorf(rev);
            RC[idx] = __builtin_amdgcn_cosf(rev); RC[1024 + idx] = __builtin_amdgcn_sinf(rev);
        }
    }
    if (PH(1)) p0_weights(lds, kargs(), vcu * 8 + WAVE(), G * 8, WAVE(), (TID() & 63));
    GSYNC();
    bias_phase(lds, kargs(), bx, G, TID(), WAVE(), (TID() & 63));
    xa_phase(INP(0), INP(1) - (size_t)M_CTX * D, INP(8), (const float*)WSP(WS_MOD), 1, (bf16*)WSP(WS_H), (float*)WSP(WS_PSS), vcu * 8 + WAVE(), G * 8, (TID() & 63));
    GSYNC();

    for (int l = 0; l < 2; ++l) {
        for (int half = 0; half < 2; ++half) {
            if (PH(3)) {   pg8::Gemm g{(const bf16*)WSP(WS_H), (const bf16*)WSP(WS_W + (size_t)l * W_LAYER + (half ? W_GU2 : W_GU1)), M, NGU, D}; pg8::StaticOrder S; S.init(M, NGU, G, bx);
                EpiSwiglu E{WSP(0), l * 9 * NBIAS + (half ? BOFF_GU2 : BOFF_GU1)};
                pg8::gemm_phase<EpiSwiglu, pg8::StaticOrder, true, true>(lds, g, S, E, TID()); }
            GSYNC();
            if (PH(4)) {   const bool first = (l == 0 && half == 0);
                float* X = (float*)WSP(WS_X);
                const float* in_ctx = first ? INP(0) : X;
                const float* in_lat = first ? INP(1) - (size_t)M_CTX * D : X;
                const bool has_next = (half == 0) || (l == 0);
                const int ln = half == 0 ? l : l + 1;
                const float* gnext = has_next ? INP(8) + (size_t)(ln * 3 + (half == 0 ? 1 : 0)) * D : nullptr;
                const int sc_off = ln * 9 * NMOD + (half == 0 ? 4 : 1) * 1024;
                pg8::Gemm g{(const bf16*)WSP(WS_ACT), (const bf16*)WSP(WS_W + (size_t)l * W_LAYER + (half ? W_D2 : W_D1)), M, D, FF}; pg8::StaticOrder S; S.initmn(M / 192, D / 256, G, bx);
                EpiRes3 E{in_ctx, in_lat, WSP(0), gnext, l * 9 * NMOD + (half ? 8 : 2) * 1024, sc_off, 0.5f};
                pg8::gemm_phase<EpiRes3, pg8::StaticOrder, true, true, 3>(lds, g, S, E, TID()); }
            GSYNC();
            if (half == 0) {
                if (PH(5)) {   pg8::Gemm g{(const bf16*)WSP(WS_H), (const bf16*)WSP(WS_W + (size_t)l * W_LAYER + W_IN), M, NIN, D}; pg8::StaticOrder S; S.initmn(M / 192, NIN / 256, G, bx);
                    float* newk = kargs()->out + (size_t)M * D;
                    EpiWin3 E{WSP(0), newk, l};
                    pg8::gemm_phase<EpiWin3, pg8::StaticOrder, true, true, 3>(lds, g, S, E, TID()); }
                GSYNC();
                if (PH(6)) mixer_phase(lds, kargs(), l, vcu, G, TID(), WAVE(), (TID() & 63));
                if (PROBE == 3) mixer_phase(lds, kargs(), l, vcu, G, TID(), WAVE(), (TID() & 63));
                GSYNC();
                if (PH(7)) {   float* X = (float*)WSP(WS_X);
                    pg8::Gemm g{(const bf16*)WSP(WS_Y), (const bf16*)WSP(WS_W + (size_t)l * W_LAYER + W_OUT), M, D, D}; pg8::StaticOrder S; S.initmn(M / 192, D / 256, G, bx);
                    EpiRes3 E{X, X, WSP(0), INP(8) + (size_t)(l * 3 + 2) * D, l * 9 * NMOD + 5 * 1024, l * 9 * NMOD + 7 * 1024, 1.0f};
                    pg8::gemm_phase<EpiRes3, pg8::StaticOrder, true, true, 3>(lds, g, S, E, TID()); }
                GSYNC();
            }
        }
    }
    final_norm((const float*)WSP(WS_X), INP(20), kargs()->out, vcu * 8 + WAVE(), G * 8, (TID() & 63));
}

extern "C" void kernel_launch(void* const* d_in, const int* in_sizes, int n_in, void* d_out, int out_size, void* d_ws, size_t ws_size, hipStream_t stream) {
    static int grid = 0;
    if (grid == 0) {
        if (n_in != 21 || ws_size < WS_END2) { fprintf(stderr, "kernel_launch: need 21 inputs and >= %zu bytes of workspace; got %d, %zu\n", (size_t)WS_END2, n_in, ws_size); grid = -1; return; }
        int dev = 0, cus = 0, per_cu = 0;
        hipGetDevice(&dev);
        hipDeviceGetAttribute(&cus, hipDeviceAttributeMultiprocessorCount, dev);
        if (hipFuncSetAttribute((const void*)fwd_megakernel, hipFuncAttributeMaxDynamicSharedMemorySize, LDS_BYTES) != hipSuccess) { fprintf(stderr, "kernel_launch: hipFuncSetAttribute failed\n"); grid = -1; return; }
        if (hipOccupancyMaxActiveBlocksPerMultiprocessor(&per_cu, (const void*)fwd_megakernel, NTHREADS, LDS_BYTES) != hipSuccess || per_cu < 1) { fprintf(stderr, "kernel_launch: occupancy query gave %d\n", per_cu); per_cu = 1; }
        (void)hipGetLastError();
        grid = cus * per_cu;
    }
    if (grid < 0) return;
    if (hipMemsetAsync(d_ws, 0, 65536, stream) != hipSuccess) { fprintf(stderr, "kernel_launch: memset of barrier words failed\n"); return; }
    Args a{};
    for (int i = 0; i < 21; ++i) a.in[i] = (const float*)d_in[i];
    a.out = (float*)d_out; a.ws = (unsigned char*)d_ws;
    void* args[] = {&a};
    hipError_t e = hipLaunchCooperativeKernel((const void*)fwd_megakernel, dim3(grid), dim3(NTHREADS), args, LDS_BYTES, stream);
    if (e != hipSuccess) fprintf(stderr, "cooperative launch failed: %s (grid %d)\n", hipGetErrorString(e), grid);
}
```

```cpp
#include <hip/hip_runtime.h>
#include <hip/hip_cooperative_groups.h>
#include <cstdio>
#include <cstdint>
namespace cg = cooperative_groups;
namespace pg8 {
#define PG8_LAS __attribute__((address_space(3)))
typedef unsigned short bf16_t;
typedef short bf16x8 __attribute__((ext_vector_type(8)));
typedef float f32x4 __attribute__((ext_vector_type(4)));
typedef unsigned u32x4 __attribute__((ext_vector_type(4)));
constexpr int BM = 256, BK = 64, HALF = 128, HTB = HALF * BK * 2  , STAGE_BYTES = 8 * HTB, NXCD = 8, WGM = 8;

__host__ __device__ __forceinline__ int lds_byte(int r, int c) { const int st = (r >> 4) * 2 + (c >> 5), rr = r & 15, cc = c & 31, ob = rr * 64 + cc * 2; return st * 1024 + (ob ^ (((ob >> 9) & 1) << 5)); }
__host__ __device__ __forceinline__ void stage_rc(int b, int& R, int& C) { const int st = b / 1024, sb = b % 1024, swz = sb ^ (((sb >> 9) & 1) << 5); R = (st >> 1) * 16 + swz / 64; C = (st & 1) * 32 + (swz % 64) / 2; }
__host__ __device__ __forceinline__ int perm32(int rho) { const int n = rho >> 4, i = rho & 15; return 8 * (i >> 2) + 4 * n + (i & 3); }

struct Unit { int pm, pn; };
struct Gemm { const bf16_t* A; const bf16_t* Bt; int M, N, K; };

struct StaticOrder {
    int nM, nN, nwg, G, c;
    __host__ __device__ void init(int M, int N, int G_, int c_) { nM = M / BM; nN = N / BM; nwg = nM * nN; G = G_; c = c_; }
    __host__ __device__ void initmn(int nM_, int nN_, int G_, int c_) { nM = nM_; nN = nN_; nwg = nM * nN; G = G_; c = c_; }
    __host__ __device__ bool next(int i, Unit& u) const {
        const long L = (long)i * G + c; if (L >= nwg) return false;
        int wgid = (int)L; { const int q = nwg / NXCD, r = nwg % NXCD, xcd = wgid % NXCD, off = wgid / NXCD; wgid = (xcd < r ? xcd * (q + 1) : r * (q + 1) + (xcd - r) * q) + off; }
        const int nig = WGM * nN, gid = wgid / nig, fm = gid * WGM, gsz = (nM - fm) < WGM ? (nM - fm) : WGM;
        u.pm = fm + ((wgid % nig) % gsz); u.pn = (wgid % nig) / gsz; return true;
    }
    __device__ __forceinline__ void a_ready(const Unit&) const {}
    __device__ __forceinline__ void done(const Unit&) const {}
};

__device__ __forceinline__ unsigned cvt_pk_bf16(float lo, float hi) { unsigned r; asm volatile("v_cvt_pk_bf16_f32 %0, %1, %2" : "=v"(r) : "v"(lo), "v"(hi)); return r; }
typedef float f32x2 __attribute__((ext_vector_type(2)));
template <class Epi, class Sched, bool ALIGN_EPI = false, bool SP2 = false, int MB = 4>
__device__ __forceinline__ void gemm_phase(PG8_LAS unsigned char* lds, const Gemm g, const Sched& S, const Epi& E, int tid) {
    asm volatile("" : "+v"(tid));
    const int wid = __builtin_amdgcn_readfirstlane(tid >> 6), lane = tid & 63, wr = wid >> 2, wc = wid & 3, fr = lane & 15, fq = lane >> 4;
    const int K = g.K, nt = K / BK;
    const bool lightw = SP2 && MB == 3 && wid >= 6;
    unsigned voffA[2], voffB[2];
#pragma unroll
    for (int i = 0; i < 2; ++i) { int R, C; stage_rc(tid * 16 + i * 8192, R, C); const int Rb = Epi::PERM ? ((R & ~31) + perm32(R & 31)) : R;
        const int Ra = MB == 4 ? R : R - 16 * (R >> 6);
        voffA[i] = (unsigned)(Ra * K + C) * 2u; voffB[i] = (unsigned)(Rb * K + C) * 2u; }
    const size_t kstep = (size_t)(BK * 2);
    const size_t hstep = (size_t)HALF * K * 2;
    const size_t tstep = 2 * hstep;
    const size_t hstepA = (size_t)(32 * MB) * K * 2, tstepA = 2 * hstepA;
    const unsigned ldsw = (unsigned)wid * 1024u;
    const int aoff = lds_byte(wr * 64 + fr, fq * 8), boff = lds_byte(wc * 32 + fr, fq * 8);
#define PG8_SA(b, h) (((b) * 2 + (h)) * HTB)
#define PG8_SB(b, h) ((4 + (b) * 2 + (h)) * HTB)
#define PG8_STAGE(bufoff, gbase, voff) do { _Pragma("unroll") for (int _i = 0; _i < 2; ++_i) \
        __builtin_amdgcn_global_load_lds((const unsigned*)((const char*)(gbase) + (voff)[_i]), (PG8_LAS unsigned*)(lds + (bufoff) + ldsw + _i * 8192), 16, 0, 0); } while (0)
#define PG8_LDA(dst, b, h) do { _Pragma("unroll") for (int m = 0; m < MB; ++m) _Pragma("unroll") for (int k = 0; k < 2; ++k) dst[m][k] = *(const PG8_LAS bf16x8*)(lds + PG8_SA(b, h) + aoff + m * 2048 + k * 1024); } while (0)
#define PG8_LDB(dst, b, h) do { _Pragma("unroll") for (int n = 0; n < 2; ++n) _Pragma("unroll") for (int k = 0; k < 2; ++k) dst[n][k] = *(const PG8_LAS bf16x8*)(lds + PG8_SB(b, h) + boff + n * 2048 + k * 1024); } while (0)
#define PG8_MMA(ai, bj, At, Bt) do { __builtin_amdgcn_s_setprio(1); _Pragma("unroll") for (int m = 0; m < MB; ++m) _Pragma("unroll") for (int n = 0; n < 2; ++n) _Pragma("unroll") for (int k = 0; k < 2; ++k) \
        acc[ai][bj][m][n] = __builtin_amdgcn_mfma_f32_16x16x32_bf16(Bt[n][k], At[m][k], acc[ai][bj][m][n], 0, 0, 0); __builtin_amdgcn_s_setprio(0); } while (0)
#define PG8_WAIT_V(n) asm volatile("s_waitcnt vmcnt(" #n ")" ::: "memory")
#define PG8_STAGE_A(bufoff, gbase, voff) do { if (!lightw) PG8_STAGE(bufoff, gbase, voff); } while (0)
#define PG8_WAIT_VL(n, nl) do { if (lightw) asm volatile("s_waitcnt vmcnt(" #nl ")" ::: "memory"); else asm volatile("s_waitcnt vmcnt(" #n ")" ::: "memory"); } while (0)
#define PG8_WAIT_L(n) asm volatile("s_waitcnt lgkmcnt(" #n ")" ::: "memory")
#define PG8_BAR __builtin_amdgcn_s_barrier()
#define PG8_SCHED __builtin_amdgcn_sched_barrier(0)
    Unit cur, nxt; int ui = 0;
    if (!S.next(0, cur)) return;
    PG8_LAS float* tabs = (PG8_LAS float*)(lds + STAGE_BYTES + 1024);
    if constexpr (Epi::HAS_TAB) { typename Epi::Pre p0_ = E.pre_load(cur, tid); E.pre_store(p0_, tabs, tid); }
    f32x4 acc[2][2][4][2];
#pragma unroll
    for (int a = 0; a < 2; ++a)
#pragma unroll
        for (int b = 0; b < 2; ++b)
#pragma unroll
            for (int m = 0; m < 4; ++m)
#pragma unroll
                for (int n = 0; n < 2; ++n) acc[a][b][m][n] = (f32x4){0.f, 0.f, 0.f, 0.f};
    bf16x8 At[4][2], B0[2][2], B1[2][2];
    const char* cA = (const char*)g.A + (size_t)cur.pm * tstepA; const char* cB = (const char*)g.Bt + (size_t)cur.pn * tstep;
    S.a_ready(cur);
    if constexpr (SP2) {
        PG8_STAGE(PG8_SB(0, 0), cB, voffB); PG8_STAGE(PG8_SB(0, 1), cB + hstep, voffB); PG8_STAGE_A(PG8_SA(0, 0), cA, voffA); PG8_STAGE_A(PG8_SA(0, 1), cA + hstepA, voffA);
        if (wr == 1) PG8_BAR;
        PG8_WAIT_VL(2, 0); PG8_BAR;
        PG8_STAGE(PG8_SB(1, 0), cB + kstep, voffB); PG8_STAGE_A(PG8_SA(1, 0), cA + kstep, voffA); PG8_STAGE(PG8_SB(1, 1), cB + hstep + kstep, voffB);
        PG8_WAIT_VL(6, 4); PG8_BAR;
    } else {
        PG8_STAGE(PG8_SB(0, 0), cB, voffB); PG8_STAGE(PG8_SA(0, 0), cA, voffA); PG8_STAGE(PG8_SB(0, 1), cB + hstep, voffB); PG8_STAGE(PG8_SA(0, 1), cA + hstepA, voffA);
        if (wr == 1) PG8_BAR;
        PG8_WAIT_V(4); PG8_BAR;
        PG8_STAGE(PG8_SB(1, 0), cB + kstep, voffB); PG8_STAGE(PG8_SA(1, 0), cA + kstep, voffA); PG8_STAGE(PG8_SB(1, 1), cB + hstep + kstep, voffB);
        PG8_WAIT_V(6); PG8_BAR;
    }
    for (;;) {
        const bool has_next = S.next(ui + 1, nxt);
        const char* nA = has_next ? (const char*)g.A + (size_t)nxt.pm * tstepA : cA; const char* nB = has_next ? (const char*)g.Bt + (size_t)nxt.pn * tstep : cB;
        for (int t = 0; t < nt; t += 2) {
            const bool last = (t == nt - 2);
            const char* a1 = cA + (size_t)(t + 1) * kstep;
            const char* a2 = last ? nA : cA + (size_t)(t + 2) * kstep; const char* b2 = last ? nB : cB + (size_t)(t + 2) * kstep;
            const char* a3 = a2 + kstep; const char* b3 = b2 + kstep;
            if (last && has_next) S.a_ready(nxt);
            if constexpr (SP2) {
            PG8_LDB(B0, 0, 0); PG8_LDB(B1, 0, 1); PG8_SCHED; PG8_LDA(At, 0, 0); PG8_STAGE_A(PG8_SA(1, 1), a1 + hstepA, voffA);
            PG8_WAIT_VL(8, 4); PG8_WAIT_L(0); PG8_BAR; PG8_MMA(0, 0, At, B0); PG8_MMA(0, 1, At, B1); PG8_BAR; PG8_SCHED;
            PG8_LDA(At, 0, 1); PG8_STAGE(PG8_SB(0, 0), b2, voffB); PG8_STAGE(PG8_SB(0, 1), b2 + hstep, voffB); PG8_STAGE_A(PG8_SA(0, 0), a2, voffA);
            PG8_WAIT_VL(8, 4); PG8_WAIT_L(0); PG8_BAR; PG8_MMA(1, 0, At, B0); PG8_MMA(1, 1, At, B1); PG8_BAR; PG8_SCHED;
            PG8_LDB(B0, 1, 0); PG8_LDB(B1, 1, 1); PG8_SCHED; PG8_LDA(At, 1, 0); PG8_STAGE_A(PG8_SA(0, 1), a2 + hstepA, voffA);
            PG8_WAIT_VL(8, 4); PG8_WAIT_L(0); PG8_BAR; PG8_MMA(0, 0, At, B0); PG8_MMA(0, 1, At, B1); PG8_BAR; PG8_SCHED;
            PG8_LDA(At, 1, 1); PG8_STAGE(PG8_SB(1, 0), b3, voffB); PG8_STAGE(PG8_SB(1, 1), b3 + hstep, voffB); PG8_STAGE_A(PG8_SA(1, 0), a3, voffA);
            PG8_WAIT_VL(8, 4); PG8_WAIT_L(0); PG8_BAR; PG8_MMA(1, 0, At, B0); PG8_MMA(1, 1, At, B1); PG8_BAR; PG8_SCHED;
            } else {
            PG8_LDB(B0, 0, 0); PG8_SCHED; PG8_LDA(At, 0, 0); PG8_STAGE(PG8_SA(1, 1), a1 + hstepA, voffA);
            PG8_WAIT_L(8); PG8_BAR; PG8_WAIT_L(0); PG8_MMA(0, 0, At, B0); PG8_BAR; PG8_SCHED;
            PG8_LDB(B1, 0, 1); PG8_STAGE(PG8_SB(0, 0), b2, voffB);
            PG8_BAR; PG8_WAIT_L(0); PG8_MMA(0, 1, At, B1); PG8_BAR;
            PG8_LDA(At, 0, 1); PG8_STAGE(PG8_SA(0, 0), a2, voffA);
            PG8_BAR; PG8_WAIT_L(0); PG8_MMA(1, 0, At, B0); PG8_BAR; PG8_SCHED;
            PG8_STAGE(PG8_SB(0, 1), b2 + hstep, voffB);
            PG8_WAIT_V(6); PG8_BAR; PG8_MMA(1, 1, At, B1); PG8_BAR;
            PG8_LDB(B0, 1, 0); PG8_SCHED; PG8_LDA(At, 1, 0); PG8_STAGE(PG8_SA(0, 1), a2 + hstepA, voffA);
            PG8_WAIT_L(8); PG8_BAR; PG8_WAIT_L(0); PG8_MMA(0, 0, At, B0); PG8_BAR; PG8_SCHED;
            PG8_LDB(B1, 1, 1); PG8_STAGE(PG8_SB(1, 0), b3, voffB);
            PG8_BAR; PG8_WAIT_L(0); PG8_MMA(0, 1, At, B1); PG8_BAR;
            PG8_LDA(At, 1, 1); PG8_STAGE(PG8_SA(1, 0), a3, voffA);
            PG8_BAR; PG8_WAIT_L(0); PG8_MMA(1, 0, At, B0); PG8_BAR; PG8_SCHED;
            PG8_STAGE(PG8_SB(1, 1), b3 + hstep, voffB);
            PG8_WAIT_V(6); PG8_BAR; PG8_MMA(1, 1, At, B1); PG8_BAR;
            }
        }
        if constexpr (ALIGN_EPI) { if (wr == 0) PG8_BAR; }
        if constexpr (Epi::HAS_TAB) {
            typename Epi::Pre pn_; if (has_next) pn_ = E.pre_load(nxt, tid);
            E(acc, cur, wr, wc, fr, fq, tabs + (ui & 1) * Epi::TABSZ);
            if (has_next) E.pre_store(pn_, tabs + ((ui + 1) & 1) * Epi::TABSZ, tid);
            S.done(cur);
        } else
        if constexpr (!Epi::AFTER_DRAIN) { E(acc, cur, wr, wc, fr, fq); S.done(cur); }
        if (!has_next) break;
#pragma unroll
        for (int a = 0; a < 2; ++a)
#pragma unroll
            for (int b = 0; b < 2; ++b)
#pragma unroll
                for (int m = 0; m < 4; ++m)
#pragma unroll
                    for (int n = 0; n < 2; ++n) acc[a][b][m][n] = (f32x4){0.f, 0.f, 0.f, 0.f};
        cur = nxt; cA = nA; cB = nB; ++ui;
        if constexpr (ALIGN_EPI) { if (wr == 1) PG8_BAR; }
    }
    PG8_WAIT_V(0);
    if constexpr (!ALIGN_EPI) { if (wr == 0) PG8_BAR; }
    PG8_BAR;
    if constexpr (Epi::AFTER_DRAIN) { E.fused(acc, cur, wr, wc, fr, fq, lds, wid, lane); S.done(cur); }
#undef PG8_SA
#undef PG8_SB
#undef PG8_STAGE
#undef PG8_LDA
#undef PG8_LDB
#undef PG8_MMA
#undef PG8_WAIT_V
#undef PG8_WAIT_VL
#undef PG8_STAGE_A
#undef PG8_WAIT_L
#undef PG8_BAR
#undef PG8_SCHED
}
}

constexpr int D = 1024, FF = 2816, NGU = 5632, NIN = 2816;
constexpr int M_CTX = 4096, M = 12288;
constexpr int NMOD = 9216;
constexpr size_t MiB = 1u << 20;
constexpr size_t WS_MOD = 1 * MiB, WS_ROPE = 1 * MiB + 768 * 1024, WS_W = 2 * MiB;
constexpr size_t W_GU1 = 0, W_D1 = 11534336, W_IN = 17301504, W_OUT = 23068672, W_GU2 = 25165824, W_D2 = 36700160, W_LAYER = 42467328;
constexpr size_t WS_X = WS_W + 2 * W_LAYER;
constexpr size_t WS_H = WS_X + (size_t)M * D * 4;
constexpr size_t WS_Y = WS_H + (size_t)M * D * 2;
constexpr size_t WS_ACT = WS_Y + (size_t)M * D * 2;
constexpr size_t WS_END = WS_ACT + (size_t)M * FF * 2;
constexpr size_t WS_BIAS = WS_END;
constexpr int NBIAS = NGU + NIN + NGU, BOFF_GU1 = 0, BOFF_IN = NGU, BOFF_GU2 = NGU + NIN;
constexpr size_t WS_PSS = WS_BIAS + (size_t)2 * 9 * NBIAS * 4;
constexpr size_t WS_END2 = WS_PSS + (size_t)M * 16 * 4;
constexpr int LDS_BYTES = 147456;
constexpr int NTHREADS = 512;

#define LAS __attribute__((address_space(3)))
typedef unsigned short bf16;
typedef unsigned v4u __attribute__((ext_vector_type(4)));
typedef unsigned v2u __attribute__((ext_vector_type(2)));
typedef float f32x4 __attribute__((ext_vector_type(4)));
typedef short bf16x8 __attribute__((ext_vector_type(8)));
typedef short s16x4 __attribute__((ext_vector_type(4)));

struct Args { const float* in[21]; float* out; unsigned char* ws; };
typedef const __attribute__((address_space(4))) Args* KArgs;
__device__ __forceinline__ int lane_id_fresh() { int l; asm volatile("v_mbcnt_lo_u32_b32 %0, -1, 0\n\tv_mbcnt_hi_u32_b32 %0, -1, %0" : "=v"(l)); return l; }
__device__ __forceinline__ KArgs kargs() { KArgs p = (KArgs)__builtin_amdgcn_kernarg_segment_ptr(); asm volatile("" : "+s"(p)); return p; }

__device__ __forceinline__ unsigned pk2(float lo, float hi) { return pg8::cvt_pk_bf16(lo, hi); }
__device__ __forceinline__ v4u pack8(f32x4 a, f32x4 b) { v4u w; w.x = pk2(a[0], a[1]); w.y = pk2(a[2], a[3]); w.z = pk2(b[0], b[1]); w.w = pk2(b[2], b[3]); return w; }
__device__ __forceinline__ float bflo(unsigned u) { return __uint_as_float(u << 16); }
__device__ __forceinline__ float bfhi(unsigned u) { return __uint_as_float(u & 0xffff0000u); }
__device__ __forceinline__ float wave_sum(float v) {
#pragma unroll
    for (int o = 1; o < 64; o <<= 1) v += __shfl_xor(v, o);
    return v;
}
__device__ __forceinline__ float xmax16_32(float v) {
    auto a = __builtin_amdgcn_permlane16_swap(__float_as_uint(v), __float_as_uint(v), false, false); v = fmaxf(__uint_as_float(a[0]), __uint_as_float(a[1]));
    auto b = __builtin_amdgcn_permlane32_swap(__float_as_uint(v), __float_as_uint(v), false, false); return fmaxf(__uint_as_float(b[0]), __uint_as_float(b[1]));
}
__device__ __forceinline__ float xsum16_32(float v) {
    auto a = __builtin_amdgcn_permlane16_swap(__float_as_uint(v), __float_as_uint(v), false, false); v = __uint_as_float(a[0]) + __uint_as_float(a[1]);
    auto b = __builtin_amdgcn_permlane32_swap(__float_as_uint(v), __float_as_uint(v), false, false); return __uint_as_float(b[0]) + __uint_as_float(b[1]);
}
__device__ __forceinline__ float silu_f(float x) { return x * __builtin_amdgcn_rcpf(1.f + __builtin_amdgcn_exp2f(-1.4426950408889634f * x)); }

__device__ __forceinline__ void load_rstd(const float* PSS, int row0, int fq, float (&rstd)[2][4]) {
#pragma unroll
    for (int ai = 0; ai < 2; ++ai)
#pragma unroll
        for (int m = 0; m < 4; ++m) {
            const f32x4 t = *((const f32x4*)(PSS + (unsigned)(row0 + ai * 128 + m * 16) * 16) + fq);
            rstd[ai][m] = (t[0] + t[1]) + (t[2] + t[3]);
        }
#pragma unroll
    for (int ai = 0; ai < 2; ++ai)
#pragma unroll
        for (int m = 0; m < 4; ++m) {
            float q = rstd[ai][m]; q += __shfl_xor(q, 16); q += __shfl_xor(q, 32);
            rstd[ai][m] = 1.f / sqrtf(q * (1.f / D) + 1e-6f);
        }
}
struct TabPre { f32x4 a, b, c, d; };
__device__ __forceinline__ TabPre tab_pre_load(const unsigned char* ws, int bias_off, const pg8::Unit& u, int tid) {
    TabPre p;
    if (tid < 256) { const f32x4* pp = (const f32x4*)((const float*)(ws + WS_PSS) + (unsigned)(u.pm * 256 + tid) * 16); p.a = pp[0]; p.b = pp[1]; p.c = pp[2]; p.d = pp[3]; }
    else { const int cond = u.pm < 16 ? 0 : 1 + ((u.pm - 16) >> 2);
        p.a[0] = ((const float*)(ws + WS_BIAS))[(unsigned)(bias_off + cond * NBIAS + u.pn * 256 + (tid - 256))]; p.b = p.a; p.c = p.a; p.d = p.a; }
    return p;
}
__device__ __forceinline__ void tab_pre_store(const TabPre& p, LAS float* tab, int tid) {
    if (tid < 256) { const f32x4 t = (p.a + p.b) + (p.c + p.d); tab[tid] = 1.f / sqrtf(((t[0] + t[1]) + (t[2] + t[3])) * (1.f / D) + 1e-6f); }
    else tab[tid] = p.a[0];
}
struct EpiSwiglu {
    static constexpr bool PERM = true, AFTER_DRAIN = false, HAS_TAB = true; static constexpr int TABSZ = 512;
    typedef TabPre Pre;
    unsigned char* ws; int bias_off;
    __device__ __forceinline__ Pre pre_load(const pg8::Unit& u, int tid) const { return tab_pre_load(ws, bias_off, u, tid); }
    __device__ __forceinline__ void pre_store(const Pre& p, LAS float* tab, int tid) const { tab_pre_store(p, tab, tid); }
    __device__ __forceinline__ void operator()(const f32x4 (&acc)[2][2][4][2], const pg8::Unit& u, int wr, int wc, int fr, int fq, const LAS float* tab) const {
        bf16* ACT = (bf16*)(ws + WS_ACT);
        const int row0 = u.pm * 256 + wr * 64 + fr, j0 = u.pn * 128 + wc * 32 + 8 * fq;
        const LAS float* bp = tab + 256 + wc * 32 + 8 * fq;
        const f32x4 bg0 = *(const LAS f32x4*)bp, bg1 = *(const LAS f32x4*)(bp + 4), bu0 = *(const LAS f32x4*)(bp + 128), bu1 = *(const LAS f32x4*)(bp + 132);
#pragma unroll
        for (int ai = 0; ai < 2; ++ai)
#pragma unroll
            for (int m = 0; m < 4; ++m) {
                bf16* p = ACT + (unsigned)((row0 + ai * 128 + m * 16) * FF + j0);
                const float r = tab[wr * 64 + ai * 128 + m * 16 + fr];
                const f32x4 g0 = acc[ai][0][m][0] * r + bg0, g1 = acc[ai][0][m][1] * r + bg1, u0 = acc[ai][1][m][0] * r + bu0, u1 = acc[ai][1][m][1] * r + bu1;
                f32x4 o0, o1;
#pragma unroll
                for (int e = 0; e < 4; ++e) { o0[e] = silu_f(g0[e]) * u0[e]; o1[e] = silu_f(g1[e]) * u1[e]; }
                *(v4u*)p = pack8(o0, o1);
            }
    }
};
struct EpiRes {
    static constexpr bool PERM = true, AFTER_DRAIN = false, HAS_TAB = false;
    const float* in_ctx; const float* in_lat; unsigned char* ws; const float* gnext; int gate_off, sc_off; float gs;
    __device__ __forceinline__ void operator()(const f32x4 (&acc)[2][2][4][2], const pg8::Unit& u, int wr, int wc, int fr, int fq) const {
        const int cond = u.pm < 16 ? 0 : 1 + ((u.pm - 16) >> 2);
        float* out = (float*)(ws + WS_X); bf16* XA = (bf16*)(ws + WS_H); float* PSS = (float*)(ws + WS_PSS);
        const float* gp = (const float*)(ws + WS_MOD) + gate_off + (unsigned)cond * NMOD;
        const float* scp = (const float*)(ws + WS_MOD) + sc_off + (unsigned)cond * NMOD;
        const float* base = u.pm < 16 ? in_ctx : in_lat;
        const int row0 = u.pm * 256 + wr * 64 + fr, col0 = u.pn * 256 + wc * 32 + 8 * fq;
        float ss[2][4];
#pragma unroll
        for (int bj = 0; bj < 2; ++bj) {
            const int cb = col0 + bj * 128;
            const f32x4 gv0 = *(const f32x4*)(gp + cb) * gs, gv1 = *(const f32x4*)(gp + cb + 4) * gs;
            f32x4 an0 = (f32x4){0.f, 0.f, 0.f, 0.f}, an1 = an0;
            if (gnext) { an0 = *(const f32x4*)(gnext + cb) * (*(const f32x4*)(scp + cb) + 1.f); an1 = *(const f32x4*)(gnext + cb + 4) * (*(const f32x4*)(scp + cb + 4) + 1.f); }
#pragma unroll
            for (int ai = 0; ai < 2; ++ai)
#pragma unroll
                for (int m = 0; m < 4; ++m) {
                    const unsigned off = (unsigned)(row0 + ai * 128 + m * 16) * D + cb;
                    const f32x4 b0 = *(const f32x4*)(base + off), b1 = *(const f32x4*)(base + off + 4);
                    const f32x4 o0 = b0 + gv0 * acc[ai][bj][m][0], o1 = b1 + gv1 * acc[ai][bj][m][1];
                    *(f32x4*)(out + off) = o0; *(f32x4*)(out + off + 4) = o1;
                    if (gnext) {
                        const float q = ((o0[0] * o0[0] + o0[1] * o0[1]) + (o0[2] * o0[2] + o0[3] * o0[3])) + ((o1[0] * o1[0] + o1[1] * o1[1]) + (o1[2] * o1[2] + o1[3] * o1[3]));
                        ss[ai][m] = bj == 0 ? q : ss[ai][m] + q;
                        *(v4u*)(XA + off) = pack8(o0 * an0, o1 * an1);
                    }
                    if (m & 1) asm volatile("" ::: "memory");
                }
        }
        if (gnext) {
#pragma unroll
            for (int ai = 0; ai < 2; ++ai)
#pragma unroll
                for (int m = 0; m < 4; ++m) {
                    const float q = xsum16_32(ss[ai][m]);
                    if (fq == 0) PSS[(unsigned)(row0 + ai * 128 + m * 16) * 16 + u.pn * 4 + wc] = q;
                }
        }
    }
};
struct EpiRes3 {
    static constexpr bool PERM = true, AFTER_DRAIN = false, HAS_TAB = false;
    const float* in_ctx; const float* in_lat; unsigned char* ws; const float* gnext; int gate_off, sc_off; float gs;
    __device__ __forceinline__ void operator()(const f32x4 (&acc)[2][2][4][2], const pg8::Unit& u, int wr, int wc, int fr, int fq) const {
        float* out = (float*)(ws + WS_X); bf16* XA = (bf16*)(ws + WS_H); float* PSS = (float*)(ws + WS_PSS);
        const float* gp0 = (const float*)(ws + WS_MOD) + gate_off;
        const float* scp0 = (const float*)(ws + WS_MOD) + sc_off;
        const int rb0 = u.pm * 192 + wr * 48, col0 = u.pn * 256 + wc * 32 + 8 * fq;
        float ss[2][3];
#pragma unroll
        for (int bj = 0; bj < 2; ++bj) {
            const int cb = col0 + bj * 128;
            f32x4 gn0 = (f32x4){0.f, 0.f, 0.f, 0.f}, gn1 = gn0;
            if (gnext) { gn0 = *(const f32x4*)(gnext + cb); gn1 = *(const f32x4*)(gnext + cb + 4); }
#pragma unroll
            for (int ai = 0; ai < 2; ++ai)
#pragma unroll
                for (int m = 0; m < 3; ++m) {
                    const int rb = rb0 + ai * 96 + m * 16;
                    const int cond = rb < M_CTX ? 0 : 1 + ((rb - M_CTX) >> 10);
                    const float* base = rb < M_CTX ? in_ctx : in_lat;
                    const float* gp = gp0 + (unsigned)(cond * NMOD + cb);
                    const f32x4 gv0 = *(const f32x4*)gp * gs, gv1 = *(const f32x4*)(gp + 4) * gs;
                    const unsigned off = (unsigned)((rb + fr) * D + cb);
                    const f32x4 b0 = *(const f32x4*)(base + off), b1 = *(const f32x4*)(base + off + 4);
                    const f32x4 o0 = b0 + gv0 * acc[ai][bj][m][0], o1 = b1 + gv1 * acc[ai][bj][m][1];
                    *(f32x4*)(out + off) = o0; *(f32x4*)(out + off + 4) = o1;
                    if (gnext) {
                        const float* sp = scp0 + (unsigned)(cond * NMOD + cb);
                        const f32x4 an0 = gn0 * (*(const f32x4*)sp + 1.f), an1 = gn1 * (*(const f32x4*)(sp + 4) + 1.f);
                        const float q = ((o0[0] * o0[0] + o0[1] * o0[1]) + (o0[2] * o0[2] + o0[3] * o0[3])) + ((o1[0] * o1[0] + o1[1] * o1[1]) + (o1[2] * o1[2] + o1[3] * o1[3]));
                        ss[ai][m] = bj == 0 ? q : ss[ai][m] + q;
                        *(v4u*)(XA + off) = pack8(o0 * an0, o1 * an1);
                    }
                }
        }
        if (gnext) {
#pragma unroll
            for (int ai = 0; ai < 2; ++ai)
#pragma unroll
                for (int m = 0; m < 3; ++m) {
                    const float q = xsum16_32(ss[ai][m]);
                    if (fq == 0) PSS[(unsigned)(rb0 + ai * 96 + m * 16 + fr) * 16 + u.pn * 4 + wc] = q;
                }
        }
    }
};
struct EpiWin {
    static constexpr bool PERM = true, AFTER_DRAIN = false, HAS_TAB = true; static constexpr int TABSZ = 512;
    typedef TabPre Pre;
    unsigned char* ws; float* newk; int layer;
    __device__ __forceinline__ Pre pre_load(const pg8::Unit& u, int tid) const { return tab_pre_load(ws, layer * 9 * NBIAS + BOFF_IN, u, tid); }
    __device__ __forceinline__ void pre_store(const Pre& p, LAS float* tab, int tid) const { tab_pre_store(p, tab, tid); }
    __device__ __forceinline__ void operator()(const f32x4 (&acc)[2][2][4][2], const pg8::Unit& u, int wr, int wc, int fr, int fq, const LAS float* tab) const {
        bf16* Z = (bf16*)(ws + WS_ACT); float* newv = newk + 16 * 2 * 4 * 256 * 128;
        const float* rc = (const float*)(ws + WS_ROPE); const float* rs = rc + 1024;
        const int pn = u.pn, pm = u.pm; const bool lat = pm >= 16;
        const int row0 = pm * 256 + wr * 64 + fr;
        const LAS float* bp = tab + 256 + wc * 32 + 8 * fq;
        const LAS float* rp = tab + wr * 64 + fr;
#define WIN_BV() const f32x4 bv00 = *(const LAS f32x4*)bp, bv01 = *(const LAS f32x4*)(bp + 4), bv10 = *(const LAS f32x4*)(bp + 128), bv11 = *(const LAS f32x4*)(bp + 132)
        if (pn < 4) {
            const int lc = 256 * pn + 64 * wc + 8 * fq;
#pragma unroll
            for (int ai = 0; ai < 2; ++ai)
#pragma unroll
                for (int m = 0; m < 4; ++m) {
                    const int row = row0 + ai * 128 + m * 16; const float r = rp[ai * 128 + m * 16]; WIN_BV();
                    f32x4 a0 = acc[ai][0][m][0] * r + bv00, a1 = acc[ai][0][m][1] * r + bv01, b0 = acc[ai][1][m][0] * r + bv10, b1 = acc[ai][1][m][1] * r + bv11;
                    if (lat) {
                        const int t = (row - M_CTX) & 1023; const int pos = fq < 2 ? (t >> 6) : (t & 63);
                        const float* cp = rc + pos * 16 + 8 * (fq & 1); const float* sp = rs + pos * 16 + 8 * (fq & 1);
                        const f32x4 c0 = *(const f32x4*)cp, c1 = *(const f32x4*)(cp + 4), s0 = *(const f32x4*)sp, s1 = *(const f32x4*)(sp + 4);
                        const f32x4 na0 = a0 * c0 - b0 * s0, na1 = a1 * c1 - b1 * s1, nb0 = b0 * c0 + a0 * s0, nb1 = b1 * c1 + a1 * s1;
                        a0 = na0; a1 = na1; b0 = nb0; b1 = nb1;
                    }
                    bf16* zp = Z + (unsigned)(row * NIN + lc);
                    *(v4u*)zp = pack8(a0, a1); *(v4u*)(zp + 32) = pack8(b0, b1);
                    if (!lat && pn >= 2) {
                        const int kc = lc - 512, hh = kc >> 7, dd = kc & 127;
                        float* kp = newk + (unsigned)((((pm * 2 + layer) * 4 + hh) * 256 + (row & 255)) * 128 + dd);
                        *(f32x4*)kp = a0; *(f32x4*)(kp + 4) = a1; *(f32x4*)(kp + 32) = b0; *(f32x4*)(kp + 36) = b1;
                    }
                    asm volatile("" ::: "memory");
                }
        } else {
            const int col = 256 * pn + 32 * wc + 8 * fq;
#pragma unroll
            for (int ai = 0; ai < 2; ++ai)
#pragma unroll
                for (int m = 0; m < 4; ++m) {
                    const int row = row0 + ai * 128 + m * 16; const float r = rp[ai * 128 + m * 16]; WIN_BV();
                    const f32x4 a0 = acc[ai][0][m][0] * r + bv00, a1 = acc[ai][0][m][1] * r + bv01, b0 = acc[ai][1][m][0] * r + bv10, b1 = acc[ai][1][m][1] * r + bv11;
                    bf16* zp = Z + (unsigned)(row * NIN + col);
                    *(v4u*)zp = pack8(a0, a1); *(v4u*)(zp + 128) = pack8(b0, b1);
                    if (!lat && pn < 6) {
                        const int vc = col - 1024, hh = vc >> 7, dd = vc & 127;
                        float* vp = newv + (unsigned)((((pm * 2 + layer) * 4 + hh) * 256 + (row & 255)) * 128 + dd);
                        *(f32x4*)vp = a0; *(f32x4*)(vp + 4) = a1; *(f32x4*)(vp + 256 * 128) = b0; *(f32x4*)(vp + 256 * 128 + 4) = b1;
                    }
                    asm volatile("" ::: "memory");
                }
        }
    }
};

__device__ __forceinline__ int cond_of_row(int r) { return r < M_CTX ? 0 : 1 + ((r - M_CTX) >> 10); }
__device__ __forceinline__ TabPre tab_pre_load3(const unsigned char* ws, int bias_off, const pg8::Unit& u, int tid) {
    TabPre p;
    if (tid < 256) { const int t = tid < 192 ? tid : 191; const f32x4* pp = (const f32x4*)((const float*)(ws + WS_PSS) + (unsigned)(u.pm * 192 + t) * 16); p.a = pp[0]; p.b = pp[1]; p.c = pp[2]; p.d = pp[3]; }
    else { const float* bb = (const float*)(ws + WS_BIAS) + (unsigned)(bias_off + u.pn * 256 + (tid - 256));
        p.a[0] = bb[(unsigned)(cond_of_row(u.pm * 192) * NBIAS)]; p.b = p.a; p.b[0] = bb[(unsigned)(cond_of_row(u.pm * 192 + 191) * NBIAS)]; p.c = p.a; p.d = p.a; }
    return p;
}
__device__ __forceinline__ void tab_pre_store3(const TabPre& p, LAS float* tab, int tid) {
    if (tid < 256) { if (tid < 192) { const f32x4 t = (p.a + p.b) + (p.c + p.d); tab[tid] = 1.f / sqrtf(((t[0] + t[1]) + (t[2] + t[3])) * (1.f / D) + 1e-6f); } }
    else { tab[tid] = p.a[0]; tab[tid + 256] = p.b[0]; }
}
struct EpiWin3 {
    static constexpr bool PERM = true, AFTER_DRAIN = false, HAS_TAB = true; static constexpr int TABSZ = 768;
    typedef TabPre Pre;
    unsigned char* ws; float* newk; int layer;
    __device__ __forceinline__ Pre pre_load(const pg8::Unit& u, int tid) const { return tab_pre_load3(ws, layer * 9 * NBIAS + BOFF_IN, u, tid); }
    __device__ __forceinline__ void pre_store(const Pre& p, LAS float* tab, int tid) const { tab_pre_store3(p, tab, tid); }
    __device__ __forceinline__ void operator()(const f32x4 (&acc)[2][2][4][2], const pg8::Unit& u, int wr, int wc, int fr, int fq, const LAS float* tab) const {
        bf16* Z = (bf16*)(ws + WS_ACT); float* newv = newk + 16 * 2 * 4 * 256 * 128;
        const float* rc = (const float*)(ws + WS_ROPE); const float* rs = rc + 1024;
        const int pn = u.pn;
        const int rb0 = u.pm * 192 + wr * 48, cond_lo = cond_of_row(u.pm * 192);
        const LAS float* bp0 = tab + 256 + wc * 32 + 8 * fq;
        const LAS float* rp = tab + wr * 48 + fr;
#define WIN3_BV() const LAS float* bp = bp0 + (cond_of_row(rb) != cond_lo ? 256 : 0); const f32x4 bv00 = *(const LAS f32x4*)bp, bv01 = *(const LAS f32x4*)(bp + 4), bv10 = *(const LAS f32x4*)(bp + 128), bv11 = *(const LAS f32x4*)(bp + 132)
        if (pn < 4) {
            const int lc = 256 * pn + 64 * wc + 8 * fq;
#pragma unroll
            for (int ai = 0; ai < 2; ++ai)
#pragma unroll
                for (int m = 0; m < 3; ++m) {
                    const int rb = rb0 + ai * 96 + m * 16, row = rb + fr; const bool lat = rb >= M_CTX;
                    const float r = rp[ai * 96 + m * 16]; WIN3_BV();
                    f32x4 a0 = acc[ai][0][m][0] * r + bv00, a1 = acc[ai][0][m][1] * r + bv01, b0 = acc[ai][1][m][0] * r + bv10, b1 = acc[ai][1][m][1] * r + bv11;
                    if (lat) {
                        const int t = (row - M_CTX) & 1023; const int pos = fq < 2 ? (t >> 6) : (t & 63);
                        const float* cp = rc + pos * 16 + 8 * (fq & 1); const float* sp = rs + pos * 16 + 8 * (fq & 1);
                        const f32x4 c0 = *(const f32x4*)cp, c1 = *(const f32x4*)(cp + 4), s0 = *(const f32x4*)sp, s1 = *(const f32x4*)(sp + 4);
                        const f32x4 na0 = a0 * c0 - b0 * s0, na1 = a1 * c1 - b1 * s1, nb0 = b0 * c0 + a0 * s0, nb1 = b1 * c1 + a1 * s1;
                        a0 = na0; a1 = na1; b0 = nb0; b1 = nb1;
                    }
                    bf16* zp = Z + (unsigned)(row * NIN + lc);
                    *(v4u*)zp = pack8(a0, a1); *(v4u*)(zp + 32) = pack8(b0, b1);
                    if (!lat && pn >= 2) {
                        const int kc = lc - 512, hh = kc >> 7, dd = kc & 127;
                        float* kp = newk + (unsigned)(((((row >> 8) * 2 + layer) * 4 + hh) * 256 + (row & 255)) * 128 + dd);
                        *(f32x4*)kp = a0; *(f32x4*)(kp + 4) = a1; *(f32x4*)(kp + 32) = b0; *(f32x4*)(kp + 36) = b1;
                    }
                    asm volatile("" ::: "memory");
                }
        } else {
            const int col = 256 * pn + 32 * wc + 8 * fq;
#pragma unroll
            for (int ai = 0; ai < 2; ++ai)
#pragma unroll
                for (int m = 0; m < 3; ++m) {
                    const int rb = rb0 + ai * 96 + m * 16, row = rb + fr; const bool lat = rb >= M_CTX;
                    const float r = rp[ai * 96 + m * 16]; WIN3_BV();
                    const f32x4 a0 = acc[ai][0][m][0] * r + bv00, a1 = acc[ai][0][m][1] * r + bv01, b0 = acc[ai][1][m][0] * r + bv10, b1 = acc[ai][1][m][1] * r + bv11;
                    bf16* zp = Z + (unsigned)(row * NIN + col);
                    *(v4u*)zp = pack8(a0, a1); *(v4u*)(zp + 128) = pack8(b0, b1);
                    if (!lat && pn < 6) {
                        const int vc = col - 1024, hh = vc >> 7, dd = vc & 127;
                        float* vp = newv + (unsigned)(((((row >> 8) * 2 + layer) * 4 + hh) * 256 + (row & 255)) * 128 + dd);
                        *(f32x4*)vp = a0; *(f32x4*)(vp + 4) = a1; *(f32x4*)(vp + 256 * 128) = b0; *(f32x4*)(vp + 256 * 128 + 4) = b1;
                    }
                    asm volatile("" ::: "memory");
                }
        }
#undef WIN3_BV
    }
};

__device__ __forceinline__ void p0_mod(LAS unsigned char* lds, KArgs A, int tid) {
    LAS float* sc = (LAS float*)lds;
    LAS float* red = (LAS float*)(lds + 36864);
    for (int idx = tid; idx < 9 * 1024; idx += NTHREADS) { const int c = idx >> 10, k = idx & 1023; const float x = c == 0 ? A->in[5][k] : A->in[4][(c - 1) * 1024 + k]; sc[idx] = x / (1.f + __expf(-x)); }
    __syncthreads();
    float* MOD = (float*)(A->ws + WS_MOD);
    for (int it = blockIdx.x; it < 256; it += gridDim.x) {
        const int l = it >> 7, col0 = (it & 127) * 72;
        if (tid < 504) {
            const int kg = tid / 18, c4 = tid % 18;
            f32x4 acc[9];
#pragma unroll
            for (int c = 0; c < 9; ++c) acc[c] = (f32x4){0.f, 0.f, 0.f, 0.f};
            const float* wp = A->in[6] + (size_t)l * 1024 * NMOD + col0 + 4 * c4;
#pragma unroll 4
            for (int k = kg; k < 1024; k += 28) {
                const f32x4 w = *(const f32x4*)(wp + (size_t)k * NMOD);
#pragma unroll
                for (int c = 0; c < 9; ++c) acc[c] += w * sc[c * 1024 + k];
            }
#pragma unroll
            for (int c = 0; c < 9; ++c)
#pragma unroll
                for (int e = 0; e < 4; ++e) red[(kg * 9 + c) * 72 + 4 * c4 + e] = acc[c][e];
        }
        __syncthreads();
        for (int idx = tid; idx < 648; idx += NTHREADS) {
            const int c = idx / 72, j = idx % 72; float s = A->in[7][l * NMOD + col0 + j];
            for (int kg = 0; kg < 28; ++kg) s += red[(kg * 9 + c) * 72 + j];
            MOD[(size_t)(l * 9 + c) * NMOD + col0 + j] = s;
        }
        __syncthreads();
    }
}
__device__ __forceinline__ void transpose_item(const float* W, int K, int N, bf16* WT, LAS float* scr, int item, int lane, int kind) {
    const int nblk = N / 32, kb = item / nblk, nb = item % nblk, k0 = 64 * kb, n0 = 32 * nb;
    int ln0 = n0;
    if (kind == 1) { const int pn = n0 >> 8, w = n0 & 255; ln0 = (w >> 7) * FF + 128 * pn + (w & 127); }
    else if (kind == 2 && n0 < 1024) { const int pn = n0 >> 8, w = n0 & 255; ln0 = 256 * pn + 64 * ((w & 127) >> 5) + 32 * (w >> 7); }
#pragma unroll 8
    for (int i = 0; i < 32; ++i) { const int kk = 2 * i + (lane >> 5); scr[kk * 33 + (lane & 31)] = W[(size_t)(k0 + kk) * N + ln0 + (lane & 31)]; }
    asm volatile("s_waitcnt lgkmcnt(0)" ::: "memory");
    const int c = lane & 7;
#pragma unroll
    for (int j = 0; j < 4; ++j) { const int n = (lane >> 3) + 8 * j; const LAS float* s = scr + (8 * c) * 33 + n;
        v4u o; o.x = pk2(s[0 * 33], s[1 * 33]); o.y = pk2(s[2 * 33], s[3 * 33]); o.z = pk2(s[4 * 33], s[5 * 33]); o.w = pk2(s[6 * 33], s[7 * 33]);
        *(v4u*)(WT + (size_t)(n0 + n) * K + k0 + 8 * c) = o; }
    asm volatile("s_waitcnt lgkmcnt(0)" ::: "memory");
}
__device__ __forceinline__ void p0_weights(LAS unsigned char* lds, KArgs A, int gw, int NGW, int wave, int lane) {
    LAS float* scr = (LAS float*)(lds + wave * 16384);
    constexpr int I_GU = 16 * 176, I_D = 44 * 32, I_IN = 16 * 88, I_OUT = 16 * 32, I_LAYER = 2 * I_GU + 2 * I_D + I_IN + I_OUT;
    for (int it = gw; it < 2 * I_LAYER; it += NGW) {
        const int l = it / I_LAYER; int r = it % I_LAYER;
        unsigned char* wl = A->ws + WS_W + (size_t)l * W_LAYER;
        if (r < I_GU) { transpose_item(A->in[9] + (size_t)l * D * NGU, D, NGU, (bf16*)(wl + W_GU1), scr, r, lane, 1); continue; } r -= I_GU;
        if (r < I_D) { transpose_item(A->in[10] + (size_t)l * FF * D, FF, D, (bf16*)(wl + W_D1), scr, r, lane, 0); continue; } r -= I_D;
        if (r < I_IN) { transpose_item(A->in[13] + (size_t)l * D * NIN, D, NIN, (bf16*)(wl + W_IN), scr, r, lane, 2); continue; } r -= I_IN;
        if (r < I_OUT) { transpose_item(A->in[14] + (size_t)l * D * D, D, D, (bf16*)(wl + W_OUT), scr, r, lane, 0); continue; } r -= I_OUT;
        if (r < I_GU) { transpose_item(A->in[11] + (size_t)l * D * NGU, D, NGU, (bf16*)(wl + W_GU2), scr, r, lane, 1); continue; } r -= I_GU;
        transpose_item(A->in[12] + (size_t)l * FF * D, FF, D, (bf16*)(wl + W_D2), scr, r, lane, 0);
    }
}

__device__ __forceinline__ void xa_phase(const float* in_ctx, const float* in_lat, const float* g, const float* modl, int isc, bf16* XA, float* PSS, int gw, int NGW, int lane) {
    asm volatile("" : "+v"(lane));
    for (int m = gw; m < M; m += NGW) {
        const float* xrow = (m < M_CTX ? in_ctx : in_lat) + (size_t)m * D;
        const int cond = m < M_CTX ? 0 : 1 + ((m - M_CTX) >> 10);
        const f32x4* sc4 = (const f32x4*)(modl + (size_t)cond * NMOD + isc * 1024);
        const f32x4* g4 = (const f32x4*)g; const f32x4* x4 = (const f32x4*)xrow;
        f32x4 v[4]; float ss = 0.f;
#pragma unroll
        for (int j = 0; j < 4; ++j) { v[j] = x4[lane + 64 * j]; ss += (v[j].x * v[j].x + v[j].y * v[j].y) + (v[j].z * v[j].z + v[j].w * v[j].w); }
        ss = wave_sum(ss);
        if (lane < 16) PSS[(size_t)m * 16 + lane] = lane == 0 ? ss : 0.f;
        v2u* o = (v2u*)(XA + (size_t)m * D);
#pragma unroll
        for (int j = 0; j < 4; ++j) {
            const int k4 = lane + 64 * j;
            const f32x4 r = v[j] * g4[k4] * (sc4[k4] + 1.f);
            v2u w; w.x = pk2(r.x, r.y); w.y = pk2(r.z, r.w); o[k4] = w;
        }
    }
}
__device__ __forceinline__ void bias_phase(LAS unsigned char* lds, KArgs A, int bxv, int G, int tid, int wave, int lane) {
    const int combo = bxv % 6, l = combo / 3, sidx = combo % 3;
    const int N = sidx == 1 ? NIN : NGU;
    const int boff = sidx == 0 ? BOFF_GU1 : (sidx == 1 ? BOFF_IN : BOFF_GU2);
    const bf16* Wt = (const bf16*)(A->ws + WS_W + (size_t)l * W_LAYER + (sidx == 0 ? W_GU1 : (sidx == 1 ? W_IN : W_GU2)));
    const float* MOD = (const float*)(A->ws + WS_MOD) + (size_t)l * 9 * NMOD + sidx * 3 * 1024;
    float* BIAS = (float*)(A->ws + WS_BIAS) + (size_t)l * 9 * NBIAS + boff;
    LAS bf16* shh = (LAS bf16*)lds;
    LAS bf16* shl = (LAS bf16*)(lds + 32768);
    __syncthreads();
    for (int idx = tid; idx < 16 * 1024; idx += NTHREADS) {
        const int c = idx >> 10, k = idx & 1023;
        const float v = c < 9 ? MOD[(size_t)c * NMOD + k] : 0.f;
        const unsigned hi = pk2(v, 0.f) & 0xffffu; const float r = v - __uint_as_float(hi << 16);
        shh[idx] = (bf16)hi; shl[idx] = (bf16)(pk2(r, 0.f) & 0xffffu);
    }
    __syncthreads();
    const int i16 = lane & 15, kg = lane >> 4;
    const int nwg = (G - combo + 5) / 6;
    const int wslot = (bxv / 6) * 8 + wave, nslots = nwg * 8;
    for (int task = wslot; task < N / 16; task += nslots) {
        const bf16* wp = Wt + (size_t)(task * 16 + i16) * D + 8 * kg;
        f32x4 acc = (f32x4){0.f, 0.f, 0.f, 0.f};
#pragma unroll 8
        for (int ks = 0; ks < 32; ++ks) {
            const bf16x8 a = *(const bf16x8*)(wp + 32 * ks);
            const bf16x8 bh = *(const LAS bf16x8*)(shh + i16 * 1024 + 32 * ks + 8 * kg), bl = *(const LAS bf16x8*)(shl + i16 * 1024 + 32 * ks + 8 * kg);
            acc = __builtin_amdgcn_mfma_f32_16x16x32_bf16(a, bh, acc, 0, 0, 0);
            acc = __builtin_amdgcn_mfma_f32_16x16x32_bf16(a, bl, acc, 0, 0, 0);
        }
        if (i16 < 9) *(f32x4*)(BIAS + (size_t)i16 * NBIAS + task * 16 + 4 * kg) = acc;
    }
    __syncthreads();
}
__device__ __forceinline__ void final_norm(const float* X, const float* g, float* out, int gw, int NGW, int lane) {
    for (int m = gw; m < M; m += NGW) {
        const f32x4* x4 = (const f32x4*)(X + (size_t)m * D); const f32x4* g4 = (const f32x4*)g;
        f32x4 v[4]; float ss = 0.f;
#pragma unroll
        for (int j = 0; j < 4; ++j) { v[j] = x4[lane + 64 * j]; ss += (v[j].x * v[j].x + v[j].y * v[j].y) + (v[j].z * v[j].z + v[j].w * v[j].w); }
        const float rstd = 1.f / sqrtf(wave_sum(ss) * (1.f / D) + 1e-6f);
        f32x4* o = (f32x4*)(out + (size_t)m * D);
#pragma unroll
        for (int j = 0; j < 4; ++j) o[lane + 64 * j] = v[j] * rstd * g4[lane + 64 * j];
    }
}

__device__ __forceinline__ unsigned off_b(unsigned row, unsigned ch) { return 256u * row + 16u * (ch ^ (((row & 3u) << 2) | ((0u - (row >> 2)) & 3u))); }
__device__ __forceinline__ s16x4 vtr(const LAS unsigned char* p) { return __builtin_bit_cast(s16x4, __builtin_amdgcn_ds_read_tr16_b64_v4i16((LAS s16x4*)p)); }

__device__ __forceinline__ void attn_item(LAS unsigned char* lds, KArgs A, int l, bool isLat, int b, int h, int qb, float lam, float oml, int tid, int wave, int lane) {
    const bf16* Z = (const bf16*)(A->ws + WS_ACT);
    bf16* Y = (bf16*)(A->ws + WS_Y);
    const int i16 = lane & 15, kg = lane >> 4;
    const int seq0 = isLat ? M_CTX + b * 1024 : b * 256;
    const int qrow = seq0 + qb * 128 + wave * 16 + i16;
    bf16x8 qf[4];
#pragma unroll
    for (int s = 0; s < 4; ++s) qf[s] = *(const bf16x8*)(Z + (size_t)qrow * NIN + h * 128 + 32 * s + 8 * kg);
    const int NT = isLat ? 20 : 4;
    const size_t coff = (size_t)((b * 2 + l) * 4 + h) * 256 * 128;
    const float* ck = A->in[2] + coff; const float* cv = A->in[3] + coff;
    const int sr = tid >> 4, sch = tid & 15;
    const unsigned sd0 = off_b(sr, sch), sd1 = off_b(sr + 32, sch);
    unsigned koff[4], voff[8];
#pragma unroll
    for (int s = 0; s < 4; ++s) koff[s] = off_b(i16, 4 * s + kg);
    { const int q_ = i16 >> 2, p = lane & 3;
#pragma unroll
      for (int c = 0; c < 8; ++c) voff[c] = 32768u + off_b(4 * kg + q_, 2 * c + (p >> 1)) + 8 * (p & 1); }
    v4u kreg[2], vreg[2];
#define ATT_LOAD(t) do { \
        if (isLat && (t) < 4) { \
            _Pragma("unroll") for (int i_ = 0; i_ < 2; ++i_) { const int key = 64 * (t) + sr + 32 * i_; \
                const float* pk = ck + key * 128 + sch * 8; const float* pv = cv + key * 128 + sch * 8; \
                kreg[i_] = pack8(*(const f32x4*)pk, *(const f32x4*)(pk + 4)); vreg[i_] = pack8(*(const f32x4*)pv, *(const f32x4*)(pv + 4)); } \
        } else { \
            _Pragma("unroll") for (int i_ = 0; i_ < 2; ++i_) { const size_t row = seq0 + 64 * (isLat ? (t) - 4 : (t)) + sr + 32 * i_; \
                kreg[i_] = *(const v4u*)(Z + row * NIN + 512 + h * 128 + sch * 8); vreg[i_] = *(const v4u*)(Z + row * NIN + 1024 + h * 128 + sch * 8); } \
        } } while (0)
#define ATT_STORE(bi) do { \
        *(LAS v4u*)(lds + (bi) * 16384 + sd0) = kreg[0]; *(LAS v4u*)(lds + (bi) * 16384 + sd1) = kreg[1]; \
        *(LAS v4u*)(lds + 32768 + (bi) * 16384 + sd0) = vreg[0]; *(LAS v4u*)(lds + 32768 + (bi) * 16384 + sd1) = vreg[1]; } while (0)
    f32x4 O[2][8];
#pragma unroll
    for (int mp = 0; mp < 2; ++mp)
#pragma unroll
        for (int c = 0; c < 8; ++c) O[mp][c] = (f32x4){0.f, 0.f, 0.f, 0.f};
    float mrun[2] = {-INFINITY, -INFINITY}, lsum[2] = {0.f, 0.f};
    const float c2 = 0.125f * 1.4426950408889634f;
    ATT_LOAD(0); ATT_STORE(0); __syncthreads();
    for (int t = 0; t < NT; ++t) {
        const int bi = t & 1;
        if (t + 1 < NT) ATT_LOAD(t + 1);
        const LAS unsigned char* kb_ = lds + bi * 16384;
        const LAS unsigned char* vb_ = lds + bi * 16384;
        bf16x8 kf[4][4];
#pragma unroll
        for (int kb = 0; kb < 4; ++kb)
#pragma unroll
            for (int s = 0; s < 4; ++s) kf[kb][s] = *(const LAS bf16x8*)(kb_ + kb * 4096 + koff[s]);
        __builtin_amdgcn_sched_barrier(0);
        f32x4 S[2][4];
#pragma unroll
        for (int mp = 0; mp < 2; ++mp)
#pragma unroll
            for (int kb = 0; kb < 4; ++kb) {
                S[mp][kb] = __builtin_amdgcn_mfma_f32_16x16x32_bf16(kf[kb][2 * mp], qf[2 * mp], (f32x4){0.f, 0.f, 0.f, 0.f}, 0, 0, 0);
                S[mp][kb] = __builtin_amdgcn_mfma_f32_16x16x32_bf16(kf[kb][2 * mp + 1], qf[2 * mp + 1], S[mp][kb], 0, 0, 0);
            }
        s16x4 va[8][2], vc[8][2];
#pragma unroll
        for (int c = 0; c < 8; ++c) { va[c][0] = vtr(vb_ + voff[c]); va[c][1] = vtr(vb_ + 256 * 16 + voff[c]); }
        __builtin_amdgcn_sched_barrier(0);
        bf16x8 pb[2][2];
#pragma unroll
        for (int mp = 0; mp < 2; ++mp) {
            float mx = fmaxf(fmaxf(S[mp][0][0], S[mp][0][1]), fmaxf(S[mp][0][2], S[mp][0][3]));
#pragma unroll
            for (int kb = 1; kb < 4; ++kb) mx = fmaxf(mx, fmaxf(fmaxf(S[mp][kb][0], S[mp][kb][1]), fmaxf(S[mp][kb][2], S[mp][kb][3])));
            mx = xmax16_32(mx);
            const float tm = mx * c2;
            if (__builtin_amdgcn_ballot_w64(tm > mrun[mp] + 8.f) != 0ull) {
                const float mnew = fmaxf(mrun[mp], tm);
                const float alpha = __builtin_amdgcn_exp2f(mrun[mp] - mnew);
                mrun[mp] = mnew; lsum[mp] *= alpha;
#pragma unroll
                for (int c = 0; c < 8; ++c) O[mp][c] *= alpha;
            }
            const float mref = mrun[mp];
            float ps = 0.f;
#pragma unroll
            for (int kb = 0; kb < 4; ++kb)
#pragma unroll
                for (int e = 0; e < 4; ++e) { S[mp][kb][e] = __builtin_amdgcn_exp2f(S[mp][kb][e] * c2 - mref); ps += S[mp][kb][e]; }
            lsum[mp] += ps;
#pragma unroll
            for (int ks = 0; ks < 2; ++ks) { const v4u w = pack8(S[mp][2 * ks], S[mp][2 * ks + 1]); pb[mp][ks] = __builtin_bit_cast(bf16x8, w); }
        }
        __builtin_amdgcn_sched_barrier(0);
#pragma unroll
        for (int c = 0; c < 8; ++c) { vc[c][0] = vtr(vb_ + 256 * 32 + voff[c]); vc[c][1] = vtr(vb_ + 256 * 48 + voff[c]); }
#pragma unroll
        for (int c = 0; c < 8; ++c) {
            const bf16x8 vf = (bf16x8){va[c][0][0], va[c][0][1], va[c][0][2], va[c][0][3], va[c][1][0], va[c][1][1], va[c][1][2], va[c][1][3]};
            O[0][c] = __builtin_amdgcn_mfma_f32_16x16x32_bf16(vf, pb[0][0], O[0][c], 0, 0, 0);
            O[1][c] = __builtin_amdgcn_mfma_f32_16x16x32_bf16(vf, pb[1][0], O[1][c], 0, 0, 0);
        }
        __builtin_amdgcn_sched_barrier(0);
#pragma unroll
        for (int c = 0; c < 8; ++c) {
            const bf16x8 vf = (bf16x8){vc[c][0][0], vc[c][0][1], vc[c][0][2], vc[c][0][3], vc[c][1][0], vc[c][1][1], vc[c][1][2], vc[c][1][3]};
            O[0][c] = __builtin_amdgcn_mfma_f32_16x16x32_bf16(vf, pb[0][1], O[0][c], 0, 0, 0);
            O[1][c] = __builtin_amdgcn_mfma_f32_16x16x32_bf16(vf, pb[1][1], O[1][c], 0, 0, 0);
        }
        __builtin_amdgcn_sched_barrier(0);
        if (t + 1 < NT) ATT_STORE(bi ^ 1);
        __syncthreads();
    }
#undef ATT_LOAD
#undef ATT_STORE
    float l1 = lsum[0], l2 = lsum[1];
    l1 += __shfl_xor(l1, 16); l1 += __shfl_xor(l1, 32); l2 += __shfl_xor(l2, 16); l2 += __shfl_xor(l2, 32);
    const float r1 = 1.f / l1, r2 = lam / l2;
    float ss = 0.f;
#pragma unroll
    for (int c = 0; c < 8; ++c) { O[0][c] = O[0][c] * r1 - O[1][c] * r2; ss += (O[0][c][0] * O[0][c][0] + O[0][c][1] * O[0][c][1]) + (O[0][c][2] * O[0][c][2] + O[0][c][3] * O[0][c][3]); }
    ss += __shfl_xor(ss, 16); ss += __shfl_xor(ss, 32);
    const float rstd = oml / sqrtf(ss * (1.f / 128.f) + 1e-6f);
    const float* gsub = A->in[16] + (size_t)(l * 4 + h) * 128;
    bf16* yp = Y + (size_t)qrow * D + h * 128 + 4 * kg;
#pragma unroll
    for (int c = 0; c < 8; ++c) {
        const f32x4 gv = *(const f32x4*)(gsub + 16 * c + 4 * kg);
        const f32x4 o = O[0][c] * rstd * gv;
        v2u w; w.x = pk2(o[0], o[1]); w.y = pk2(o[2], o[3]);
        *(v2u*)(yp + 16 * c) = w;
    }
}

__device__ __forceinline__ void bc_item(LAS unsigned char* lds, KArgs A, int l, int n, int g, int tid, int wave, int lane) {
    asm volatile("" : "+v"(tid)); asm volatile("" : "+v"(lane));
    const bf16* Z = (const bf16*)(A->ws + WS_ACT);
    bf16* Y = (bf16*)(A->ws + WS_Y);
    LAS unsigned char* VC = lds;
    const int r0 = n * 128;
    const int i16 = lane & 15, kg = lane >> 4;
    v4u vcr[2];
#pragma unroll
    for (int i = 0; i < 2; ++i) { const int idx = tid + NTHREADS * i, q = idx >> 3, ch = idx & 7; vcr[i] = *(const v4u*)(Z + (unsigned)((r0 + q) * NIN + 2560 + g * 64 + ch * 8)); }
    const float* wrow = A->in[18] + (unsigned)(((l * 4 + g) * 128 + 16 * wave + i16) * 128 + 8 * kg);
    f32x4 wr_[4][2];
#pragma unroll
    for (int ks = 0; ks < 4; ++ks) { wr_[ks][0] = *(const f32x4*)(wrow + 32 * ks); wr_[ks][1] = *(const f32x4*)(wrow + 32 * ks + 4); }
    const int rowm = r0 + 16 * wave + i16;
    const float bias = A->in[19][(l * 4 + g) * 128 + 16 * wave + i16];
    v2u uu[4];
#pragma unroll
    for (int cb = 0; cb < 4; ++cb) uu[cb] = *(const v2u*)(Z + (unsigned)(rowm * NIN + 2304 + g * 64 + 16 * cb + 4 * kg));
    const int p = tid >> 2, cq = tid & 3;
    const int rowc = r0 + p; const int cc = g * 64 + cq * 16;
    const int seqlen = n < 32 ? 256 : 1024; const int tpos = n < 32 ? (rowc & 255) : ((rowc - M_CTX) & 1023);
    const bool hasp = tpos > 0, hasn = tpos < seqlen - 1;
    const bf16* zr = Z + (unsigned)(rowc * NIN + cc);
    const bf16* zp = hasp ? zr - NIN : zr; const bf16* zn = hasn ? zr + NIN : zr;
    v4u gb[2], gc0[2], hc0[2], gc1[2], hc1[2], gc2[2], hc2[2];
#pragma unroll
    for (int hf = 0; hf < 2; ++hf) {
        gb[hf] = *(const v4u*)(zr + 1536 + 8 * hf);
        gc1[hf] = *(const v4u*)(zr + 1792 + 8 * hf); hc1[hf] = *(const v4u*)(zr + 2048 + 8 * hf);
        gc0[hf] = *(const v4u*)(zp + 1792 + 8 * hf); hc0[hf] = *(const v4u*)(zp + 2048 + 8 * hf);
        gc2[hf] = *(const v4u*)(zn + 1792 + 8 * hf); hc2[hf] = *(const v4u*)(zn + 2048 + 8 * hf);
    }
#pragma unroll
    for (int i = 0; i < 2; ++i) { const int idx = tid + NTHREADS * i, q = idx >> 3, ch = idx & 7; *(LAS v4u*)(VC + q * 128 + ch * 16) = vcr[i]; }
    bf16x8 wf[4];
#pragma unroll
    for (int ks = 0; ks < 4; ++ks) { const v4u w = pack8(wr_[ks][0], wr_[ks][1]); wf[ks] = __builtin_bit_cast(bf16x8, w); }
    __syncthreads();
    f32x4 acc[4];
#pragma unroll
    for (int cb = 0; cb < 4; ++cb) acc[cb] = (f32x4){0.f, 0.f, 0.f, 0.f};
    const LAS unsigned char* vb = VC + (8 * kg + (i16 >> 2)) * 128 + 8 * (lane & 3);
#pragma unroll
    for (int ks = 0; ks < 4; ++ks)
#pragma unroll
        for (int cb = 0; cb < 4; ++cb) {
            const s16x4 lo = vtr(vb + (32 * ks) * 128 + 32 * cb), hi = vtr(vb + (32 * ks + 4) * 128 + 32 * cb);
            const bf16x8 vf = (bf16x8){lo[0], lo[1], lo[2], lo[3], hi[0], hi[1], hi[2], hi[3]};
            acc[cb] = __builtin_amdgcn_mfma_f32_16x16x32_bf16(vf, wf[ks], acc[cb], 0, 0, 0);
        }
#pragma unroll
    for (int cb = 0; cb < 4; ++cb) {
        v2u o; o.x = pk2(bflo(uu[cb].x) * (acc[cb][0] + bias), bfhi(uu[cb].x) * (acc[cb][1] + bias)); o.y = pk2(bflo(uu[cb].y) * (acc[cb][2] + bias), bfhi(uu[cb].y) * (acc[cb][3] + bias));
        *(v2u*)(Y + (unsigned)(rowm * D + 768 + g * 64 + 16 * cb + 4 * kg)) = o;
    }
    {
        const float* cw = A->in[17] + (unsigned)(l * 3 * 256 + cc);
        const float mp_ = hasp ? 1.f : 0.f, mn_ = hasn ? 1.f : 0.f;
#pragma unroll
        for (int hf = 0; hf < 2; ++hf) {
            const f32x4 w0a = *(const f32x4*)(cw + 8 * hf) * mp_, w0b = *(const f32x4*)(cw + 8 * hf + 4) * mp_;
            const f32x4 w1a = *(const f32x4*)(cw + 256 + 8 * hf), w1b = *(const f32x4*)(cw + 256 + 8 * hf + 4);
            const f32x4 w2a = *(const f32x4*)(cw + 512 + 8 * hf) * mn_, w2b = *(const f32x4*)(cw + 512 + 8 * hf + 4) * mn_;
            v4u o;
#pragma unroll
            for (int e = 0; e < 4; ++e) {
                const float wl0 = e < 2 ? w0a[2 * e] : w0b[2 * e - 4], wh0 = e < 2 ? w0a[2 * e + 1] : w0b[2 * e - 3];
                const float wl1 = e < 2 ? w1a[2 * e] : w1b[2 * e - 4], wh1 = e < 2 ? w1a[2 * e + 1] : w1b[2 * e - 3];
                const float wl2 = e < 2 ? w2a[2 * e] : w2b[2 * e - 4], wh2 = e < 2 ? w2a[2 * e + 1] : w2b[2 * e - 3];
                const float lo = bflo(gb[hf][e]) * (wl0 * bflo(gc0[hf][e]) * bflo(hc0[hf][e]) + wl1 * bflo(gc1[hf][e]) * bflo(hc1[hf][e]) + wl2 * bflo(gc2[hf][e]) * bflo(hc2[hf][e]));
                const float hi = bfhi(gb[hf][e]) * (wh0 * bfhi(gc0[hf][e]) * bfhi(hc0[hf][e]) + wh1 * bfhi(gc1[hf][e]) * bfhi(hc1[hf][e]) + wh2 * bfhi(gc2[hf][e]) * bfhi(hc2[hf][e]));
                o[e] = pk2(lo, hi);
            }
            *(v4u*)(Y + (unsigned)(rowc * D + 512 + cc + 8 * hf)) = o;
        }
    }
    __syncthreads();
}

__device__ __forceinline__ void mixer_phase(LAS unsigned char* lds, KArgs A, int l, int vcu, int G, int tid, int wave, int lane) {
    asm volatile("" : "+v"(tid)); lane = tid & 63; wave = __builtin_amdgcn_readfirstlane(tid >> 6);
    const float lam_init = __uint_as_float(__builtin_amdgcn_readfirstlane(l == 0 ? 0x3e4ccccdu : 0x3eb60549u));
    const float* lp = A->in[15] + (size_t)l * 256;
    const float s01 = wave_sum(lp[lane] * lp[64 + lane]), s23 = wave_sum(lp[128 + lane] * lp[192 + lane]);
    const float lam = __uint_as_float(__builtin_amdgcn_readfirstlane(__float_as_uint(__expf(s01) - __expf(s23) + lam_init)));
    const float oml = __uint_as_float(__builtin_amdgcn_readfirstlane(l == 0 ? 0x3f4ccccdu : 0x3f24fd5cu));
    for (int it = vcu; it < 768; it += G) {
        if (it < 256) attn_item(lds, A, l, true, it >> 5, (it >> 3) & 3, it & 7, lam, oml, tid, wave, lane);
        else if (it < 384) { const int j = it - 256; attn_item(lds, A, l, false, j >> 3, (j >> 1) & 3, j & 1, lam, oml, tid, wave, lane); }
        else { const int j = it - 384; bc_item(lds, A, l, j >> 2, j & 3, tid, wave, lane); }
    }
}

#define XB_TMO      128
#define XB_XCNT(j)  (256  + 64 * (j))
#define XB_XSUB(j)  (1280 + 64 * (j))
#define XB_XGEN(j)  (2304 + 64 * (j))
#define XB_TOP      3328
#define XB_TOPGEN   3392
#define XCD_BAR_WORDS 3456
#define XB_SPIN_CAP (1u << 18)

__device__ __forceinline__ unsigned xb_ld(unsigned* p)              { return __hip_atomic_load(p, __ATOMIC_RELAXED, __HIP_MEMORY_SCOPE_AGENT); }
__device__ __forceinline__ unsigned xb_add(unsigned* p, unsigned v) { return __hip_atomic_fetch_add(p, v, __ATOMIC_RELAXED, __HIP_MEMORY_SCOPE_AGENT); }
__device__ __forceinline__ unsigned xb_xcc_id() { return (unsigned)__builtin_amdgcn_s_getreg((3 << 11) | 20) & 0xFu; }
#define XB_SPIN(cond, bar) do { unsigned _sp = 0; while (cond) { __builtin_amdgcn_s_sleep(1); \
    if ((++_sp & 255u) == 0u) { if (xb_ld(&(bar)[XB_TMO])) break; if (_sp > XB_SPIN_CAP) { atomicAdd(&(bar)[XB_TMO], 1u); break; } } } } while (0)

struct XcdBarrier {
    unsigned* bar; unsigned x;
    volatile LAS unsigned* st;
};

__device__ __forceinline__ XcdBarrier xcd_barrier_post(unsigned* bar, volatile LAS unsigned* st, bool leader) {
    XcdBarrier b; b.bar = bar; b.x = xb_xcc_id(); b.st = st;
    if (leader) (void)xb_add(&bar[XB_XCNT(b.x)], 1u);
    return b;
}
__device__ __forceinline__ void xcd_barrier_complete(unsigned* bar, unsigned x, unsigned& nloc, unsigned& nx) {
    const unsigned G = gridDim.x * gridDim.y * gridDim.z;
    unsigned sum, cnt, mine, sp = 0u;
    for (;;) {
        sum = 0u; cnt = 0u; mine = 0u;
#pragma unroll
        for (unsigned j = 0; j < 16; ++j) { const unsigned c = xb_ld(&bar[XB_XCNT(j)]); sum += c; cnt += (c > 0u) ? 1u : 0u; mine = (j == x) ? c : mine; }
        if (sum == G) break;
        __builtin_amdgcn_s_sleep(1);
        if ((++sp & 255u) == 0u) { if (xb_ld(&bar[XB_TMO])) break; if (sp > XB_SPIN_CAP) { atomicAdd(&bar[XB_TMO], 1u); break; } }
    }
    nloc = mine > 0u ? mine : 1u; nx = cnt > 0u ? cnt : 1u;
}

__device__ __forceinline__ void xcd_barrier(const XcdBarrier& b, bool leader) {
    asm volatile("s_waitcnt vmcnt(0)" ::: "memory");
    __syncthreads();
    if (leader) {
        unsigned* bar = b.bar;
        __builtin_amdgcn_s_waitcnt(0);
        unsigned nloc = b.st[0], nx = b.st[1];
        if (nloc == 0u) { xcd_barrier_complete(bar, b.x, nloc, nx); b.st[0] = nloc; b.st[1] = nx; }
        const unsigned old = xb_add(&bar[XB_XSUB(b.x)], 1u);
        const unsigned gen = old / nloc;
        if (old + 1u == (gen + 1u) * nloc) {
            __builtin_amdgcn_fence(__ATOMIC_RELEASE, "agent");
            asm volatile("s_waitcnt vmcnt(0)" ::: "memory");
            const unsigned og = xb_add(&bar[XB_TOP], 1u);
            const unsigned tg = og / nx;
            if (og + 1u == (tg + 1u) * nx) xb_add(&bar[XB_TOPGEN], 1u);
            else XB_SPIN(xb_ld(&bar[XB_TOPGEN]) == tg, bar);
            __builtin_amdgcn_fence(__ATOMIC_ACQUIRE, "agent");
            xb_add(&bar[XB_XGEN(b.x)], 1u);
            asm volatile("s_waitcnt vmcnt(0)" ::: "memory");
        } else {
            XB_SPIN(xb_ld(&bar[XB_XGEN(b.x)]) == gen, bar);
            __builtin_amdgcn_fence(__ATOMIC_ACQUIRE, "agent");
            asm volatile("s_waitcnt vmcnt(0)" ::: "memory");
        }
    }
    __syncthreads();
}

#ifndef PHMASK
#define PHMASK 0xffff
#endif
#define PH(k) ((PHMASK >> (k)) & 1)
#ifndef PROBE
#define PROBE 0
#endif
#define GSYNC() do { XcdBarrier b_; b_.bar = (unsigned*)kargs()->ws; { unsigned x_ = bar_x; asm volatile("" : "+s"(x_)); b_.x = x_; } b_.st = (volatile LAS unsigned*)(lds + 131072); xcd_barrier(b_, TID() == 0); } while (0)
__global__ void __launch_bounds__(NTHREADS, 2) fwd_megakernel(Args A_byval) {
    extern __shared__ __attribute__((aligned(16))) unsigned char lds_raw[];
    LAS unsigned char* lds = (LAS unsigned char*)lds_raw;
    cg::grid_group grid = cg::this_grid();
    const int wid_s = __builtin_amdgcn_readfirstlane((int)threadIdx.x >> 6);
#define TID() (wid_s * 64 + lane_id_fresh())
    const int G = gridDim.x, bx = blockIdx.x;
    const int vcu = (G % 8 == 0) ? (bx % 8) * (G / 8) + bx / 8 : bx;
#define WAVE() wid_s
#define WSP(off) (kargs()->ws + (off))
#define INP(i) (kargs()->in[i])

    { const int t_ = TID(); if (t_ < 64) ((LAS unsigned*)(lds + 131072))[t_] = 0u; }
    __syncthreads();
    const unsigned bar_x = xcd_barrier_post((unsigned*)WSP(0), (volatile LAS unsigned*)(lds + 131072), TID() == 0).x;
    if (kargs()->ws == nullptr) grid.sync();

    if (PH(0)) p0_mod(lds, kargs(), TID());
    if (bx == G - 1) {
        float* RC = (float*)WSP(WS_ROPE);
        for (int idx = TID(); idx < 1024; idx += NTHREADS) {
            const int pos = idx >> 4, i = idx & 15;
            const float inv = exp2f(-(float)i * (13.287712379549449f / 16.f));
            float rev = (float)pos * inv * 0.15915494309189535f; rev -= floorf(rev);
            RC[idx] = __builtin_amdgcn_cosf(rev); RC[1024 + idx] = __builtin_amdgcn_sinf(rev);
        }
    }
    if (PH(1)) p0_weights(lds, kargs(), vcu * 8 + WAVE(), G * 8, WAVE(), (TID() & 63));
    GSYNC();
    bias_phase(lds, kargs(), bx, G, TID(), WAVE(), (TID() & 63));
    xa_phase(INP(0), INP(1) - (size_t)M_CTX * D, INP(8), (const float*)WSP(WS_MOD), 1, (bf16*)WSP(WS_H), (float*)WSP(WS_PSS), vcu * 8 + WAVE(), G * 8, (TID() & 63));
    GSYNC();

    for (int l = 0; l < 2; ++l) {
        for (int half = 0; half < 2; ++half) {
            if (PH(3)) {   pg8::Gemm g{(const bf16*)WSP(WS_H), (const bf16*)WSP(WS_W + (size_t)l * W_LAYER + (half ? W_GU2 : W_GU1)), M, NGU, D}; pg8::StaticOrder S; S.init(M, NGU, G, bx);
                EpiSwiglu E{WSP(0), l * 9 * NBIAS + (half ? BOFF_GU2 : BOFF_GU1)};
                pg8::gemm_phase<EpiSwiglu, pg8::StaticOrder, true, true>(lds, g, S, E, TID()); }
            GSYNC();
            if (PH(4)) {   const bool first = (l == 0 && half == 0);
                float* X = (float*)WSP(WS_X);
                const float* in_ctx = first ? INP(0) : X;
                const float* in_lat = first ? INP(1) - (size_t)M_CTX * D : X;
                const bool has_next = (half == 0) || (l == 0);
                const int ln = half == 0 ? l : l + 1;
                const float* gnext = has_next ? INP(8) + (size_t)(ln * 3 + (half == 0 ? 1 : 0)) * D : nullptr;
                const int sc_off = ln * 9 * NMOD + (half == 0 ? 4 : 1) * 1024;
                pg8::Gemm g{(const bf16*)WSP(WS_ACT), (const bf16*)WSP(WS_W + (size_t)l * W_LAYER + (half ? W_D2 : W_D1)), M, D, FF}; pg8::StaticOrder S; S.initmn(M / 192, D / 256, G, bx);
                EpiRes3 E{in_ctx, in_lat, WSP(0), gnext, l * 9 * NMOD + (half ? 8 : 2) * 1024, sc_off, 0.5f};
                pg8::gemm_phase<EpiRes3, pg8::StaticOrder, true, true, 3>(lds, g, S, E, TID()); }
            GSYNC();
            if (half == 0) {
                if (PH(5)) {   pg8::Gemm g{(const bf16*)WSP(WS_H), (const bf16*)WSP(WS_W + (size_t)l * W_LAYER + W_IN), M, NIN, D}; pg8::StaticOrder S; S.initmn(M / 192, NIN / 256, G, bx);
                    float* newk = kargs()->out + (size_t)M * D;
                    EpiWin3 E{WSP(0), newk, l};
                    pg8::gemm_phase<EpiWin3, pg8::StaticOrder, true, true, 3>(lds, g, S, E, TID()); }
                GSYNC();
                if (PH(6)) mixer_phase(lds, kargs(), l, vcu, G, TID(), WAVE(), (TID() & 63));
                if (PROBE == 3) mixer_phase(lds, kargs(), l, vcu, G, TID(), WAVE(), (TID() & 63));
                GSYNC();
                if (PH(7)) {   float* X = (float*)WSP(WS_X);
                    pg8::Gemm g{(const bf16*)WSP(WS_Y), (const bf16*)WSP(WS_W + (size_t)l * W_LAYER + W_OUT), M, D, D}; pg8::StaticOrder S; S.initmn(M / 192, D / 256, G, bx);
                    EpiRes3 E{X, X, WSP(0), INP(8) + (size_t)(l * 3 + 2) * D, l * 9 * NMOD + 5 * 1024, l * 9 * NMOD + 7 * 1024, 1.0f};
                    pg8::gemm_phase<EpiRes3, pg8::StaticOrder, true, true, 3>(lds, g, S, E, TID()); }
                GSYNC();
            }
        }
    }
    final_norm((const float*)WSP(WS_X), INP(20), kargs()->out, vcu * 8 + WAVE(), G * 8, (TID() & 63));
}

extern "C" void kernel_launch(void* const* d_in, const int* in_sizes, int n_in, void* d_out, int out_size, void* d_ws, size_t ws_size, hipStream_t stream) {
    static int grid = 0;
    if (grid == 0) {
        if (n_in != 21 || ws_size < WS_END2) { fprintf(stderr, "kernel_launch: need 21 inputs and >= %zu bytes of workspace; got %d, %zu\n", (size_t)WS_END2, n_in, ws_size); grid = -1; return; }
        int dev = 0, cus = 0, per_cu = 0;
        hipGetDevice(&dev);
        hipDeviceGetAttribute(&cus, hipDeviceAttributeMultiprocessorCount, dev);
        if (hipFuncSetAttribute((const void*)fwd_megakernel, hipFuncAttributeMaxDynamicSharedMemorySize, LDS_BYTES) != hipSuccess) { fprintf(stderr, "kernel_launch: hipFuncSetAttribute failed\n"); grid = -1; return; }
        if (hipOccupancyMaxActiveBlocksPerMultiprocessor(&per_cu, (const void*)fwd_megakernel, NTHREADS, LDS_BYTES) != hipSuccess || per_cu < 1) { fprintf(stderr, "kernel_launch: occupancy query gave %d\n", per_cu); per_cu = 1; }
        (void)hipGetLastError();
        grid = cus * per_cu;
    }
    if (grid < 0) return;
    if (hipMemsetAsync(d_ws, 0, 65536, stream) != hipSuccess) { fprintf(stderr, "kernel_launch: memset of barrier words failed\n"); return; }
    Args a{};
    for (int i = 0; i < 21; ++i) a.in[i] = (const float*)d_in[i];
    a.out = (float*)d_out; a.ws = (unsigned char*)d_ws;
    void* args[] = {&a};
    hipError_t e = hipLaunchCooperativeKernel((const void*)fwd_megakernel, dim3(grid), dim3(NTHREADS), args, LDS_BYTES, stream);
    if (e != hipSuccess) fprintf(stderr, "cooperative launch failed: %s (grid %d)\n", hipGetErrorString(e), grid);
}
```

```cpp
#include <hip/hip_runtime.h>
#include <hip/hip_cooperative_groups.h>
#include <cstdio>
#include <cstdint>
namespace cg = cooperative_groups;
namespace pg8 {
#define PG8_LAS __attribute__((address_space(3)))
typedef unsigned short bf16_t;
typedef short bf16x8 __attribute__((ext_vector_type(8)));
typedef float f32x4 __attribute__((ext_vector_type(4)));
typedef unsigned u32x4 __attribute__((ext_vector_type(4)));
constexpr int BM = 256, BK = 64, HALF = 128, HTB = HALF * BK * 2  , STAGE_BYTES = 8 * HTB, NXCD = 8, WGM = 8;

__host__ __device__ __forceinline__ int lds_byte(int r, int c) { const int st = (r >> 4) * 2 + (c >> 5), rr = r & 15, cc = c & 31, ob = rr * 64 + cc * 2; return st * 1024 + (ob ^ (((ob >> 9) & 1) << 5)); }
__host__ __device__ __forceinline__ void stage_rc(int b, int& R, int& C) { const int st = b / 1024, sb = b % 1024, swz = sb ^ (((sb >> 9) & 1) << 5); R = (st >> 1) * 16 + swz / 64; C = (st & 1) * 32 + (swz % 64) / 2; }
__host__ __device__ __forceinline__ int perm32(int rho) { const int n = rho >> 4, i = rho & 15; return 8 * (i >> 2) + 4 * n + (i & 3); }

struct Unit { int pm, pn; };
struct Gemm { const bf16_t* A; const bf16_t* Bt; int M, N, K; };

struct StaticOrder {
    int nM, nN, nwg, G, c;
    __host__ __device__ void init(int M, int N, int G_, int c_) { nM = M / BM; nN = N / BM; nwg = nM * nN; G = G_; c = c_; }
    __host__ __device__ void initmn(int nM_, int nN_, int G_, int c_) { nM = nM_; nN = nN_; nwg = nM * nN; G = G_; c = c_; }
    __host__ __device__ bool next(int i, Unit& u) const {
        const long L = (long)i * G + c; if (L >= nwg) return false;
        int wgid = (int)L; { const int q = nwg / NXCD, r = nwg % NXCD, xcd = wgid % NXCD, off = wgid / NXCD; wgid = (xcd < r ? xcd * (q + 1) : r * (q + 1) + (xcd - r) * q) + off; }
        const int nig = WGM * nN, gid = wgid / nig, fm = gid * WGM, gsz = (nM - fm) < WGM ? (nM - fm) : WGM;
        u.pm = fm + ((wgid % nig) % gsz); u.pn = (wgid % nig) / gsz; return true;
    }
    __device__ __forceinline__ void a_ready(const Unit&) const {}
    __device__ __forceinline__ void done(const Unit&) const {}
};

__device__ __forceinline__ unsigned cvt_pk_bf16(float lo, float hi) { unsigned r; asm volatile("v_cvt_pk_bf16_f32 %0, %1, %2" : "=v"(r) : "v"(lo), "v"(hi)); return r; }
typedef float f32x2 __attribute__((ext_vector_type(2)));
template <class Epi, class Sched, bool ALIGN_EPI = false, bool SP2 = false, int MB = 4>
__device__ __forceinline__ void gemm_phase(PG8_LAS unsigned char* lds, const Gemm g, const Sched& S, const Epi& E, int tid) {
    asm volatile("" : "+v"(tid));
    const int wid = __builtin_amdgcn_readfirstlane(tid >> 6), lane = tid & 63, wr = wid >> 2, wc = wid & 3, fr = lane & 15, fq = lane >> 4;
    const int K = g.K, nt = K / BK;
    const bool lightw = SP2 && MB < 4 && wid >= 2 * MB;
    unsigned voffA[2], voffB[2];
#pragma unroll
    for (int i = 0; i < 2; ++i) { int R, C; stage_rc(tid * 16 + i * 8192, R, C); const int Rb = Epi::PERM ? ((R & ~31) + perm32(R & 31)) : R;
        const int Ra = MB == 4 ? R : R - (64 - 16 * MB) * (R >> 6);
        voffA[i] = (unsigned)(Ra * K + C) * 2u; voffB[i] = (unsigned)(Rb * K + C) * 2u; }
    const size_t kstep = (size_t)(BK * 2);
    const size_t hstep = (size_t)HALF * K * 2;
    const size_t tstep = 2 * hstep;
    const size_t hstepA = (size_t)(32 * MB) * K * 2, tstepA = 2 * hstepA;
    const unsigned ldsw = (unsigned)wid * 1024u;
    const int aoff = lds_byte(wr * 64 + fr, fq * 8), boff = lds_byte(wc * 32 + fr, fq * 8);
#define PG8_SA(b, h) (((b) * 2 + (h)) * HTB)
#define PG8_SB(b, h) ((4 + (b) * 2 + (h)) * HTB)
#define PG8_STAGE(bufoff, gbase, voff) do { _Pragma("unroll") for (int _i = 0; _i < 2; ++_i) \
        __builtin_amdgcn_global_load_lds((const unsigned*)((const char*)(gbase) + (voff)[_i]), (PG8_LAS unsigned*)(lds + (bufoff) + ldsw + _i * 8192), 16, 0, 0); } while (0)
#define PG8_LDA(dst, b, h) do { _Pragma("unroll") for (int m = 0; m < MB; ++m) _Pragma("unroll") for (int k = 0; k < 2; ++k) dst[m][k] = *(const PG8_LAS bf16x8*)(lds + PG8_SA(b, h) + aoff + m * 2048 + k * 1024); } while (0)
#define PG8_LDB(dst, b, h) do { _Pragma("unroll") for (int n = 0; n < 2; ++n) _Pragma("unroll") for (int k = 0; k < 2; ++k) dst[n][k] = *(const PG8_LAS bf16x8*)(lds + PG8_SB(b, h) + boff + n * 2048 + k * 1024); } while (0)
#define PG8_MMA(ai, bj, At, Bt) do { __builtin_amdgcn_s_setprio(1); _Pragma("unroll") for (int m = 0; m < MB; ++m) _Pragma("unroll") for (int n = 0; n < 2; ++n) _Pragma("unroll") for (int k = 0; k < 2; ++k) \
        acc[ai][bj][m][n] = __builtin_amdgcn_mfma_f32_16x16x32_bf16(Bt[n][k], At[m][k], acc[ai][bj][m][n], 0, 0, 0); __builtin_amdgcn_s_setprio(0); } while (0)
#define PG8_WAIT_V(n) asm volatile("s_waitcnt vmcnt(" #n ")" ::: "memory")
#define PG8_STAGE_A(bufoff, gbase, voff) do { if (!lightw) PG8_STAGE(bufoff, gbase, voff); } while (0)
#define PG8_WAIT_VL(n, nl) do { if (lightw) asm volatile("s_waitcnt vmcnt(" #nl ")" ::: "memory"); else asm volatile("s_waitcnt vmcnt(" #n ")" ::: "memory"); } while (0)
#define PG8_WAIT_L(n) asm volatile("s_waitcnt lgkmcnt(" #n ")" ::: "memory")
#define PG8_BAR __builtin_amdgcn_s_barrier()
#define PG8_SCHED __builtin_amdgcn_sched_barrier(0)
    Unit cur, nxt; int ui = 0;
    if (!S.next(0, cur)) return;
    PG8_LAS float* tabs = (PG8_LAS float*)(lds + STAGE_BYTES + 1024);
    if constexpr (Epi::HAS_TAB) { typename Epi::Pre p0_ = E.pre_load(cur, tid); E.pre_store(p0_, tabs, tid); }
    f32x4 acc[2][2][4][2];
#pragma unroll
    for (int a = 0; a < 2; ++a)
#pragma unroll
        for (int b = 0; b < 2; ++b)
#pragma unroll
            for (int m = 0; m < 4; ++m)
#pragma unroll
                for (int n = 0; n < 2; ++n) acc[a][b][m][n] = (f32x4){0.f, 0.f, 0.f, 0.f};
    bf16x8 At[4][2], B0[2][2], B1[2][2];
    const char* cA = (const char*)g.A + (size_t)cur.pm * tstepA; const char* cB = (const char*)g.Bt + (size_t)cur.pn * tstep;
    S.a_ready(cur);
    if constexpr (SP2) {
        PG8_STAGE(PG8_SB(0, 0), cB, voffB); PG8_STAGE(PG8_SB(0, 1), cB + hstep, voffB); PG8_STAGE_A(PG8_SA(0, 0), cA, voffA); PG8_STAGE_A(PG8_SA(0, 1), cA + hstepA, voffA);
        if (wr == 1) PG8_BAR;
        PG8_WAIT_VL(2, 0); PG8_BAR;
        PG8_STAGE(PG8_SB(1, 0), cB + kstep, voffB); PG8_STAGE_A(PG8_SA(1, 0), cA + kstep, voffA); PG8_STAGE(PG8_SB(1, 1), cB + hstep + kstep, voffB);
        PG8_WAIT_VL(6, 4); PG8_BAR;
    } else {
        PG8_STAGE(PG8_SB(0, 0), cB, voffB); PG8_STAGE(PG8_SA(0, 0), cA, voffA); PG8_STAGE(PG8_SB(0, 1), cB + hstep, voffB); PG8_STAGE(PG8_SA(0, 1), cA + hstepA, voffA);
        if (wr == 1) PG8_BAR;
        PG8_WAIT_V(4); PG8_BAR;
        PG8_STAGE(PG8_SB(1, 0), cB + kstep, voffB); PG8_STAGE(PG8_SA(1, 0), cA + kstep, voffA); PG8_STAGE(PG8_SB(1, 1), cB + hstep + kstep, voffB);
        PG8_WAIT_V(6); PG8_BAR;
    }
    for (;;) {
        const bool has_next = S.next(ui + 1, nxt);
        const char* nA = has_next ? (const char*)g.A + (size_t)nxt.pm * tstepA : cA; const char* nB = has_next ? (const char*)g.Bt + (size_t)nxt.pn * tstep : cB;
        for (int t = 0; t < nt; t += 2) {
            const bool last = (t == nt - 2);
            const char* a1 = cA + (size_t)(t + 1) * kstep;
            const char* a2 = last ? nA : cA + (size_t)(t + 2) * kstep; const char* b2 = last ? nB : cB + (size_t)(t + 2) * kstep;
            const char* a3 = a2 + kstep; const char* b3 = b2 + kstep;
            if (last && has_next) S.a_ready(nxt);
            if constexpr (SP2) {
            PG8_LDB(B0, 0, 0); PG8_LDB(B1, 0, 1); PG8_SCHED; PG8_LDA(At, 0, 0); PG8_STAGE_A(PG8_SA(1, 1), a1 + hstepA, voffA);
            PG8_WAIT_VL(8, 4); PG8_WAIT_L(0); PG8_BAR; PG8_MMA(0, 0, At, B0); PG8_MMA(0, 1, At, B1); PG8_BAR; PG8_SCHED;
            PG8_LDA(At, 0, 1); PG8_STAGE(PG8_SB(0, 0), b2, voffB); PG8_STAGE(PG8_SB(0, 1), b2 + hstep, voffB); PG8_STAGE_A(PG8_SA(0, 0), a2, voffA);
            PG8_WAIT_VL(8, 4); PG8_WAIT_L(0); PG8_BAR; PG8_MMA(1, 0, At, B0); PG8_MMA(1, 1, At, B1); PG8_BAR; PG8_SCHED;
            PG8_LDB(B0, 1, 0); PG8_LDB(B1, 1, 1); PG8_SCHED; PG8_LDA(At, 1, 0); PG8_STAGE_A(PG8_SA(0, 1), a2 + hstepA, voffA);
            PG8_WAIT_VL(8, 4); PG8_WAIT_L(0); PG8_BAR; PG8_MMA(0, 0, At, B0); PG8_MMA(0, 1, At, B1); PG8_BAR; PG8_SCHED;
            PG8_LDA(At, 1, 1); PG8_STAGE(PG8_SB(1, 0), b3, voffB); PG8_STAGE(PG8_SB(1, 1), b3 + hstep, voffB); PG8_STAGE_A(PG8_SA(1, 0), a3, voffA);
            PG8_WAIT_VL(8, 4); PG8_WAIT_L(0); PG8_BAR; PG8_MMA(1, 0, At, B0); PG8_MMA(1, 1, At, B1); PG8_BAR; PG8_SCHED;
            } else {
            PG8_LDB(B0, 0, 0); PG8_SCHED; PG8_LDA(At, 0, 0); PG8_STAGE(PG8_SA(1, 1), a1 + hstepA, voffA);
            PG8_WAIT_L(8); PG8_BAR; PG8_WAIT_L(0); PG8_MMA(0, 0, At, B0); PG8_BAR; PG8_SCHED;
            PG8_LDB(B1, 0, 1); PG8_STAGE(PG8_SB(0, 0), b2, voffB);
            PG8_BAR; PG8_WAIT_L(0); PG8_MMA(0, 1, At, B1); PG8_BAR;
            PG8_LDA(At, 0, 1); PG8_STAGE(PG8_SA(0, 0), a2, voffA);
            PG8_BAR; PG8_WAIT_L(0); PG8_MMA(1, 0, At, B0); PG8_BAR; PG8_SCHED;
            PG8_STAGE(PG8_SB(0, 1), b2 + hstep, voffB);
            PG8_WAIT_V(6); PG8_BAR; PG8_MMA(1, 1, At, B1); PG8_BAR;
            PG8_LDB(B0, 1, 0); PG8_SCHED; PG8_LDA(At, 1, 0); PG8_STAGE(PG8_SA(0, 1), a2 + hstepA, voffA);
            PG8_WAIT_L(8); PG8_BAR; PG8_WAIT_L(0); PG8_MMA(0, 0, At, B0); PG8_BAR; PG8_SCHED;
            PG8_LDB(B1, 1, 1); PG8_STAGE(PG8_SB(1, 0), b3, voffB);
            PG8_BAR; PG8_WAIT_L(0); PG8_MMA(0, 1, At, B1); PG8_BAR;
            PG8_LDA(At, 1, 1); PG8_STAGE(PG8_SA(1, 0), a3, voffA);
            PG8_BAR; PG8_WAIT_L(0); PG8_MMA(1, 0, At, B0); PG8_BAR; PG8_SCHED;
            PG8_STAGE(PG8_SB(1, 1), b3 + hstep, voffB);
            PG8_WAIT_V(6); PG8_BAR; PG8_MMA(1, 1, At, B1); PG8_BAR;
            }
        }
        if constexpr (ALIGN_EPI) { if (wr == 0) PG8_BAR; }
        if constexpr (Epi::HAS_TAB) {
            typename Epi::Pre pn_; if (has_next) pn_ = E.pre_load(nxt, tid);
            E(acc, cur, wr, wc, fr, fq, tabs + (ui & 1) * Epi::TABSZ);
            if (has_next) E.pre_store(pn_, tabs + ((ui + 1) & 1) * Epi::TABSZ, tid);
            S.done(cur);
        } else
        if constexpr (!Epi::AFTER_DRAIN) { E(acc, cur, wr, wc, fr, fq); S.done(cur); }
        if (!has_next) break;
#pragma unroll
        for (int a = 0; a < 2; ++a)
#pragma unroll
            for (int b = 0; b < 2; ++b)
#pragma unroll
                for (int m = 0; m < 4; ++m)
#pragma unroll
                    for (int n = 0; n < 2; ++n) acc[a][b][m][n] = (f32x4){0.f, 0.f, 0.f, 0.f};
        cur = nxt; cA = nA; cB = nB; ++ui;
        if constexpr (ALIGN_EPI) { if (wr == 1) PG8_BAR; }
    }
    PG8_WAIT_V(0);
    if constexpr (!ALIGN_EPI) { if (wr == 0) PG8_BAR; }
    PG8_BAR;
    if constexpr (Epi::AFTER_DRAIN) { E.fused(acc, cur, wr, wc, fr, fq, lds, wid, lane); S.done(cur); }
#undef PG8_SA
#undef PG8_SB
#undef PG8_STAGE
#undef PG8_LDA
#undef PG8_LDB
#undef PG8_MMA
#undef PG8_WAIT_V
#undef PG8_WAIT_VL
#undef PG8_STAGE_A
#undef PG8_WAIT_L
#undef PG8_BAR
#undef PG8_SCHED
}
}

constexpr int D = 1024, FF = 2816, NGU = 5632, NIN = 2816;
constexpr int M_CTX = 4096, M = 12288;
constexpr int NMOD = 9216;
constexpr size_t MiB = 1u << 20;
constexpr size_t WS_MOD = 1 * MiB, WS_ROPE = 1 * MiB + 768 * 1024, WS_W = 2 * MiB;
constexpr size_t W_GU1 = 0, W_D1 = 11534336, W_IN = 17301504, W_OUT = 23068672, W_GU2 = 25165824, W_D2 = 36700160, W_LAYER = 42467328;
constexpr size_t WS_X = WS_W + 2 * W_LAYER;
constexpr size_t WS_H = WS_X + (size_t)M * D * 4;
constexpr size_t WS_Y = WS_H + (size_t)M * D * 2;
constexpr size_t WS_ACT = WS_Y + (size_t)M * D * 2;
constexpr size_t WS_END = WS_ACT + (size_t)M * FF * 2;
constexpr size_t WS_BIAS = WS_END;
constexpr int NBIAS = NGU + NIN + NGU, BOFF_GU1 = 0, BOFF_IN = NGU, BOFF_GU2 = NGU + NIN;
constexpr size_t WS_PSS = WS_BIAS + (size_t)2 * 9 * NBIAS * 4;
constexpr size_t WS_END2 = WS_PSS + (size_t)M * 16 * 4;
constexpr int LDS_BYTES = 147456;
constexpr int GU_MAIN_PANELS = 46, GU_TMB = 1;
constexpr int NTHREADS = 512;

#define LAS __attribute__((address_space(3)))
typedef unsigned short bf16;
typedef unsigned v4u __attribute__((ext_vector_type(4)));
typedef unsigned v2u __attribute__((ext_vector_type(2)));
typedef float f32x4 __attribute__((ext_vector_type(4)));
typedef short bf16x8 __attribute__((ext_vector_type(8)));
typedef short s16x4 __attribute__((ext_vector_type(4)));

struct Args { const float* in[21]; float* out; unsigned char* ws; };
typedef const __attribute__((address_space(4))) Args* KArgs;
__device__ __forceinline__ int lane_id_fresh() { int l; asm volatile("v_mbcnt_lo_u32_b32 %0, -1, 0\n\tv_mbcnt_hi_u32_b32 %0, -1, %0" : "=v"(l)); return l; }
__device__ __forceinline__ KArgs kargs() { KArgs p = (KArgs)__builtin_amdgcn_kernarg_segment_ptr(); asm volatile("" : "+s"(p)); return p; }

__device__ __forceinline__ unsigned pk2(float lo, float hi) { return pg8::cvt_pk_bf16(lo, hi); }
__device__ __forceinline__ v4u pack8(f32x4 a, f32x4 b) { v4u w; w.x = pk2(a[0], a[1]); w.y = pk2(a[2], a[3]); w.z = pk2(b[0], b[1]); w.w = pk2(b[2], b[3]); return w; }
__device__ __forceinline__ float bflo(unsigned u) { return __uint_as_float(u << 16); }
__device__ __forceinline__ float bfhi(unsigned u) { return __uint_as_float(u & 0xffff0000u); }
__device__ __forceinline__ float wave_sum(float v) {
#pragma unroll
    for (int o = 1; o < 64; o <<= 1) v += __shfl_xor(v, o);
    return v;
}
__device__ __forceinline__ float xmax16_32(float v) {
    auto a = __builtin_amdgcn_permlane16_swap(__float_as_uint(v), __float_as_uint(v), false, false); v = fmaxf(__uint_as_float(a[0]), __uint_as_float(a[1]));
    auto b = __builtin_amdgcn_permlane32_swap(__float_as_uint(v), __float_as_uint(v), false, false); return fmaxf(__uint_as_float(b[0]), __uint_as_float(b[1]));
}
__device__ __forceinline__ float xsum16_32(float v) {
    auto a = __builtin_amdgcn_permlane16_swap(__float_as_uint(v), __float_as_uint(v), false, false); v = __uint_as_float(a[0]) + __uint_as_float(a[1]);
    auto b = __builtin_amdgcn_permlane32_swap(__float_as_uint(v), __float_as_uint(v), false, false); return __uint_as_float(b[0]) + __uint_as_float(b[1]);
}
__device__ __forceinline__ float silu_f(float x) { return x * __builtin_amdgcn_rcpf(1.f + __builtin_amdgcn_exp2f(-1.4426950408889634f * x)); }

__device__ __forceinline__ void load_rstd(const float* PSS, int row0, int fq, float (&rstd)[2][4]) {
#pragma unroll
    for (int ai = 0; ai < 2; ++ai)
#pragma unroll
        for (int m = 0; m < 4; ++m) {
            const f32x4 t = *((const f32x4*)(PSS + (unsigned)(row0 + ai * 128 + m * 16) * 16) + fq);
            rstd[ai][m] = (t[0] + t[1]) + (t[2] + t[3]);
        }
#pragma unroll
    for (int ai = 0; ai < 2; ++ai)
#pragma unroll
        for (int m = 0; m < 4; ++m) {
            float q = rstd[ai][m]; q += __shfl_xor(q, 16); q += __shfl_xor(q, 32);
            rstd[ai][m] = 1.f / sqrtf(q * (1.f / D) + 1e-6f);
        }
}
struct TabPre { f32x4 a, b, c, d; };
__device__ __forceinline__ TabPre tab_pre_load(const unsigned char* ws, int bias_off, const pg8::Unit& u, int tid) {
    TabPre p;
    if (tid < 256) { const f32x4* pp = (const f32x4*)((const float*)(ws + WS_PSS) + (unsigned)(u.pm * 256 + tid) * 16); p.a = pp[0]; p.b = pp[1]; p.c = pp[2]; p.d = pp[3]; }
    else { const int cond = u.pm < 16 ? 0 : 1 + ((u.pm - 16) >> 2);
        p.a[0] = ((const float*)(ws + WS_BIAS))[(unsigned)(bias_off + cond * NBIAS + u.pn * 256 + (tid - 256))]; p.b = p.a; p.c = p.a; p.d = p.a; }
    return p;
}
__device__ __forceinline__ void tab_pre_store(const TabPre& p, LAS float* tab, int tid) {
    if (tid < 256) { const f32x4 t = (p.a + p.b) + (p.c + p.d); tab[tid] = 1.f / sqrtf(((t[0] + t[1]) + (t[2] + t[3])) * (1.f / D) + 1e-6f); }
    else tab[tid] = p.a[0];
}
struct EpiSwiglu {
    static constexpr bool PERM = true, AFTER_DRAIN = false, HAS_TAB = true; static constexpr int TABSZ = 512;
    typedef TabPre Pre;
    unsigned char* ws; int bias_off;
    __device__ __forceinline__ Pre pre_load(const pg8::Unit& u, int tid) const { return tab_pre_load(ws, bias_off, u, tid); }
    __device__ __forceinline__ void pre_store(const Pre& p, LAS float* tab, int tid) const { tab_pre_store(p, tab, tid); }
    __device__ __forceinline__ void operator()(const f32x4 (&acc)[2][2][4][2], const pg8::Unit& u, int wr, int wc, int fr, int fq, const LAS float* tab) const {
        bf16* ACT = (bf16*)(ws + WS_ACT);
        const int row0 = u.pm * 256 + wr * 64 + fr, j0 = u.pn * 128 + wc * 32 + 8 * fq;
        const LAS float* bp = tab + 256 + wc * 32 + 8 * fq;
        const f32x4 bg0 = *(const LAS f32x4*)bp, bg1 = *(const LAS f32x4*)(bp + 4), bu0 = *(const LAS f32x4*)(bp + 128), bu1 = *(const LAS f32x4*)(bp + 132);
#pragma unroll
        for (int ai = 0; ai < 2; ++ai)
#pragma unroll
            for (int m = 0; m < 4; ++m) {
                bf16* p = ACT + (unsigned)((row0 + ai * 128 + m * 16) * FF + j0);
                const float r = tab[wr * 64 + ai * 128 + m * 16 + fr];
                const f32x4 g0 = acc[ai][0][m][0] * r + bg0, g1 = acc[ai][0][m][1] * r + bg1, u0 = acc[ai][1][m][0] * r + bu0, u1 = acc[ai][1][m][1] * r + bu1;
                f32x4 o0, o1;
#pragma unroll
                for (int e = 0; e < 4; ++e) { o0[e] = silu_f(g0[e]) * u0[e]; o1[e] = silu_f(g1[e]) * u1[e]; }
                *(v4u*)p = pack8(o0, o1);
            }
    }
};
__device__ __forceinline__ int cond_of_row(int r) { return r < M_CTX ? 0 : 1 + ((r - M_CTX) >> 10); }
template <int TMB> struct EpiSwigluT {
    static constexpr bool PERM = true, AFTER_DRAIN = false, HAS_TAB = true; static constexpr int TABSZ = 512;
    typedef TabPre Pre;
    unsigned char* ws; int bias_off; int row_base;
    __device__ __forceinline__ Pre pre_load(const pg8::Unit& u, int tid) const {
        TabPre p; const int r0 = row_base + 64 * TMB * u.pm;
        if (tid < 256) { const int t = tid < 64 * TMB ? tid : 64 * TMB - 1; const f32x4* pp = (const f32x4*)((const float*)(ws + WS_PSS) + (unsigned)(r0 + t) * 16); p.a = pp[0]; p.b = pp[1]; p.c = pp[2]; p.d = pp[3]; }
        else { p.a[0] = ((const float*)(ws + WS_BIAS))[(unsigned)(bias_off + cond_of_row(r0) * NBIAS + u.pn * 256 + (tid - 256))]; p.b = p.a; p.c = p.a; p.d = p.a; }
        return p;
    }
    __device__ __forceinline__ void pre_store(const Pre& p, LAS float* tab, int tid) const {
        if (tid < 256) { if (tid < 64 * TMB) { const f32x4 t = (p.a + p.b) + (p.c + p.d); tab[tid] = 1.f / sqrtf(((t[0] + t[1]) + (t[2] + t[3])) * (1.f / D) + 1e-6f); } }
        else tab[tid] = p.a[0];
    }
    __device__ __forceinline__ void operator()(const f32x4 (&acc)[2][2][4][2], const pg8::Unit& u, int wr, int wc, int fr, int fq, const LAS float* tab) const {
        bf16* ACT = (bf16*)(ws + WS_ACT);
        const int rl0 = wr * 16 * TMB + fr, j0 = u.pn * 128 + wc * 32 + 8 * fq;
        const int r0 = row_base + 64 * TMB * u.pm;
        const LAS float* bp = tab + 256 + wc * 32 + 8 * fq;
        const f32x4 bg0 = *(const LAS f32x4*)bp, bg1 = *(const LAS f32x4*)(bp + 4), bu0 = *(const LAS f32x4*)(bp + 128), bu1 = *(const LAS f32x4*)(bp + 132);
#pragma unroll
        for (int ai = 0; ai < 2; ++ai)
#pragma unroll
            for (int m = 0; m < TMB; ++m) {
                const int rl = rl0 + ai * 32 * TMB + m * 16;
                bf16* p = ACT + (unsigned)((r0 + rl) * FF + j0);
                const float r = tab[rl];
                const f32x4 g0 = acc[ai][0][m][0] * r + bg0, g1 = acc[ai][0][m][1] * r + bg1, u0 = acc[ai][1][m][0] * r + bu0, u1 = acc[ai][1][m][1] * r + bu1;
                f32x4 o0, o1;
#pragma unroll
                for (int e = 0; e < 4; ++e) { o0[e] = silu_f(g0[e]) * u0[e]; o1[e] = silu_f(g1[e]) * u1[e]; }
                *(v4u*)p = pack8(o0, o1);
            }
    }
};
struct EpiRes {
    static constexpr bool PERM = true, AFTER_DRAIN = false, HAS_TAB = false;
    const float* in_ctx; const float* in_lat; unsigned char* ws; const float* gnext; int gate_off, sc_off; float gs;
    __device__ __forceinline__ void operator()(const f32x4 (&acc)[2][2][4][2], const pg8::Unit& u, int wr, int wc, int fr, int fq) const {
        const int cond = u.pm < 16 ? 0 : 1 + ((u.pm - 16) >> 2);
        float* out = (float*)(ws + WS_X); bf16* XA = (bf16*)(ws + WS_H); float* PSS = (float*)(ws + WS_PSS);
        const float* gp = (const float*)(ws + WS_MOD) + gate_off + (unsigned)cond * NMOD;
        const float* scp = (const float*)(ws + WS_MOD) + sc_off + (unsigned)cond * NMOD;
        const float* base = u.pm < 16 ? in_ctx : in_lat;
        const int row0 = u.pm * 256 + wr * 64 + fr, col0 = u.pn * 256 + wc * 32 + 8 * fq;
        float ss[2][4];
#pragma unroll
        for (int bj = 0; bj < 2; ++bj) {
            const int cb = col0 + bj * 128;
            const f32x4 gv0 = *(const f32x4*)(gp + cb) * gs, gv1 = *(const f32x4*)(gp + cb + 4) * gs;
            f32x4 an0 = (f32x4){0.f, 0.f, 0.f, 0.f}, an1 = an0;
            if (gnext) { an0 = *(const f32x4*)(gnext + cb) * (*(const f32x4*)(scp + cb) + 1.f); an1 = *(const f32x4*)(gnext + cb + 4) * (*(const f32x4*)(scp + cb + 4) + 1.f); }
#pragma unroll
            for (int ai = 0; ai < 2; ++ai)
#pragma unroll
                for (int m = 0; m < 4; ++m) {
                    const unsigned off = (unsigned)(row0 + ai * 128 + m * 16) * D + cb;
                    const f32x4 b0 = *(const f32x4*)(base + off), b1 = *(const f32x4*)(base + off + 4);
                    const f32x4 o0 = b0 + gv0 * acc[ai][bj][m][0], o1 = b1 + gv1 * acc[ai][bj][m][1];
                    *(f32x4*)(out + off) = o0; *(f32x4*)(out + off + 4) = o1;
                    if (gnext) {
                        const float q = ((o0[0] * o0[0] + o0[1] * o0[1]) + (o0[2] * o0[2] + o0[3] * o0[3])) + ((o1[0] * o1[0] + o1[1] * o1[1]) + (o1[2] * o1[2] + o1[3] * o1[3]));
                        ss[ai][m] = bj == 0 ? q : ss[ai][m] + q;
                        *(v4u*)(XA + off) = pack8(o0 * an0, o1 * an1);
                    }
                    if (m & 1) asm volatile("" ::: "memory");
                }
        }
        if (gnext) {
#pragma unroll
            for (int ai = 0; ai < 2; ++ai)
#pragma unroll
                for (int m = 0; m < 4; ++m) {
                    const float q = xsum16_32(ss[ai][m]);
                    if (fq == 0) PSS[(unsigned)(row0 + ai * 128 + m * 16) * 16 + u.pn * 4 + wc] = q;
                }
        }
    }
};
struct EpiRes3 {
    static constexpr bool PERM = true, AFTER_DRAIN = false, HAS_TAB = false;
    const float* in_ctx; const float* in_lat; unsigned char* ws; const float* gnext; int gate_off, sc_off; float gs;
    __device__ __forceinline__ void operator()(const f32x4 (&acc)[2][2][4][2], const pg8::Unit& u, int wr, int wc, int fr, int fq) const {
        float* out = (float*)(ws + WS_X); bf16* XA = (bf16*)(ws + WS_H); float* PSS = (float*)(ws + WS_PSS);
        const float* gp0 = (const float*)(ws + WS_MOD) + gate_off;
        const float* scp0 = (const float*)(ws + WS_MOD) + sc_off;
        const int rb0 = u.pm * 192 + wr * 48, col0 = u.pn * 256 + wc * 32 + 8 * fq;
        float ss[2][3];
#pragma unroll
        for (int bj = 0; bj < 2; ++bj) {
            const int cb = col0 + bj * 128;
            f32x4 gn0 = (f32x4){0.f, 0.f, 0.f, 0.f}, gn1 = gn0;
            if (gnext) { gn0 = *(const f32x4*)(gnext + cb); gn1 = *(const f32x4*)(gnext + cb + 4); }
#pragma unroll
            for (int ai = 0; ai < 2; ++ai)
#pragma unroll
                for (int m = 0; m < 3; ++m) {
                    const int rb = rb0 + ai * 96 + m * 16;
                    const int cond = rb < M_CTX ? 0 : 1 + ((rb - M_CTX) >> 10);
                    const float* base = rb < M_CTX ? in_ctx : in_lat;
                    const float* gp = gp0 + (unsigned)(cond * NMOD + cb);
                    const f32x4 gv0 = *(const f32x4*)gp * gs, gv1 = *(const f32x4*)(gp + 4) * gs;
                    const unsigned off = (unsigned)((rb + fr) * D + cb);
                    const f32x4 b0 = *(const f32x4*)(base + off), b1 = *(const f32x4*)(base + off + 4);
                    const f32x4 o0 = b0 + gv0 * acc[ai][bj][m][0], o1 = b1 + gv1 * acc[ai][bj][m][1];
                    *(f32x4*)(out + off) = o0; *(f32x4*)(out + off + 4) = o1;
                    if (gnext) {
                        const float* sp = scp0 + (unsigned)(cond * NMOD + cb);
                        const f32x4 an0 = gn0 * (*(const f32x4*)sp + 1.f), an1 = gn1 * (*(const f32x4*)(sp + 4) + 1.f);
                        const float q = ((o0[0] * o0[0] + o0[1] * o0[1]) + (o0[2] * o0[2] + o0[3] * o0[3])) + ((o1[0] * o1[0] + o1[1] * o1[1]) + (o1[2] * o1[2] + o1[3] * o1[3]));
                        ss[ai][m] = bj == 0 ? q : ss[ai][m] + q;
                        *(v4u*)(XA + off) = pack8(o0 * an0, o1 * an1);
                    }
                }
        }
        if (gnext) {
#pragma unroll
            for (int ai = 0; ai < 2; ++ai)
#pragma unroll
                for (int m = 0; m < 3; ++m) {
                    const float q = xsum16_32(ss[ai][m]);
                    if (fq == 0) PSS[(unsigned)(rb0 + ai * 96 + m * 16 + fr) * 16 + u.pn * 4 + wc] = q;
                }
        }
    }
};
struct EpiWin {
    static constexpr bool PERM = true, AFTER_DRAIN = false, HAS_TAB = true; static constexpr int TABSZ = 512;
    typedef TabPre Pre;
    unsigned char* ws; float* newk; int layer;
    __device__ __forceinline__ Pre pre_load(const pg8::Unit& u, int tid) const { return tab_pre_load(ws, layer * 9 * NBIAS + BOFF_IN, u, tid); }
    __device__ __forceinline__ void pre_store(const Pre& p, LAS float* tab, int tid) const { tab_pre_store(p, tab, tid); }
    __device__ __forceinline__ void operator()(const f32x4 (&acc)[2][2][4][2], const pg8::Unit& u, int wr, int wc, int fr, int fq, const LAS float* tab) const {
        bf16* Z = (bf16*)(ws + WS_ACT); float* newv = newk + 16 * 2 * 4 * 256 * 128;
        const float* rc = (const float*)(ws + WS_ROPE); const float* rs = rc + 1024;
        const int pn = u.pn, pm = u.pm; const bool lat = pm >= 16;
        const int row0 = pm * 256 + wr * 64 + fr;
        const LAS float* bp = tab + 256 + wc * 32 + 8 * fq;
        const LAS float* rp = tab + wr * 64 + fr;
#define WIN_BV() const f32x4 bv00 = *(const LAS f32x4*)bp, bv01 = *(const LAS f32x4*)(bp + 4), bv10 = *(const LAS f32x4*)(bp + 128), bv11 = *(const LAS f32x4*)(bp + 132)
        if (pn < 4) {
            const int lc = 256 * pn + 64 * wc + 8 * fq;
#pragma unroll
            for (int ai = 0; ai < 2; ++ai)
#pragma unroll
                for (int m = 0; m < 4; ++m) {
                    const int row = row0 + ai * 128 + m * 16; const float r = rp[ai * 128 + m * 16]; WIN_BV();
                    f32x4 a0 = acc[ai][0][m][0] * r + bv00, a1 = acc[ai][0][m][1] * r + bv01, b0 = acc[ai][1][m][0] * r + bv10, b1 = acc[ai][1][m][1] * r + bv11;
                    if (lat) {
                        const int t = (row - M_CTX) & 1023; const int pos = fq < 2 ? (t >> 6) : (t & 63);
                        const float* cp = rc + pos * 16 + 8 * (fq & 1); const float* sp = rs + pos * 16 + 8 * (fq & 1);
                        const f32x4 c0 = *(const f32x4*)cp, c1 = *(const f32x4*)(cp + 4), s0 = *(const f32x4*)sp, s1 = *(const f32x4*)(sp + 4);
                        const f32x4 na0 = a0 * c0 - b0 * s0, na1 = a1 * c1 - b1 * s1, nb0 = b0 * c0 + a0 * s0, nb1 = b1 * c1 + a1 * s1;
                        a0 = na0; a1 = na1; b0 = nb0; b1 = nb1;
                    }
                    bf16* zp = Z + (unsigned)(row * NIN + lc);
                    *(v4u*)zp = pack8(a0, a1); *(v4u*)(zp + 32) = pack8(b0, b1);
                    if (!lat && pn >= 2) {
                        const int kc = lc - 512, hh = kc >> 7, dd = kc & 127;
                        float* kp = newk + (unsigned)((((pm * 2 + layer) * 4 + hh) * 256 + (row & 255)) * 128 + dd);
                        *(f32x4*)kp = a0; *(f32x4*)(kp + 4) = a1; *(f32x4*)(kp + 32) = b0; *(f32x4*)(kp + 36) = b1;
                    }
                    asm volatile("" ::: "memory");
                }
        } else {
            const int col = 256 * pn + 32 * wc + 8 * fq;
#pragma unroll
            for (int ai = 0; ai < 2; ++ai)
#pragma unroll
                for (int m = 0; m < 4; ++m) {
                    const int row = row0 + ai * 128 + m * 16; const float r = rp[ai * 128 + m * 16]; WIN_BV();
                    const f32x4 a0 = acc[ai][0][m][0] * r + bv00, a1 = acc[ai][0][m][1] * r + bv01, b0 = acc[ai][1][m][0] * r + bv10, b1 = acc[ai][1][m][1] * r + bv11;
                    bf16* zp = Z + (unsigned)(row * NIN + col);
                    *(v4u*)zp = pack8(a0, a1); *(v4u*)(zp + 128) = pack8(b0, b1);
                    if (!lat && pn < 6) {
                        const int vc = col - 1024, hh = vc >> 7, dd = vc & 127;
                        float* vp = newv + (unsigned)((((pm * 2 + layer) * 4 + hh) * 256 + (row & 255)) * 128 + dd);
                        *(f32x4*)vp = a0; *(f32x4*)(vp + 4) = a1; *(f32x4*)(vp + 256 * 128) = b0; *(f32x4*)(vp + 256 * 128 + 4) = b1;
                    }
                    asm volatile("" ::: "memory");
                }
        }
    }
};

__device__ __forceinline__ TabPre tab_pre_load3(const unsigned char* ws, int bias_off, const pg8::Unit& u, int tid) {
    TabPre p;
    if (tid < 256) { const int t = tid < 192 ? tid : 191; const f32x4* pp = (const f32x4*)((const float*)(ws + WS_PSS) + (unsigned)(u.pm * 192 + t) * 16); p.a = pp[0]; p.b = pp[1]; p.c = pp[2]; p.d = pp[3]; }
    else { const float* bb = (const float*)(ws + WS_BIAS) + (unsigned)(bias_off + u.pn * 256 + (tid - 256));
        p.a[0] = bb[(unsigned)(cond_of_row(u.pm * 192) * NBIAS)]; p.b = p.a; p.b[0] = bb[(unsigned)(cond_of_row(u.pm * 192 + 191) * NBIAS)]; p.c = p.a; p.d = p.a; }
    return p;
}
__device__ __forceinline__ void tab_pre_store3(const TabPre& p, LAS float* tab, int tid) {
    if (tid < 256) { if (tid < 192) { const f32x4 t = (p.a + p.b) + (p.c + p.d); tab[tid] = 1.f / sqrtf(((t[0] + t[1]) + (t[2] + t[3])) * (1.f / D) + 1e-6f); } }
    else { tab[tid] = p.a[0]; tab[tid + 256] = p.b[0]; }
}
struct EpiWin3 {
    static constexpr bool PERM = true, AFTER_DRAIN = false, HAS_TAB = true; static constexpr int TABSZ = 768;
    typedef TabPre Pre;
    unsigned char* ws; float* newk; int layer;
    __device__ __forceinline__ Pre pre_load(const pg8::Unit& u, int tid) const { return tab_pre_load3(ws, layer * 9 * NBIAS + BOFF_IN, u, tid); }
    __device__ __forceinline__ void pre_store(const Pre& p, LAS float* tab, int tid) const { tab_pre_store3(p, tab, tid); }
    __device__ __forceinline__ void operator()(const f32x4 (&acc)[2][2][4][2], const pg8::Unit& u, int wr, int wc, int fr, int fq, const LAS float* tab) const {
        bf16* Z = (bf16*)(ws + WS_ACT); float* newv = newk + 16 * 2 * 4 * 256 * 128;
        const float* rc = (const float*)(ws + WS_ROPE); const float* rs = rc + 1024;
        const int pn = u.pn;
        const int rb0 = u.pm * 192 + wr * 48, cond_lo = cond_of_row(u.pm * 192);
        const LAS float* bp0 = tab + 256 + wc * 32 + 8 * fq;
        const LAS float* rp = tab + wr * 48 + fr;
#define WIN3_BV() const LAS float* bp = bp0 + (cond_of_row(rb) != cond_lo ? 256 : 0); const f32x4 bv00 = *(const LAS f32x4*)bp, bv01 = *(const LAS f32x4*)(bp + 4), bv10 = *(const LAS f32x4*)(bp + 128), bv11 = *(const LAS f32x4*)(bp + 132)
        if (pn < 4) {
            const int lc = 256 * pn + 64 * wc + 8 * fq;
#pragma unroll
            for (int ai = 0; ai < 2; ++ai)
#pragma unroll
                for (int m = 0; m < 3; ++m) {
                    const int rb = rb0 + ai * 96 + m * 16, row = rb + fr; const bool lat = rb >= M_CTX;
                    const float r = rp[ai * 96 + m * 16]; WIN3_BV();
                    f32x4 a0 = acc[ai][0][m][0] * r + bv00, a1 = acc[ai][0][m][1] * r + bv01, b0 = acc[ai][1][m][0] * r + bv10, b1 = acc[ai][1][m][1] * r + bv11;
                    if (lat) {
                        const int t = (row - M_CTX) & 1023; const int pos = fq < 2 ? (t >> 6) : (t & 63);
                        const float* cp = rc + pos * 16 + 8 * (fq & 1); const float* sp = rs + pos * 16 + 8 * (fq & 1);
                        const f32x4 c0 = *(const f32x4*)cp, c1 = *(const f32x4*)(cp + 4), s0 = *(const f32x4*)sp, s1 = *(const f32x4*)(sp + 4);
                        const f32x4 na0 = a0 * c0 - b0 * s0, na1 = a1 * c1 - b1 * s1, nb0 = b0 * c0 + a0 * s0, nb1 = b1 * c1 + a1 * s1;
                        a0 = na0; a1 = na1; b0 = nb0; b1 = nb1;
                    }
                    bf16* zp = Z + (unsigned)(row * NIN + lc);
                    *(v4u*)zp = pack8(a0, a1); *(v4u*)(zp + 32) = pack8(b0, b1);
                    if (!lat && pn >= 2) {
                        const int kc = lc - 512, hh = kc >> 7, dd = kc & 127;
                        float* kp = newk + (unsigned)(((((row >> 8) * 2 + layer) * 4 + hh) * 256 + (row & 255)) * 128 + dd);
                        *(f32x4*)kp = a0; *(f32x4*)(kp + 4) = a1; *(f32x4*)(kp + 32) = b0; *(f32x4*)(kp + 36) = b1;
                    }
                    asm volatile("" ::: "memory");
                }
        } else {
            const int col = 256 * pn + 32 * wc + 8 * fq;
#pragma unroll
            for (int ai = 0; ai < 2; ++ai)
#pragma unroll
                for (int m = 0; m < 3; ++m) {
                    const int rb = rb0 + ai * 96 + m * 16, row = rb + fr; const bool lat = rb >= M_CTX;
                    const float r = rp[ai * 96 + m * 16]; WIN3_BV();
                    const f32x4 a0 = acc[ai][0][m][0] * r + bv00, a1 = acc[ai][0][m][1] * r + bv01, b0 = acc[ai][1][m][0] * r + bv10, b1 = acc[ai][1][m][1] * r + bv11;
                    bf16* zp = Z + (unsigned)(row * NIN + col);
                    *(v4u*)zp = pack8(a0, a1); *(v4u*)(zp + 128) = pack8(b0, b1);
                    if (!lat && pn < 6) {
                        const int vc = col - 1024, hh = vc >> 7, dd = vc & 127;
                        float* vp = newv + (unsigned)(((((row >> 8) * 2 + layer) * 4 + hh) * 256 + (row & 255)) * 128 + dd);
                        *(f32x4*)vp = a0; *(f32x4*)(vp + 4) = a1; *(f32x4*)(vp + 256 * 128) = b0; *(f32x4*)(vp + 256 * 128 + 4) = b1;
                    }
                    asm volatile("" ::: "memory");
                }
        }
#undef WIN3_BV
    }
};

__device__ __forceinline__ void p0_mod(LAS unsigned char* lds, KArgs A, int tid) {
    LAS float* sc = (LAS float*)lds;
    LAS float* red = (LAS float*)(lds + 36864);
    for (int idx = tid; idx < 9 * 1024; idx += NTHREADS) { const int c = idx >> 10, k = idx & 1023; const float x = c == 0 ? A->in[5][k] : A->in[4][(c - 1) * 1024 + k]; sc[idx] = x / (1.f + __expf(-x)); }
    __syncthreads();
    float* MOD = (float*)(A->ws + WS_MOD);
    for (int it = blockIdx.x; it < 256; it += gridDim.x) {
        const int l = it >> 7, col0 = (it & 127) * 72;
        if (tid < 504) {
            const int kg = tid / 18, c4 = tid % 18;
            f32x4 acc[9];
#pragma unroll
            for (int c = 0; c < 9; ++c) acc[c] = (f32x4){0.f, 0.f, 0.f, 0.f};
            const float* wp = A->in[6] + (size_t)l * 1024 * NMOD + col0 + 4 * c4;
#pragma unroll 4
            for (int k = kg; k < 1024; k += 28) {
                const f32x4 w = *(const f32x4*)(wp + (size_t)k * NMOD);
#pragma unroll
                for (int c = 0; c < 9; ++c) acc[c] += w * sc[c * 1024 + k];
            }
#pragma unroll
            for (int c = 0; c < 9; ++c)
#pragma unroll
                for (int e = 0; e < 4; ++e) red[(kg * 9 + c) * 72 + 4 * c4 + e] = acc[c][e];
        }
        __syncthreads();
        for (int idx = tid; idx < 648; idx += NTHREADS) {
            const int c = idx / 72, j = idx % 72; float s = A->in[7][l * NMOD + col0 + j];
            for (int kg = 0; kg < 28; ++kg) s += red[(kg * 9 + c) * 72 + j];
            MOD[(size_t)(l * 9 + c) * NMOD + col0 + j] = s;
        }
        __syncthreads();
    }
}
__device__ __forceinline__ void transpose_item(const float* W, int K, int N, bf16* WT, LAS float* scr, int item, int lane, int kind) {
    const int nblk = N / 32, kb = item / nblk, nb = item % nblk, k0 = 64 * kb, n0 = 32 * nb;
    int ln0 = n0;
    if (kind == 1) { const int pn = n0 >> 8, w = n0 & 255; ln0 = (w >> 7) * FF + 128 * pn + (w & 127); }
    else if (kind == 2 && n0 < 1024) { const int pn = n0 >> 8, w = n0 & 255; ln0 = 256 * pn + 64 * ((w & 127) >> 5) + 32 * (w >> 7); }
#pragma unroll 8
    for (int i = 0; i < 32; ++i) { const int kk = 2 * i + (lane >> 5); scr[kk * 33 + (lane & 31)] = W[(size_t)(k0 + kk) * N + ln0 + (lane & 31)]; }
    asm volatile("s_waitcnt lgkmcnt(0)" ::: "memory");
    const int c = lane & 7;
#pragma unroll
    for (int j = 0; j < 4; ++j) { const int n = (lane >> 3) + 8 * j; const LAS float* s = scr + (8 * c) * 33 + n;
        v4u o; o.x = pk2(s[0 * 33], s[1 * 33]); o.y = pk2(s[2 * 33], s[3 * 33]); o.z = pk2(s[4 * 33], s[5 * 33]); o.w = pk2(s[6 * 33], s[7 * 33]);
        *(v4u*)(WT + (size_t)(n0 + n) * K + k0 + 8 * c) = o; }
    asm volatile("s_waitcnt lgkmcnt(0)" ::: "memory");
}
__device__ __forceinline__ void p0_weights(LAS unsigned char* lds, KArgs A, int gw, int NGW, int wave, int lane) {
    LAS float* scr = (LAS float*)(lds + wave * 16384);
    constexpr int I_GU = 16 * 176, I_D = 44 * 32, I_IN = 16 * 88, I_OUT = 16 * 32, I_LAYER = 2 * I_GU + 2 * I_D + I_IN + I_OUT;
    for (int it = gw; it < 2 * I_LAYER; it += NGW) {
        const int l = it / I_LAYER; int r = it % I_LAYER;
        unsigned char* wl = A->ws + WS_W + (size_t)l * W_LAYER;
        if (r < I_GU) { transpose_item(A->in[9] + (size_t)l * D * NGU, D, NGU, (bf16*)(wl + W_GU1), scr, r, lane, 1); continue; } r -= I_GU;
        if (r < I_D) { transpose_item(A->in[10] + (size_t)l * FF * D, FF, D, (bf16*)(wl + W_D1), scr, r, lane, 0); continue; } r -= I_D;
        if (r < I_IN) { transpose_item(A->in[13] + (size_t)l * D * NIN, D, NIN, (bf16*)(wl + W_IN), scr, r, lane, 2); continue; } r -= I_IN;
        if (r < I_OUT) { transpose_item(A->in[14] + (size_t)l * D * D, D, D, (bf16*)(wl + W_OUT), scr, r, lane, 0); continue; } r -= I_OUT;
        if (r < I_GU) { transpose_item(A->in[11] + (size_t)l * D * NGU, D, NGU, (bf16*)(wl + W_GU2), scr, r, lane, 1); continue; } r -= I_GU;
        transpose_item(A->in[12] + (size_t)l * FF * D, FF, D, (bf16*)(wl + W_D2), scr, r, lane, 0);
    }
}

__device__ __forceinline__ void xa_phase(const float* in_ctx, const float* in_lat, const float* g, const float* modl, int isc, bf16* XA, float* PSS, int gw, int NGW, int lane) {
    asm volatile("" : "+v"(lane));
    for (int m = gw; m < M; m += NGW) {
        const float* xrow = (m < M_CTX ? in_ctx : in_lat) + (size_t)m * D;
        const int cond = m < M_CTX ? 0 : 1 + ((m - M_CTX) >> 10);
        const f32x4* sc4 = (const f32x4*)(modl + (size_t)cond * NMOD + isc * 1024);
        const f32x4* g4 = (const f32x4*)g; const f32x4* x4 = (const f32x4*)xrow;
        f32x4 v[4]; float ss = 0.f;
#pragma unroll
        for (int j = 0; j < 4; ++j) { v[j] = x4[lane + 64 * j]; ss += (v[j].x * v[j].x + v[j].y * v[j].y) + (v[j].z * v[j].z + v[j].w * v[j].w); }
        ss = wave_sum(ss);
        if (lane < 16) PSS[(size_t)m * 16 + lane] = lane == 0 ? ss : 0.f;
        v2u* o = (v2u*)(XA + (size_t)m * D);
#pragma unroll
        for (int j = 0; j < 4; ++j) {
            const int k4 = lane + 64 * j;
            const f32x4 r = v[j] * g4[k4] * (sc4[k4] + 1.f);
            v2u w; w.x = pk2(r.x, r.y); w.y = pk2(r.z, r.w); o[k4] = w;
        }
    }
}
__device__ __forceinline__ void bias_phase(LAS unsigned char* lds, KArgs A, int bxv, int G, int tid, int wave, int lane) {
    const int combo = bxv % 6, l = combo / 3, sidx = combo % 3;
    const int N = sidx == 1 ? NIN : NGU;
    const int boff = sidx == 0 ? BOFF_GU1 : (sidx == 1 ? BOFF_IN : BOFF_GU2);
    const bf16* Wt = (const bf16*)(A->ws + WS_W + (size_t)l * W_LAYER + (sidx == 0 ? W_GU1 : (sidx == 1 ? W_IN : W_GU2)));
    const float* MOD = (const float*)(A->ws + WS_MOD) + (size_t)l * 9 * NMOD + sidx * 3 * 1024;
    float* BIAS = (float*)(A->ws + WS_BIAS) + (size_t)l * 9 * NBIAS + boff;
    LAS bf16* shh = (LAS bf16*)lds;
    LAS bf16* shl = (LAS bf16*)(lds + 32768);
    __syncthreads();
    for (int idx = tid; idx < 16 * 1024; idx += NTHREADS) {
        const int c = idx >> 10, k = idx & 1023;
        const float v = c < 9 ? MOD[(size_t)c * NMOD + k] : 0.f;
        const unsigned hi = pk2(v, 0.f) & 0xffffu; const float r = v - __uint_as_float(hi << 16);
        shh[idx] = (bf16)hi; shl[idx] = (bf16)(pk2(r, 0.f) & 0xffffu);
    }
    __syncthreads();
    const int i16 = lane & 15, kg = lane >> 4;
    const int nwg = (G - combo + 5) / 6;
    const int wslot = (bxv / 6) * 8 + wave, nslots = nwg * 8;
    for (int task = wslot; task < N / 16; task += nslots) {
        const bf16* wp = Wt + (size_t)(task * 16 + i16) * D + 8 * kg;
        f32x4 acc = (f32x4){0.f, 0.f, 0.f, 0.f};
#pragma unroll 8
        for (int ks = 0; ks < 32; ++ks) {
            const bf16x8 a = *(const bf16x8*)(wp + 32 * ks);
            const bf16x8 bh = *(const LAS bf16x8*)(shh + i16 * 1024 + 32 * ks + 8 * kg), bl = *(const LAS bf16x8*)(shl + i16 * 1024 + 32 * ks + 8 * kg);
            acc = __builtin_amdgcn_mfma_f32_16x16x32_bf16(a, bh, acc, 0, 0, 0);
            acc = __builtin_amdgcn_mfma_f32_16x16x32_bf16(a, bl, acc, 0, 0, 0);
        }
        if (i16 < 9) *(f32x4*)(BIAS + (size_t)i16 * NBIAS + task * 16 + 4 * kg) = acc;
    }
    __syncthreads();
}
__device__ __forceinline__ void final_norm(const float* X, const float* g, float* out, int gw, int NGW, int lane) {
    for (int m = gw; m < M; m += NGW) {
        const f32x4* x4 = (const f32x4*)(X + (size_t)m * D); const f32x4* g4 = (const f32x4*)g;
        f32x4 v[4]; float ss = 0.f;
#pragma unroll
        for (int j = 0; j < 4; ++j) { v[j] = x4[lane + 64 * j]; ss += (v[j].x * v[j].x + v[j].y * v[j].y) + (v[j].z * v[j].z + v[j].w * v[j].w); }
        const float rstd = 1.f / sqrtf(wave_sum(ss) * (1.f / D) + 1e-6f);
        f32x4* o = (f32x4*)(out + (size_t)m * D);
#pragma unroll
        for (int j = 0; j < 4; ++j) o[lane + 64 * j] = v[j] * rstd * g4[lane + 64 * j];
    }
}

__device__ __forceinline__ unsigned off_b(unsigned row, unsigned ch) { return 256u * row + 16u * (ch ^ (((row & 3u) << 2) | ((0u - (row >> 2)) & 3u))); }
__device__ __forceinline__ s16x4 vtr(const LAS unsigned char* p) { return __builtin_bit_cast(s16x4, __builtin_amdgcn_ds_read_tr16_b64_v4i16((LAS s16x4*)p)); }

__device__ __forceinline__ void attn_item(LAS unsigned char* lds, KArgs A, int l, bool isLat, int b, int h, int qb, float lam, float oml, int tid, int wave, int lane) {
    const bf16* Z = (const bf16*)(A->ws + WS_ACT);
    bf16* Y = (bf16*)(A->ws + WS_Y);
    const int i16 = lane & 15, kg = lane >> 4;
    const int seq0 = isLat ? M_CTX + b * 1024 : b * 256;
    const int qrow = seq0 + qb * 128 + wave * 16 + i16;
    bf16x8 qf[4];
#pragma unroll
    for (int s = 0; s < 4; ++s) qf[s] = *(const bf16x8*)(Z + (size_t)qrow * NIN + h * 128 + 32 * s + 8 * kg);
    const int NT = isLat ? 20 : 4;
    const size_t coff = (size_t)((b * 2 + l) * 4 + h) * 256 * 128;
    const float* ck = A->in[2] + coff; const float* cv = A->in[3] + coff;
    const int sr = tid >> 4, sch = tid & 15;
    const unsigned sd0 = off_b(sr, sch), sd1 = off_b(sr + 32, sch);
    unsigned koff[4], voff[8];
#pragma unroll
    for (int s = 0; s < 4; ++s) koff[s] = off_b(i16, 4 * s + kg);
    { const int q_ = i16 >> 2, p = lane & 3;
#pragma unroll
      for (int c = 0; c < 8; ++c) voff[c] = 32768u + off_b(4 * kg + q_, 2 * c + (p >> 1)) + 8 * (p & 1); }
    v4u kreg[2], vreg[2];
#define ATT_LOAD(t) do { \
        if (isLat && (t) < 4) { \
            _Pragma("unroll") for (int i_ = 0; i_ < 2; ++i_) { const int key = 64 * (t) + sr + 32 * i_; \
                const float* pk = ck + key * 128 + sch * 8; const float* pv = cv + key * 128 + sch * 8; \
                kreg[i_] = pack8(*(const f32x4*)pk, *(const f32x4*)(pk + 4)); vreg[i_] = pack8(*(const f32x4*)pv, *(const f32x4*)(pv + 4)); } \
        } else { \
            _Pragma("unroll") for (int i_ = 0; i_ < 2; ++i_) { const size_t row = seq0 + 64 * (isLat ? (t) - 4 : (t)) + sr + 32 * i_; \
                kreg[i_] = *(const v4u*)(Z + row * NIN + 512 + h * 128 + sch * 8); vreg[i_] = *(const v4u*)(Z + row * NIN + 1024 + h * 128 + sch * 8); } \
        } } while (0)
#define ATT_STORE(bi) do { \
        *(LAS v4u*)(lds + (bi) * 16384 + sd0) = kreg[0]; *(LAS v4u*)(lds + (bi) * 16384 + sd1) = kreg[1]; \
        *(LAS v4u*)(lds + 32768 + (bi) * 16384 + sd0) = vreg[0]; *(LAS v4u*)(lds + 32768 + (bi) * 16384 + sd1) = vreg[1]; } while (0)
    f32x4 O[2][8];
#pragma unroll
    for (int mp = 0; mp < 2; ++mp)
#pragma unroll
        for (int c = 0; c < 8; ++c) O[mp][c] = (f32x4){0.f, 0.f, 0.f, 0.f};
    float mrun[2] = {-INFINITY, -INFINITY}, lsum[2] = {0.f, 0.f};
    const float c2 = 0.125f * 1.4426950408889634f;
    ATT_LOAD(0); ATT_STORE(0); __syncthreads();
    for (int t = 0; t < NT; ++t) {
        const int bi = t & 1;
        if (t + 1 < NT) ATT_LOAD(t + 1);
        const LAS unsigned char* kb_ = lds + bi * 16384;
        const LAS unsigned char* vb_ = lds + bi * 16384;
        bf16x8 kf[4][4];
#pragma unroll
        for (int kb = 0; kb < 4; ++kb)
#pragma unroll
            for (int s = 0; s < 4; ++s) kf[kb][s] = *(const LAS bf16x8*)(kb_ + kb * 4096 + koff[s]);
        __builtin_amdgcn_sched_barrier(0);
        f32x4 S[2][4];
#pragma unroll
        for (int mp = 0; mp < 2; ++mp)
#pragma unroll
            for (int kb = 0; kb < 4; ++kb) {
                S[mp][kb] = __builtin_amdgcn_mfma_f32_16x16x32_bf16(kf[kb][2 * mp], qf[2 * mp], (f32x4){0.f, 0.f, 0.f, 0.f}, 0, 0, 0);
                S[mp][kb] = __builtin_amdgcn_mfma_f32_16x16x32_bf16(kf[kb][2 * mp + 1], qf[2 * mp + 1], S[mp][kb], 0, 0, 0);
            }
        s16x4 va[8][2], vc[8][2];
#pragma unroll
        for (int c = 0; c < 8; ++c) { va[c][0] = vtr(vb_ + voff[c]); va[c][1] = vtr(vb_ + 256 * 16 + voff[c]); }
        __builtin_amdgcn_sched_barrier(0);
        bf16x8 pb[2][2];
#pragma unroll
        for (int mp = 0; mp < 2; ++mp) {
            float mx = fmaxf(fmaxf(S[mp][0][0], S[mp][0][1]), fmaxf(S[mp][0][2], S[mp][0][3]));
#pragma unroll
            for (int kb = 1; kb < 4; ++kb) mx = fmaxf(mx, fmaxf(fmaxf(S[mp][kb][0], S[mp][kb][1]), fmaxf(S[mp][kb][2], S[mp][kb][3])));
            mx = xmax16_32(mx);
            const float tm = mx * c2;
            if (__builtin_amdgcn_ballot_w64(tm > mrun[mp] + 8.f) != 0ull) {
                const float mnew = fmaxf(mrun[mp], tm);
                const float alpha = __builtin_amdgcn_exp2f(mrun[mp] - mnew);
                mrun[mp] = mnew; lsum[mp] *= alpha;
#pragma unroll
                for (int c = 0; c < 8; ++c) O[mp][c] *= alpha;
            }
            const float mref = mrun[mp];
            float ps = 0.f;
#pragma unroll
            for (int kb = 0; kb < 4; ++kb)
#pragma unroll
                for (int e = 0; e < 4; ++e) { S[mp][kb][e] = __builtin_amdgcn_exp2f(S[mp][kb][e] * c2 - mref); ps += S[mp][kb][e]; }
            lsum[mp] += ps;
#pragma unroll
            for (int ks = 0; ks < 2; ++ks) { const v4u w = pack8(S[mp][2 * ks], S[mp][2 * ks + 1]); pb[mp][ks] = __builtin_bit_cast(bf16x8, w); }
        }
        __builtin_amdgcn_sched_barrier(0);
#pragma unroll
        for (int c = 0; c < 8; ++c) { vc[c][0] = vtr(vb_ + 256 * 32 + voff[c]); vc[c][1] = vtr(vb_ + 256 * 48 + voff[c]); }
#pragma unroll
        for (int c = 0; c < 8; ++c) {
            const bf16x8 vf = (bf16x8){va[c][0][0], va[c][0][1], va[c][0][2], va[c][0][3], va[c][1][0], va[c][1][1], va[c][1][2], va[c][1][3]};
            O[0][c] = __builtin_amdgcn_mfma_f32_16x16x32_bf16(vf, pb[0][0], O[0][c], 0, 0, 0);
            O[1][c] = __builtin_amdgcn_mfma_f32_16x16x32_bf16(vf, pb[1][0], O[1][c], 0, 0, 0);
        }
        __builtin_amdgcn_sched_barrier(0);
#pragma unroll
        for (int c = 0; c < 8; ++c) {
            const bf16x8 vf = (bf16x8){vc[c][0][0], vc[c][0][1], vc[c][0][2], vc[c][0][3], vc[c][1][0], vc[c][1][1], vc[c][1][2], vc[c][1][3]};
            O[0][c] = __builtin_amdgcn_mfma_f32_16x16x32_bf16(vf, pb[0][1], O[0][c], 0, 0, 0);
            O[1][c] = __builtin_amdgcn_mfma_f32_16x16x32_bf16(vf, pb[1][1], O[1][c], 0, 0, 0);
        }
        __builtin_amdgcn_sched_barrier(0);
        if (t + 1 < NT) ATT_STORE(bi ^ 1);
        __syncthreads();
    }
#undef ATT_LOAD
#undef ATT_STORE
    float l1 = lsum[0], l2 = lsum[1];
    l1 += __shfl_xor(l1, 16); l1 += __shfl_xor(l1, 32); l2 += __shfl_xor(l2, 16); l2 += __shfl_xor(l2, 32);
    const float r1 = 1.f / l1, r2 = lam / l2;
    float ss = 0.f;
#pragma unroll
    for (int c = 0; c < 8; ++c) { O[0][c] = O[0][c] * r1 - O[1][c] * r2; ss += (O[0][c][0] * O[0][c][0] + O[0][c][1] * O[0][c][1]) + (O[0][c][2] * O[0][c][2] + O[0][c][3] * O[0][c][3]); }
    ss += __shfl_xor(ss, 16); ss += __shfl_xor(ss, 32);
    const float rstd = oml / sqrtf(ss * (1.f / 128.f) + 1e-6f);
    const float* gsub = A->in[16] + (size_t)(l * 4 + h) * 128;
    bf16* yp = Y + (size_t)qrow * D + h * 128 + 4 * kg;
#pragma unroll
    for (int c = 0; c < 8; ++c) {
        const f32x4 gv = *(const f32x4*)(gsub + 16 * c + 4 * kg);
        const f32x4 o = O[0][c] * rstd * gv;
        v2u w; w.x = pk2(o[0], o[1]); w.y = pk2(o[2], o[3]);
        *(v2u*)(yp + 16 * c) = w;
    }
}

__device__ __forceinline__ void bc_item(LAS unsigned char* lds, KArgs A, int l, int n, int g, int tid, int wave, int lane) {
    asm volatile("" : "+v"(tid)); asm volatile("" : "+v"(lane));
    const bf16* Z = (const bf16*)(A->ws + WS_ACT);
    bf16* Y = (bf16*)(A->ws + WS_Y);
    LAS unsigned char* VC = lds;
    const int r0 = n * 128;
    const int i16 = lane & 15, kg = lane >> 4;
    v4u vcr[2];
#pragma unroll
    for (int i = 0; i < 2; ++i) { const int idx = tid + NTHREADS * i, q = idx >> 3, ch = idx & 7; vcr[i] = *(const v4u*)(Z + (unsigned)((r0 + q) * NIN + 2560 + g * 64 + ch * 8)); }
    const float* wrow = A->in[18] + (unsigned)(((l * 4 + g) * 128 + 16 * wave + i16) * 128 + 8 * kg);
    f32x4 wr_[4][2];
#pragma unroll
    for (int ks = 0; ks < 4; ++ks) { wr_[ks][0] = *(const f32x4*)(wrow + 32 * ks); wr_[ks][1] = *(const f32x4*)(wrow + 32 * ks + 4); }
    const int rowm = r0 + 16 * wave + i16;
    const float bias = A->in[19][(l * 4 + g) * 128 + 16 * wave + i16];
    v2u uu[4];
#pragma unroll
    for (int cb = 0; cb < 4; ++cb) uu[cb] = *(const v2u*)(Z + (unsigned)(rowm * NIN + 2304 + g * 64 + 16 * cb + 4 * kg));
    const int p = tid >> 2, cq = tid & 3;
    const int rowc = r0 + p; const int cc = g * 64 + cq * 16;
    const int seqlen = n < 32 ? 256 : 1024; const int tpos = n < 32 ? (rowc & 255) : ((rowc - M_CTX) & 1023);
    const bool hasp = tpos > 0, hasn = tpos < seqlen - 1;
    const bf16* zr = Z + (unsigned)(rowc * NIN + cc);
    const bf16* zp = hasp ? zr - NIN : zr; const bf16* zn = hasn ? zr + NIN : zr;
    v4u gb[2], gc0[2], hc0[2], gc1[2], hc1[2], gc2[2], hc2[2];
#pragma unroll
    for (int hf = 0; hf < 2; ++hf) {
        gb[hf] = *(const v4u*)(zr + 1536 + 8 * hf);
        gc1[hf] = *(const v4u*)(zr + 1792 + 8 * hf); hc1[hf] = *(const v4u*)(zr + 2048 + 8 * hf);
        gc0[hf] = *(const v4u*)(zp + 1792 + 8 * hf); hc0[hf] = *(const v4u*)(zp + 2048 + 8 * hf);
        gc2[hf] = *(const v4u*)(zn + 1792 + 8 * hf); hc2[hf] = *(const v4u*)(zn + 2048 + 8 * hf);
    }
#pragma unroll
    for (int i = 0; i < 2; ++i) { const int idx = tid + NTHREADS * i, q = idx >> 3, ch = idx & 7; *(LAS v4u*)(VC + q * 128 + ch * 16) = vcr[i]; }
    bf16x8 wf[4];
#pragma unroll
    for (int ks = 0; ks < 4; ++ks) { const v4u w = pack8(wr_[ks][0], wr_[ks][1]); wf[ks] = __builtin_bit_cast(bf16x8, w); }
    __syncthreads();
    f32x4 acc[4];
#pragma unroll
    for (int cb = 0; cb < 4; ++cb) acc[cb] = (f32x4){0.f, 0.f, 0.f, 0.f};
    const LAS unsigned char* vb = VC + (8 * kg + (i16 >> 2)) * 128 + 8 * (lane & 3);
#pragma unroll
    for (int ks = 0; ks < 4; ++ks)
#pragma unroll
        for (int cb = 0; cb < 4; ++cb) {
            const s16x4 lo = vtr(vb + (32 * ks) * 128 + 32 * cb), hi = vtr(vb + (32 * ks + 4) * 128 + 32 * cb);
            const bf16x8 vf = (bf16x8){lo[0], lo[1], lo[2], lo[3], hi[0], hi[1], hi[2], hi[3]};
            acc[cb] = __builtin_amdgcn_mfma_f32_16x16x32_bf16(vf, wf[ks], acc[cb], 0, 0, 0);
        }
#pragma unroll
    for (int cb = 0; cb < 4; ++cb) {
        v2u o; o.x = pk2(bflo(uu[cb].x) * (acc[cb][0] + bias), bfhi(uu[cb].x) * (acc[cb][1] + bias)); o.y = pk2(bflo(uu[cb].y) * (acc[cb][2] + bias), bfhi(uu[cb].y) * (acc[cb][3] + bias));
        *(v2u*)(Y + (unsigned)(rowm * D + 768 + g * 64 + 16 * cb + 4 * kg)) = o;
    }
    {
        const float* cw = A->in[17] + (unsigned)(l * 3 * 256 + cc);
        const float mp_ = hasp ? 1.f : 0.f, mn_ = hasn ? 1.f : 0.f;
#pragma unroll
        for (int hf = 0; hf < 2; ++hf) {
            const f32x4 w0a = *(const f32x4*)(cw + 8 * hf) * mp_, w0b = *(const f32x4*)(cw + 8 * hf + 4) * mp_;
            const f32x4 w1a = *(const f32x4*)(cw + 256 + 8 * hf), w1b = *(const f32x4*)(cw + 256 + 8 * hf + 4);
            const f32x4 w2a = *(const f32x4*)(cw + 512 + 8 * hf) * mn_, w2b = *(const f32x4*)(cw + 512 + 8 * hf + 4) * mn_;
            v4u o;
#pragma unroll
            for (int e = 0; e < 4; ++e) {
                const float wl0 = e < 2 ? w0a[2 * e] : w0b[2 * e - 4], wh0 = e < 2 ? w0a[2 * e + 1] : w0b[2 * e - 3];
                const float wl1 = e < 2 ? w1a[2 * e] : w1b[2 * e - 4], wh1 = e < 2 ? w1a[2 * e + 1] : w1b[2 * e - 3];
                const float wl2 = e < 2 ? w2a[2 * e] : w2b[2 * e - 4], wh2 = e < 2 ? w2a[2 * e + 1] : w2b[2 * e - 3];
                const float lo = bflo(gb[hf][e]) * (wl0 * bflo(gc0[hf][e]) * bflo(hc0[hf][e]) + wl1 * bflo(gc1[hf][e]) * bflo(hc1[hf][e]) + wl2 * bflo(gc2[hf][e]) * bflo(hc2[hf][e]));
                const float hi = bfhi(gb[hf][e]) * (wh0 * bfhi(gc0[hf][e]) * bfhi(hc0[hf][e]) + wh1 * bfhi(gc1[hf][e]) * bfhi(hc1[hf][e]) + wh2 * bfhi(gc2[hf][e]) * bfhi(hc2[hf][e]));
                o[e] = pk2(lo, hi);
            }
            *(v4u*)(Y + (unsigned)(rowc * D + 512 + cc + 8 * hf)) = o;
        }
    }
    __syncthreads();
}

__device__ __forceinline__ void mixer_phase(LAS unsigned char* lds, KArgs A, int l, int vcu, int G, int tid, int wave, int lane) {
    asm volatile("" : "+v"(tid)); lane = tid & 63; wave = __builtin_amdgcn_readfirstlane(tid >> 6);
    const float lam_init = __uint_as_float(__builtin_amdgcn_readfirstlane(l == 0 ? 0x3e4ccccdu : 0x3eb60549u));
    const float* lp = A->in[15] + (size_t)l * 256;
    const float s01 = wave_sum(lp[lane] * lp[64 + lane]), s23 = wave_sum(lp[128 + lane] * lp[192 + lane]);
    const float lam = __uint_as_float(__builtin_amdgcn_readfirstlane(__float_as_uint(__expf(s01) - __expf(s23) + lam_init)));
    const float oml = __uint_as_float(__builtin_amdgcn_readfirstlane(l == 0 ? 0x3f4ccccdu : 0x3f24fd5cu));
    for (int it = vcu; it < 768; it += G) {
        if (it < 256) attn_item(lds, A, l, true, it >> 5, (it >> 3) & 3, it & 7, lam, oml, tid, wave, lane);
        else if (it < 384) { const int j = it - 256; attn_item(lds, A, l, false, j >> 3, (j >> 1) & 3, j & 1, lam, oml, tid, wave, lane); }
        else { const int j = it - 384; bc_item(lds, A, l, j >> 2, j & 3, tid, wave, lane); }
    }
}

#define XB_TMO      128
#define XB_XCNT(j)  (256  + 64 * (j))
#define XB_XSUB(j)  (1280 + 64 * (j))
#define XB_XGEN(j)  (2304 + 64 * (j))
#define XB_TOP      3328
#define XB_TOPGEN   3392
#define XCD_BAR_WORDS 3456
#define XB_SPIN_CAP (1u << 18)

__device__ __forceinline__ unsigned xb_ld(unsigned* p)              { return __hip_atomic_load(p, __ATOMIC_RELAXED, __HIP_MEMORY_SCOPE_AGENT); }
__device__ __forceinline__ unsigned xb_add(unsigned* p, unsigned v) { return __hip_atomic_fetch_add(p, v, __ATOMIC_RELAXED, __HIP_MEMORY_SCOPE_AGENT); }
__device__ __forceinline__ unsigned xb_xcc_id() { return (unsigned)__builtin_amdgcn_s_getreg((3 << 11) | 20) & 0xFu; }
#define XB_SPIN(cond, bar) do { unsigned _sp = 0; while (cond) { __builtin_amdgcn_s_sleep(1); \
    if ((++_sp & 255u) == 0u) { if (xb_ld(&(bar)[XB_TMO])) break; if (_sp > XB_SPIN_CAP) { atomicAdd(&(bar)[XB_TMO], 1u); break; } } } } while (0)

struct XcdBarrier {
    unsigned* bar; unsigned x;
    volatile LAS unsigned* st;
};

__device__ __forceinline__ XcdBarrier xcd_barrier_post(unsigned* bar, volatile LAS unsigned* st, bool leader) {
    XcdBarrier b; b.bar = bar; b.x = xb_xcc_id(); b.st = st;
    if (leader) (void)xb_add(&bar[XB_XCNT(b.x)], 1u);
    return b;
}
__device__ __forceinline__ void xcd_barrier_complete(unsigned* bar, unsigned x, unsigned& nloc, unsigned& nx) {
    const unsigned G = gridDim.x * gridDim.y * gridDim.z;
    unsigned sum, cnt, mine, sp = 0u;
    for (;;) {
        sum = 0u; cnt = 0u; mine = 0u;
#pragma unroll
        for (unsigned j = 0; j < 16; ++j) { const unsigned c = xb_ld(&bar[XB_XCNT(j)]); sum += c; cnt += (c > 0u) ? 1u : 0u; mine = (j == x) ? c : mine; }
        if (sum == G) break;
        __builtin_amdgcn_s_sleep(1);
        if ((++sp & 255u) == 0u) { if (xb_ld(&bar[XB_TMO])) break; if (sp > XB_SPIN_CAP) { atomicAdd(&bar[XB_TMO], 1u); break; } }
    }
    nloc = mine > 0u ? mine : 1u; nx = cnt > 0u ? cnt : 1u;
}

__device__ __forceinline__ void xcd_barrier(const XcdBarrier& b, bool leader) {
    asm volatile("s_waitcnt vmcnt(0)" ::: "memory");
    __syncthreads();
    if (leader) {
        unsigned* bar = b.bar;
        __builtin_amdgcn_s_waitcnt(0);
        unsigned nloc = b.st[0], nx = b.st[1];
        if (nloc == 0u) { xcd_barrier_complete(bar, b.x, nloc, nx); b.st[0] = nloc; b.st[1] = nx; }
        const unsigned old = xb_add(&bar[XB_XSUB(b.x)], 1u);
        const unsigned gen = old / nloc;
        if (old + 1u == (gen + 1u) * nloc) {
            __builtin_amdgcn_fence(__ATOMIC_RELEASE, "agent");
            asm volatile("s_waitcnt vmcnt(0)" ::: "memory");
            const unsigned og = xb_add(&bar[XB_TOP], 1u);
            const unsigned tg = og / nx;
            if (og + 1u == (tg + 1u) * nx) xb_add(&bar[XB_TOPGEN], 1u);
            else XB_SPIN(xb_ld(&bar[XB_TOPGEN]) == tg, bar);
            __builtin_amdgcn_fence(__ATOMIC_ACQUIRE, "agent");
            xb_add(&bar[XB_XGEN(b.x)], 1u);
            asm volatile("s_waitcnt vmcnt(0)" ::: "memory");
        } else {
            XB_SPIN(xb_ld(&bar[XB_XGEN(b.x)]) == gen, bar);
            __builtin_amdgcn_fence(__ATOMIC_ACQUIRE, "agent");
            asm volatile("s_waitcnt vmcnt(0)" ::: "memory");
        }
    }
    __syncthreads();
}

#ifndef PHMASK
#define PHMASK 0xffff
#endif
#define PH(k) ((PHMASK >> (k)) & 1)
#ifndef PROBE
#define PROBE 0
#endif
#define GSYNC() do { XcdBarrier b_; b_.bar = (unsigned*)kargs()->ws; { unsigned x_ = bar_x; asm volatile("" : "+s"(x_)); b_.x = x_; } b_.st = (volatile LAS unsigned*)(lds + 131072); xcd_barrier(b_, TID() == 0); } while (0)
__global__ void __launch_bounds__(NTHREADS, 2) fwd_megakernel(Args A_byval) {
    extern __shared__ __attribute__((aligned(16))) unsigned char lds_raw[];
    LAS unsigned char* lds = (LAS unsigned char*)lds_raw;
    cg::grid_group grid = cg::this_grid();
    const int wid_s = __builtin_amdgcn_readfirstlane((int)threadIdx.x >> 6);
#define TID() (wid_s * 64 + lane_id_fresh())
    const int G = gridDim.x, bx = blockIdx.x;
    const int vcu = (G % 8 == 0) ? (bx % 8) * (G / 8) + bx / 8 : bx;
#define WAVE() wid_s
#define WSP(off) (kargs()->ws + (off))
#define INP(i) (kargs()->in[i])

    { const int t_ = TID(); if (t_ < 64) ((LAS unsigned*)(lds + 131072))[t_] = 0u; }
    __syncthreads();
    const unsigned bar_x = xcd_barrier_post((unsigned*)WSP(0), (volatile LAS unsigned*)(lds + 131072), TID() == 0).x;
    if (kargs()->ws == nullptr) grid.sync();

    if (PH(0)) p0_mod(lds, kargs(), TID());
    if (bx == G - 1) {
        float* RC = (float*)WSP(WS_ROPE);
        for (int idx = TID(); idx < 1024; idx += NTHREADS) {
            const int pos = idx >> 4, i = idx & 15;
            const float inv = exp2f(-(float)i * (13.287712379549449f / 16.f));
            float rev = (float)pos * inv * 0.15915494309189535f; rev -= floorf(rev);
            RC[idx] = __builtin_amdgcn_cosf(rev); RC[1024 + idx] = __builtin_amdgcn_sinf(rev);
        }
    }
    if (PH(1)) p0_weights(lds, kargs(), vcu * 8 + WAVE(), G * 8, WAVE(), (TID() & 63));
    GSYNC();
    bias_phase(lds, kargs(), bx, G, TID(), WAVE(), (TID() & 63));
    xa_phase(INP(0), INP(1) - (size_t)M_CTX * D, INP(8), (const float*)WSP(WS_MOD), 1, (bf16*)WSP(WS_H), (float*)WSP(WS_PSS), vcu * 8 + WAVE(), G * 8, (TID() & 63));
    GSYNC();

    for (int l = 0; l < 2; ++l) {
        for (int half = 0; half < 2; ++half) {
            if (PH(3)) {   pg8::Gemm g{(const bf16*)WSP(WS_H), (const bf16*)WSP(WS_W + (size_t)l * W_LAYER + (half ? W_GU2 : W_GU1)), M, NGU, D}; pg8::StaticOrder S; S.initmn(GU_MAIN_PANELS, NGU / 256, G, bx);
                EpiSwiglu E{WSP(0), l * 9 * NBIAS + (half ? BOFF_GU2 : BOFF_GU1)};
                pg8::gemm_phase<EpiSwiglu, pg8::StaticOrder, true, true>(lds, g, S, E, TID());
                pg8::Gemm g2{(const bf16*)WSP(WS_H) + (size_t)GU_MAIN_PANELS * 256 * D, g.Bt, M, NGU, D}; pg8::StaticOrder S2; S2.initmn((M - GU_MAIN_PANELS * 256) / (64 * GU_TMB), NGU / 256, G, (bx + 12) % G);
                EpiSwigluT<GU_TMB> E2{WSP(0), l * 9 * NBIAS + (half ? BOFF_GU2 : BOFF_GU1), GU_MAIN_PANELS * 256};
                pg8::gemm_phase<EpiSwigluT<GU_TMB>, pg8::StaticOrder, true, true, GU_TMB>(lds, g2, S2, E2, TID()); }
            GSYNC();
            if (PH(4)) {   const bool first = (l == 0 && half == 0);
                float* X = (float*)WSP(WS_X);
                const float* in_ctx = first ? INP(0) : X;
                const float* in_lat = first ? INP(1) - (size_t)M_CTX * D : X;
                const bool has_next = (half == 0) || (l == 0);
                const int ln = half == 0 ? l : l + 1;
                const float* gnext = has_next ? INP(8) + (size_t)(ln * 3 + (half == 0 ? 1 : 0)) * D : nullptr;
                const int sc_off = ln * 9 * NMOD + (half == 0 ? 4 : 1) * 1024;
                pg8::Gemm g{(const bf16*)WSP(WS_ACT), (const bf16*)WSP(WS_W + (size_t)l * W_LAYER + (half ? W_D2 : W_D1)), M, D, FF}; pg8::StaticOrder S; S.initmn(M / 192, D / 256, G, bx);
                EpiRes3 E{in_ctx, in_lat, WSP(0), gnext, l * 9 * NMOD + (half ? 8 : 2) * 1024, sc_off, 0.5f};
                pg8::gemm_phase<EpiRes3, pg8::StaticOrder, true, true, 3>(lds, g, S, E, TID()); }
            GSYNC();
            if (half == 0) {
                if (PH(5)) {   pg8::Gemm g{(const bf16*)WSP(WS_H), (const bf16*)WSP(WS_W + (size_t)l * W_LAYER + W_IN), M, NIN, D}; pg8::StaticOrder S; S.initmn(M / 192, NIN / 256, G, bx);
                    float* newk = kargs()->out + (size_t)M * D;
                    EpiWin3 E{WSP(0), newk, l};
                    pg8::gemm_phase<EpiWin3, pg8::StaticOrder, true, true, 3>(lds, g, S, E, TID()); }
                GSYNC();
                if (PH(6)) mixer_phase(lds, kargs(), l, vcu, G, TID(), WAVE(), (TID() & 63));
                if (PROBE == 3) mixer_phase(lds, kargs(), l, vcu, G, TID(), WAVE(), (TID() & 63));
                GSYNC();
                if (PH(7)) {   float* X = (float*)WSP(WS_X);
                    pg8::Gemm g{(const bf16*)WSP(WS_Y), (const bf16*)WSP(WS_W + (size_t)l * W_LAYER + W_OUT), M, D, D}; pg8::StaticOrder S; S.initmn(M / 192, D / 256, G, bx);
                    EpiRes3 E{X, X, WSP(0), INP(8) + (size_t)(l * 3 + 2) * D, l * 9 * NMOD + 5 * 1024, l * 9 * NMOD + 7 * 1024, 1.0f};
                    pg8::gemm_phase<EpiRes3, pg8::StaticOrder, true, true, 3>(lds, g, S, E, TID()); }
                GSYNC();
            }
        }
    }
    final_norm((const float*)WSP(WS_X), INP(20), kargs()->out, vcu * 8 + WAVE(), G * 8, (TID() & 63));
}

extern "C" void kernel_launch(void* const* d_in, const int* in_sizes, int n_in, void* d_out, int out_size, void* d_ws, size_t ws_size, hipStream_t stream) {
    static int grid = 0;
    if (grid == 0) {
        if (n_in != 21 || ws_size < WS_END2) { fprintf(stderr, "kernel_launch: need 21 inputs and >= %zu bytes of workspace; got %d, %zu\n", (size_t)WS_END2, n_in, ws_size); grid = -1; return; }
        int dev = 0, cus = 0, per_cu = 0;
        hipGetDevice(&dev);
        hipDeviceGetAttribute(&cus, hipDeviceAttributeMultiprocessorCount, dev);
        if (hipFuncSetAttribute((const void*)fwd_megakernel, hipFuncAttributeMaxDynamicSharedMemorySize, LDS_BYTES) != hipSuccess) { fprintf(stderr, "kernel_launch: hipFuncSetAttribute failed\n"); grid = -1; return; }
        if (hipOccupancyMaxActiveBlocksPerMultiprocessor(&per_cu, (const void*)fwd_megakernel, NTHREADS, LDS_BYTES) != hipSuccess || per_cu < 1) { fprintf(stderr, "kernel_launch: occupancy query gave %d\n", per_cu); per_cu = 1; }
        (void)hipGetLastError();
        grid = cus * per_cu;
    }
    if (grid < 0) return;
    if (hipMemsetAsync(d_ws, 0, 65536, stream) != hipSuccess) { fprintf(stderr, "kernel_launch: memset of barrier words failed\n"); return; }
    Args a{};
    for (int i = 0; i < 21; ++i) a.in[i] = (const float*)d_in[i];
    a.out = (float*)d_out; a.ws = (unsigned char*)d_ws;
    void* args[] = {&a};
    hipError_t e = hipLaunchCooperativeKernel((const void*)fwd_megakernel, dim3(grid), dim3(NTHREADS), args, LDS_BYTES, stream);
    if (e != hipSuccess) fprintf(stderr, "cooperative launch failed: %s (grid %d)\n", hipGetErrorString(e), grid);
}
```

```cpp
#include <hip/hip_runtime.h>
#include <hip/hip_cooperative_groups.h>
#include <cstdio>
#include <cstdint>
namespace cg = cooperative_groups;
namespace pg8 {
#define PG8_LAS __attribute__((address_space(3)))
typedef unsigned short bf16_t;
typedef short bf16x8 __attribute__((ext_vector_type(8)));
typedef float f32x4 __attribute__((ext_vector_type(4)));
typedef unsigned u32x4 __attribute__((ext_vector_type(4)));
constexpr int BM = 256, BK = 64, HALF = 128, HTB = HALF * BK * 2  , STAGE_BYTES = 8 * HTB, NXCD = 8, WGM = 8;

__host__ __device__ __forceinline__ int lds_byte(int r, int c) { const int st = (r >> 4) * 2 + (c >> 5), rr = r & 15, cc = c & 31, ob = rr * 64 + cc * 2; return st * 1024 + (ob ^ (((ob >> 9) & 1) << 5)); }
__host__ __device__ __forceinline__ void stage_rc(int b, int& R, int& C) { const int st = b / 1024, sb = b % 1024, swz = sb ^ (((sb >> 9) & 1) << 5); R = (st >> 1) * 16 + swz / 64; C = (st & 1) * 32 + (swz % 64) / 2; }
__host__ __device__ __forceinline__ int perm32(int rho) { const int n = rho >> 4, i = rho & 15; return 8 * (i >> 2) + 4 * n + (i & 3); }

struct Unit { int pm, pn; };
struct Gemm { const bf16_t* A; const bf16_t* Bt; int M, N, K; };

struct StaticOrder {
    int nM, nN, nwg, G, c;
    __host__ __device__ void init(int M, int N, int G_, int c_) { nM = M / BM; nN = N / BM; nwg = nM * nN; G = G_; c = c_; }
    __host__ __device__ void initmn(int nM_, int nN_, int G_, int c_) { nM = nM_; nN = nN_; nwg = nM * nN; G = G_; c = c_; }
    __host__ __device__ bool next(int i, Unit& u) const {
        const long L = (long)i * G + c; if (L >= nwg) return false;
        int wgid = (int)L; { const int q = nwg / NXCD, r = nwg % NXCD, xcd = wgid % NXCD, off = wgid / NXCD; wgid = (xcd < r ? xcd * (q + 1) : r * (q + 1) + (xcd - r) * q) + off; }
        const int nig = WGM * nN, gid = wgid / nig, fm = gid * WGM, gsz = (nM - fm) < WGM ? (nM - fm) : WGM;
        u.pm = fm + ((wgid % nig) % gsz); u.pn = (wgid % nig) / gsz; return true;
    }
    __device__ __forceinline__ void a_ready(const Unit&) const {}
    __device__ __forceinline__ void done(const Unit&) const {}
};

__device__ __forceinline__ unsigned cvt_pk_bf16(float lo, float hi) { unsigned r; asm volatile("v_cvt_pk_bf16_f32 %0, %1, %2" : "=v"(r) : "v"(lo), "v"(hi)); return r; }
typedef float f32x2 __attribute__((ext_vector_type(2)));
template <class Epi, class Sched, bool ALIGN_EPI = false, bool SP2 = false, int MB = 4>
__device__ __forceinline__ void gemm_phase(PG8_LAS unsigned char* lds, const Gemm g, const Sched& S, const Epi& E, int tid) {
    asm volatile("" : "+v"(tid));
    const int wid = __builtin_amdgcn_readfirstlane(tid >> 6), lane = tid & 63, wr = wid >> 2, wc = wid & 3, fr = lane & 15, fq = lane >> 4;
    const int K = g.K, nt = K / BK;
    const bool lightw = SP2 && MB < 4 && wid >= 2 * MB;
    unsigned voffA[2], voffB[2];
#pragma unroll
    for (int i = 0; i < 2; ++i) { int R, C; stage_rc(tid * 16 + i * 8192, R, C); const int Rb = Epi::PERM ? ((R & ~31) + perm32(R & 31)) : R;
        const int Ra = MB == 4 ? R : R - (64 - 16 * MB) * (R >> 6);
        voffA[i] = (unsigned)(Ra * K + C) * 2u; voffB[i] = (unsigned)(Rb * K + C) * 2u; }
    const size_t kstep = (size_t)(BK * 2);
    const size_t hstep = (size_t)HALF * K * 2;
    const size_t tstep = 2 * hstep;
    const size_t hstepA = (size_t)(32 * MB) * K * 2, tstepA = 2 * hstepA;
    const unsigned ldsw = (unsigned)wid * 1024u;
    const int aoff = lds_byte(wr * 64 + fr, fq * 8), boff = lds_byte(wc * 32 + fr, fq * 8);
#define PG8_SA(b, h) (((b) * 2 + (h)) * HTB)
#define PG8_SB(b, h) ((4 + (b) * 2 + (h)) * HTB)
#define PG8_STAGE(bufoff, gbase, voff) do { _Pragma("unroll") for (int _i = 0; _i < 2; ++_i) \
        __builtin_amdgcn_global_load_lds((const unsigned*)((const char*)(gbase) + (voff)[_i]), (PG8_LAS unsigned*)(lds + (bufoff) + ldsw + _i * 8192), 16, 0, 0); } while (0)
#define PG8_LDA(dst, b, h) do { _Pragma("unroll") for (int m = 0; m < MB; ++m) _Pragma("unroll") for (int k = 0; k < 2; ++k) dst[m][k] = *(const PG8_LAS bf16x8*)(lds + PG8_SA(b, h) + aoff + m * 2048 + k * 1024); } while (0)
#define PG8_LDB(dst, b, h) do { _Pragma("unroll") for (int n = 0; n < 2; ++n) _Pragma("unroll") for (int k = 0; k < 2; ++k) dst[n][k] = *(const PG8_LAS bf16x8*)(lds + PG8_SB(b, h) + boff + n * 2048 + k * 1024); } while (0)
#define PG8_MMA(ai, bj, At, Bt) do { __builtin_amdgcn_s_setprio(1); _Pragma("unroll") for (int m = 0; m < MB; ++m) _Pragma("unroll") for (int n = 0; n < 2; ++n) _Pragma("unroll") for (int k = 0; k < 2; ++k) \
        acc[ai][bj][m][n] = __builtin_amdgcn_mfma_f32_16x16x32_bf16(Bt[n][k], At[m][k], acc[ai][bj][m][n], 0, 0, 0); __builtin_amdgcn_s_setprio(0); } while (0)
#define PG8_WAIT_V(n) asm volatile("s_waitcnt vmcnt(" #n ")" ::: "memory")
#define PG8_STAGE_A(bufoff, gbase, voff) do { if (!lightw) PG8_STAGE(bufoff, gbase, voff); } while (0)
#define PG8_WAIT_VL(n, nl) do { if (lightw) asm volatile("s_waitcnt vmcnt(" #nl ")" ::: "memory"); else asm volatile("s_waitcnt vmcnt(" #n ")" ::: "memory"); } while (0)
#define PG8_WAIT_L(n) asm volatile("s_waitcnt lgkmcnt(" #n ")" ::: "memory")
#define PG8_BAR __builtin_amdgcn_s_barrier()
#define PG8_SCHED __builtin_amdgcn_sched_barrier(0)
    Unit cur, nxt; int ui = 0;
    if (!S.next(0, cur)) return;
    PG8_LAS float* tabs = (PG8_LAS float*)(lds + STAGE_BYTES + 1024);
    if constexpr (Epi::HAS_TAB) { typename Epi::Pre p0_ = E.pre_load(cur, tid); E.pre_store(p0_, tabs, tid); }
    f32x4 acc[2][2][4][2];
#pragma unroll
    for (int a = 0; a < 2; ++a)
#pragma unroll
        for (int b = 0; b < 2; ++b)
#pragma unroll
            for (int m = 0; m < 4; ++m)
#pragma unroll
                for (int n = 0; n < 2; ++n) acc[a][b][m][n] = (f32x4){0.f, 0.f, 0.f, 0.f};
    bf16x8 At[4][2], B0[2][2], B1[2][2];
    const char* cA = (const char*)g.A + (size_t)cur.pm * tstepA; const char* cB = (const char*)g.Bt + (size_t)cur.pn * tstep;
    S.a_ready(cur);
    if constexpr (SP2) {
        PG8_STAGE(PG8_SB(0, 0), cB, voffB); PG8_STAGE(PG8_SB(0, 1), cB + hstep, voffB); PG8_STAGE_A(PG8_SA(0, 0), cA, voffA); PG8_STAGE_A(PG8_SA(0, 1), cA + hstepA, voffA);
        if (wr == 1) PG8_BAR;
        PG8_WAIT_VL(2, 0); PG8_BAR;
        PG8_STAGE(PG8_SB(1, 0), cB + kstep, voffB); PG8_STAGE_A(PG8_SA(1, 0), cA + kstep, voffA); PG8_STAGE(PG8_SB(1, 1), cB + hstep + kstep, voffB);
        PG8_WAIT_VL(6, 4); PG8_BAR;
    } else {
        PG8_STAGE(PG8_SB(0, 0), cB, voffB); PG8_STAGE(PG8_SA(0, 0), cA, voffA); PG8_STAGE(PG8_SB(0, 1), cB + hstep, voffB); PG8_STAGE(PG8_SA(0, 1), cA + hstepA, voffA);
        if (wr == 1) PG8_BAR;
        PG8_WAIT_V(4); PG8_BAR;
        PG8_STAGE(PG8_SB(1, 0), cB + kstep, voffB); PG8_STAGE(PG8_SA(1, 0), cA + kstep, voffA); PG8_STAGE(PG8_SB(1, 1), cB + hstep + kstep, voffB);
        PG8_WAIT_V(6); PG8_BAR;
    }
    for (;;) {
        const bool has_next = S.next(ui + 1, nxt);
        const char* nA = has_next ? (const char*)g.A + (size_t)nxt.pm * tstepA : cA; const char* nB = has_next ? (const char*)g.Bt + (size_t)nxt.pn * tstep : cB;
        for (int t = 0; t < nt; t += 2) {
            const bool last = (t == nt - 2);
            const char* a1 = cA + (size_t)(t + 1) * kstep;
            const char* a2 = last ? nA : cA + (size_t)(t + 2) * kstep; const char* b2 = last ? nB : cB + (size_t)(t + 2) * kstep;
            const char* a3 = a2 + kstep; const char* b3 = b2 + kstep;
            if (last && has_next) S.a_ready(nxt);
            if constexpr (SP2) {
            PG8_LDB(B0, 0, 0); PG8_LDB(B1, 0, 1); PG8_SCHED; PG8_LDA(At, 0, 0); PG8_STAGE_A(PG8_SA(1, 1), a1 + hstepA, voffA);
            PG8_WAIT_VL(8, 4); PG8_WAIT_L(0); PG8_BAR; PG8_MMA(0, 0, At, B0); PG8_MMA(0, 1, At, B1); PG8_BAR; PG8_SCHED;
            PG8_LDA(At, 0, 1); PG8_STAGE(PG8_SB(0, 0), b2, voffB); PG8_STAGE(PG8_SB(0, 1), b2 + hstep, voffB); PG8_STAGE_A(PG8_SA(0, 0), a2, voffA);
            PG8_WAIT_VL(8, 4); PG8_WAIT_L(0); PG8_BAR; PG8_MMA(1, 0, At, B0); PG8_MMA(1, 1, At, B1); PG8_BAR; PG8_SCHED;
            PG8_LDB(B0, 1, 0); PG8_LDB(B1, 1, 1); PG8_SCHED; PG8_LDA(At, 1, 0); PG8_STAGE_A(PG8_SA(0, 1), a2 + hstepA, voffA);
            PG8_WAIT_VL(8, 4); PG8_WAIT_L(0); PG8_BAR; PG8_MMA(0, 0, At, B0); PG8_MMA(0, 1, At, B1); PG8_BAR; PG8_SCHED;
            PG8_LDA(At, 1, 1); PG8_STAGE(PG8_SB(1, 0), b3, voffB); PG8_STAGE(PG8_SB(1, 1), b3 + hstep, voffB); PG8_STAGE_A(PG8_SA(1, 0), a3, voffA);
            PG8_WAIT_VL(8, 4); PG8_WAIT_L(0); PG8_BAR; PG8_MMA(1, 0, At, B0); PG8_MMA(1, 1, At, B1); PG8_BAR; PG8_SCHED;
            } else {
            PG8_LDB(B0, 0, 0); PG8_SCHED; PG8_LDA(At, 0, 0); PG8_STAGE(PG8_SA(1, 1), a1 + hstepA, voffA);
            PG8_WAIT_L(8); PG8_BAR; PG8_WAIT_L(0); PG8_MMA(0, 0, At, B0); PG8_BAR; PG8_SCHED;
            PG8_LDB(B1, 0, 1); PG8_STAGE(PG8_SB(0, 0), b2, voffB);
            PG8_BAR; PG8_WAIT_L(0); PG8_MMA(0, 1, At, B1); PG8_BAR;
            PG8_LDA(At, 0, 1); PG8_STAGE(PG8_SA(0, 0), a2, voffA);
            PG8_BAR; PG8_WAIT_L(0); PG8_MMA(1, 0, At, B0); PG8_BAR; PG8_SCHED;
            PG8_STAGE(PG8_SB(0, 1), b2 + hstep, voffB);
            PG8_WAIT_V(6); PG8_BAR; PG8_MMA(1, 1, At, B1); PG8_BAR;
            PG8_LDB(B0, 1, 0); PG8_SCHED; PG8_LDA(At, 1, 0); PG8_STAGE(PG8_SA(0, 1), a2 + hstepA, voffA);
            PG8_WAIT_L(8); PG8_BAR; PG8_WAIT_L(0); PG8_MMA(0, 0, At, B0); PG8_BAR; PG8_SCHED;
            PG8_LDB(B1, 1, 1); PG8_STAGE(PG8_SB(1, 0), b3, voffB);
            PG8_BAR; PG8_WAIT_L(0); PG8_MMA(0, 1, At, B1); PG8_BAR;
            PG8_LDA(At, 1, 1); PG8_STAGE(PG8_SA(1, 0), a3, voffA);
            PG8_BAR; PG8_WAIT_L(0); PG8_MMA(1, 0, At, B0); PG8_BAR; PG8_SCHED;
            PG8_STAGE(PG8_SB(1, 1), b3 + hstep, voffB);
            PG8_WAIT_V(6); PG8_BAR; PG8_MMA(1, 1, At, B1); PG8_BAR;
            }
        }
        if constexpr (ALIGN_EPI) { if (wr == 0) PG8_BAR; }
        if constexpr (Epi::HAS_TAB) {
            typename Epi::Pre pn_; if (has_next) pn_ = E.pre_load(nxt, tid);
            E(acc, cur, wr, wc, fr, fq, tabs + (ui & 1) * Epi::TABSZ);
            if (has_next) E.pre_store(pn_, tabs + ((ui + 1) & 1) * Epi::TABSZ, tid);
            S.done(cur);
        } else
        if constexpr (!Epi::AFTER_DRAIN) { E(acc, cur, wr, wc, fr, fq); S.done(cur); }
        if (!has_next) break;
#pragma unroll
        for (int a = 0; a < 2; ++a)
#pragma unroll
            for (int b = 0; b < 2; ++b)
#pragma unroll
                for (int m = 0; m < 4; ++m)
#pragma unroll
                    for (int n = 0; n < 2; ++n) acc[a][b][m][n] = (f32x4){0.f, 0.f, 0.f, 0.f};
        cur = nxt; cA = nA; cB = nB; ++ui;
        if constexpr (ALIGN_EPI) { if (wr == 1) PG8_BAR; }
    }
    PG8_WAIT_V(0);
    if constexpr (!ALIGN_EPI) { if (wr == 0) PG8_BAR; }
    PG8_BAR;
    if constexpr (Epi::AFTER_DRAIN) { E.fused(acc, cur, wr, wc, fr, fq, lds, wid, lane); S.done(cur); }
#undef PG8_SA
#undef PG8_SB
#undef PG8_STAGE
#undef PG8_LDA
#undef PG8_LDB
#undef PG8_MMA
#undef PG8_WAIT_V
#undef PG8_WAIT_VL
#undef PG8_STAGE_A
#undef PG8_WAIT_L
#undef PG8_BAR
#undef PG8_SCHED
}
}

constexpr int D = 1024, FF = 2816, NGU = 5632, NIN = 2816;
constexpr int M_CTX = 4096, M = 12288;
constexpr int NMOD = 9216;
constexpr size_t MiB = 1u << 20;
constexpr size_t WS_MOD = 1 * MiB, WS_ROPE = 1 * MiB + 768 * 1024, WS_W = 2 * MiB;
constexpr size_t W_GU1 = 0, W_D1 = 11534336, W_IN = 17301504, W_OUT = 23068672, W_GU2 = 25165824, W_D2 = 36700160, W_LAYER = 42467328;
constexpr size_t WS_X = WS_W + 2 * W_LAYER;
constexpr size_t WS_H = WS_X + (size_t)M * D * 4;
constexpr size_t WS_Y = WS_H + (size_t)M * D * 2;
constexpr size_t WS_ACT = WS_Y + (size_t)M * D * 2;
constexpr size_t WS_END = WS_ACT + (size_t)M * FF * 2;
constexpr size_t WS_BIAS = WS_END;
constexpr int NBIAS = NGU + NIN + NGU, BOFF_GU1 = 0, BOFF_IN = NGU, BOFF_GU2 = NGU + NIN;
constexpr size_t WS_PSS = WS_BIAS + (size_t)2 * 9 * NBIAS * 4;
constexpr size_t WS_END2 = WS_PSS + (size_t)M * 16 * 4;
constexpr int LDS_BYTES = 147456;
constexpr int GU_MAIN_PANELS = 46, GU_TMB = 1;
constexpr int NTHREADS = 512;

#define LAS __attribute__((address_space(3)))
typedef unsigned short bf16;
typedef unsigned v4u __attribute__((ext_vector_type(4)));
typedef unsigned v2u __attribute__((ext_vector_type(2)));
typedef float f32x4 __attribute__((ext_vector_type(4)));
typedef short bf16x8 __attribute__((ext_vector_type(8)));
typedef short s16x4 __attribute__((ext_vector_type(4)));

struct Args { const float* in[21]; float* out; unsigned char* ws; };
typedef const __attribute__((address_space(4))) Args* KArgs;
__device__ __forceinline__ int lane_id_fresh() { int l; asm volatile("v_mbcnt_lo_u32_b32 %0, -1, 0\n\tv_mbcnt_hi_u32_b32 %0, -1, %0" : "=v"(l)); return l; }
__device__ __forceinline__ KArgs kargs() { KArgs p = (KArgs)__builtin_amdgcn_kernarg_segment_ptr(); asm volatile("" : "+s"(p)); return p; }

__device__ __forceinline__ unsigned pk2(float lo, float hi) { return pg8::cvt_pk_bf16(lo, hi); }
__device__ __forceinline__ v4u pack8(f32x4 a, f32x4 b) { v4u w; w.x = pk2(a[0], a[1]); w.y = pk2(a[2], a[3]); w.z = pk2(b[0], b[1]); w.w = pk2(b[2], b[3]); return w; }
__device__ __forceinline__ float bflo(unsigned u) { return __uint_as_float(u << 16); }
__device__ __forceinline__ float bfhi(unsigned u) { return __uint_as_float(u & 0xffff0000u); }
__device__ __forceinline__ float wave_sum(float v) {
#pragma unroll
    for (int o = 1; o < 64; o <<= 1) v += __shfl_xor(v, o);
    return v;
}
__device__ __forceinline__ float xmax16_32(float v) {
    auto a = __builtin_amdgcn_permlane16_swap(__float_as_uint(v), __float_as_uint(v), false, false); v = fmaxf(__uint_as_float(a[0]), __uint_as_float(a[1]));
    auto b = __builtin_amdgcn_permlane32_swap(__float_as_uint(v), __float_as_uint(v), false, false); return fmaxf(__uint_as_float(b[0]), __uint_as_float(b[1]));
}
__device__ __forceinline__ float xsum16_32(float v) {
    auto a = __builtin_amdgcn_permlane16_swap(__float_as_uint(v), __float_as_uint(v), false, false); v = __uint_as_float(a[0]) + __uint_as_float(a[1]);
    auto b = __builtin_amdgcn_permlane32_swap(__float_as_uint(v), __float_as_uint(v), false, false); return __uint_as_float(b[0]) + __uint_as_float(b[1]);
}
__device__ __forceinline__ float silu_f(float x) { return x * __builtin_amdgcn_rcpf(1.f + __builtin_amdgcn_exp2f(-1.4426950408889634f * x)); }

__device__ __forceinline__ void load_rstd(const float* PSS, int row0, int fq, float (&rstd)[2][4]) {
#pragma unroll
    for (int ai = 0; ai < 2; ++ai)
#pragma unroll
        for (int m = 0; m < 4; ++m) {
            const f32x4 t = *((const f32x4*)(PSS + (unsigned)(row0 + ai * 128 + m * 16) * 16) + fq);
            rstd[ai][m] = (t[0] + t[1]) + (t[2] + t[3]);
        }
#pragma unroll
    for (int ai = 0; ai < 2; ++ai)
#pragma unroll
        for (int m = 0; m < 4; ++m) {
            float q = rstd[ai][m]; q += __shfl_xor(q, 16); q += __shfl_xor(q, 32);
            rstd[ai][m] = 1.f / sqrtf(q * (1.f / D) + 1e-6f);
        }
}
struct TabPre { f32x4 a, b, c, d; };
__device__ __forceinline__ TabPre tab_pre_load(const unsigned char* ws, int bias_off, const pg8::Unit& u, int tid) {
    TabPre p;
    if (tid < 256) { const f32x4* pp = (const f32x4*)((const float*)(ws + WS_PSS) + (unsigned)(u.pm * 256 + tid) * 16); p.a = pp[0]; p.b = pp[1]; p.c = pp[2]; p.d = pp[3]; }
    else { const int cond = u.pm < 16 ? 0 : 1 + ((u.pm - 16) >> 2);
        p.a[0] = ((const float*)(ws + WS_BIAS))[(unsigned)(bias_off + cond * NBIAS + u.pn * 256 + (tid - 256))]; p.b = p.a; p.c = p.a; p.d = p.a; }
    return p;
}
__device__ __forceinline__ void tab_pre_store(const TabPre& p, LAS float* tab, int tid) {
    if (tid < 256) { const f32x4 t = (p.a + p.b) + (p.c + p.d); tab[tid] = 1.f / sqrtf(((t[0] + t[1]) + (t[2] + t[3])) * (1.f / D) + 1e-6f); }
    else tab[tid] = p.a[0];
}
struct EpiSwiglu {
    static constexpr bool PERM = true, AFTER_DRAIN = false, HAS_TAB = true; static constexpr int TABSZ = 512;
    typedef TabPre Pre;
    unsigned char* ws; int bias_off;
    __device__ __forceinline__ Pre pre_load(const pg8::Unit& u, int tid) const { return tab_pre_load(ws, bias_off, u, tid); }
    __device__ __forceinline__ void pre_store(const Pre& p, LAS float* tab, int tid) const { tab_pre_store(p, tab, tid); }
    __device__ __forceinline__ void operator()(const f32x4 (&acc)[2][2][4][2], const pg8::Unit& u, int wr, int wc, int fr, int fq, const LAS float* tab) const {
        bf16* ACT = (bf16*)(ws + WS_ACT);
        const int row0 = u.pm * 256 + wr * 64 + fr, j0 = u.pn * 128 + wc * 32 + 8 * fq;
        const LAS float* bp = tab + 256 + wc * 32 + 8 * fq;
        const f32x4 bg0 = *(const LAS f32x4*)bp, bg1 = *(const LAS f32x4*)(bp + 4), bu0 = *(const LAS f32x4*)(bp + 128), bu1 = *(const LAS f32x4*)(bp + 132);
#pragma unroll
        for (int ai = 0; ai < 2; ++ai)
#pragma unroll
            for (int m = 0; m < 4; ++m) {
                bf16* p = ACT + (unsigned)((row0 + ai * 128 + m * 16) * FF + j0);
                const float r = tab[wr * 64 + ai * 128 + m * 16 + fr];
                const f32x4 g0 = acc[ai][0][m][0] * r + bg0, g1 = acc[ai][0][m][1] * r + bg1, u0 = acc[ai][1][m][0] * r + bu0, u1 = acc[ai][1][m][1] * r + bu1;
                f32x4 t0 = g0 * (-1.4426950408889634f), t1 = g1 * (-1.4426950408889634f);
#pragma unroll
                for (int e = 0; e < 4; ++e) { t0[e] = __builtin_amdgcn_exp2f(t0[e]); t1[e] = __builtin_amdgcn_exp2f(t1[e]); }
                t0 = t0 + 1.f; t1 = t1 + 1.f;
#pragma unroll
                for (int e = 0; e < 4; ++e) { t0[e] = __builtin_amdgcn_rcpf(t0[e]); t1[e] = __builtin_amdgcn_rcpf(t1[e]); }
                const f32x4 o0 = (g0 * u0) * t0, o1 = (g1 * u1) * t1;
                *(v4u*)p = pack8(o0, o1);
            }
    }
};
__device__ __forceinline__ int cond_of_row(int r) { return r < M_CTX ? 0 : 1 + ((r - M_CTX) >> 10); }
template <int TMB> struct EpiSwigluT {
    static constexpr bool PERM = true, AFTER_DRAIN = false, HAS_TAB = true; static constexpr int TABSZ = 512;
    typedef TabPre Pre;
    unsigned char* ws; int bias_off; int row_base;
    __device__ __forceinline__ Pre pre_load(const pg8::Unit& u, int tid) const {
        TabPre p; const int r0 = row_base + 64 * TMB * u.pm;
        if (tid < 256) { const int t = tid < 64 * TMB ? tid : 64 * TMB - 1; const f32x4* pp = (const f32x4*)((const float*)(ws + WS_PSS) + (unsigned)(r0 + t) * 16); p.a = pp[0]; p.b = pp[1]; p.c = pp[2]; p.d = pp[3]; }
        else { p.a[0] = ((const float*)(ws + WS_BIAS))[(unsigned)(bias_off + cond_of_row(r0) * NBIAS + u.pn * 256 + (tid - 256))]; p.b = p.a; p.c = p.a; p.d = p.a; }
        return p;
    }
    __device__ __forceinline__ void pre_store(const Pre& p, LAS float* tab, int tid) const {
        if (tid < 256) { if (tid < 64 * TMB) { const f32x4 t = (p.a + p.b) + (p.c + p.d); tab[tid] = 1.f / sqrtf(((t[0] + t[1]) + (t[2] + t[3])) * (1.f / D) + 1e-6f); } }
        else tab[tid] = p.a[0];
    }
    __device__ __forceinline__ void operator()(const f32x4 (&acc)[2][2][4][2], const pg8::Unit& u, int wr, int wc, int fr, int fq, const LAS float* tab) const {
        bf16* ACT = (bf16*)(ws + WS_ACT);
        const int rl0 = wr * 16 * TMB + fr, j0 = u.pn * 128 + wc * 32 + 8 * fq;
        const int r0 = row_base + 64 * TMB * u.pm;
        const LAS float* bp = tab + 256 + wc * 32 + 8 * fq;
        const f32x4 bg0 = *(const LAS f32x4*)bp, bg1 = *(const LAS f32x4*)(bp + 4), bu0 = *(const LAS f32x4*)(bp + 128), bu1 = *(const LAS f32x4*)(bp + 132);
#pragma unroll
        for (int ai = 0; ai < 2; ++ai)
#pragma unroll
            for (int m = 0; m < TMB; ++m) {
                const int rl = rl0 + ai * 32 * TMB + m * 16;
                bf16* p = ACT + (unsigned)((r0 + rl) * FF + j0);
                const float r = tab[rl];
                const f32x4 g0 = acc[ai][0][m][0] * r + bg0, g1 = acc[ai][0][m][1] * r + bg1, u0 = acc[ai][1][m][0] * r + bu0, u1 = acc[ai][1][m][1] * r + bu1;
                f32x4 t0 = g0 * (-1.4426950408889634f), t1 = g1 * (-1.4426950408889634f);
#pragma unroll
                for (int e = 0; e < 4; ++e) { t0[e] = __builtin_amdgcn_exp2f(t0[e]); t1[e] = __builtin_amdgcn_exp2f(t1[e]); }
                t0 = t0 + 1.f; t1 = t1 + 1.f;
#pragma unroll
                for (int e = 0; e < 4; ++e) { t0[e] = __builtin_amdgcn_rcpf(t0[e]); t1[e] = __builtin_amdgcn_rcpf(t1[e]); }
                const f32x4 o0 = (g0 * u0) * t0, o1 = (g1 * u1) * t1;
                *(v4u*)p = pack8(o0, o1);
            }
    }
};
struct EpiRes {
    static constexpr bool PERM = true, AFTER_DRAIN = false, HAS_TAB = false;
    const float* in_ctx; const float* in_lat; unsigned char* ws; const float* gnext; int gate_off, sc_off; float gs;
    __device__ __forceinline__ void operator()(const f32x4 (&acc)[2][2][4][2], const pg8::Unit& u, int wr, int wc, int fr, int fq) const {
        const int cond = u.pm < 16 ? 0 : 1 + ((u.pm - 16) >> 2);
        float* out = (float*)(ws + WS_X); bf16* XA = (bf16*)(ws + WS_H); float* PSS = (float*)(ws + WS_PSS);
        const float* gp = (const float*)(ws + WS_MOD) + gate_off + (unsigned)cond * NMOD;
        const float* scp = (const float*)(ws + WS_MOD) + sc_off + (unsigned)cond * NMOD;
        const float* base = u.pm < 16 ? in_ctx : in_lat;
        const int row0 = u.pm * 256 + wr * 64 + fr, col0 = u.pn * 256 + wc * 32 + 8 * fq;
        float ss[2][4];
#pragma unroll
        for (int bj = 0; bj < 2; ++bj) {
            const int cb = col0 + bj * 128;
            const f32x4 gv0 = *(const f32x4*)(gp + cb) * gs, gv1 = *(const f32x4*)(gp + cb + 4) * gs;
            f32x4 an0 = (f32x4){0.f, 0.f, 0.f, 0.f}, an1 = an0;
            if (gnext) { an0 = *(const f32x4*)(gnext + cb) * (*(const f32x4*)(scp + cb) + 1.f); an1 = *(const f32x4*)(gnext + cb + 4) * (*(const f32x4*)(scp + cb + 4) + 1.f); }
#pragma unroll
            for (int ai = 0; ai < 2; ++ai)
#pragma unroll
                for (int m = 0; m < 4; ++m) {
                    const unsigned off = (unsigned)(row0 + ai * 128 + m * 16) * D + cb;
                    const f32x4 b0 = *(const f32x4*)(base + off), b1 = *(const f32x4*)(base + off + 4);
                    const f32x4 o0 = b0 + gv0 * acc[ai][bj][m][0], o1 = b1 + gv1 * acc[ai][bj][m][1];
                    *(f32x4*)(out + off) = o0; *(f32x4*)(out + off + 4) = o1;
                    if (gnext) {
                        const float q = ((o0[0] * o0[0] + o0[1] * o0[1]) + (o0[2] * o0[2] + o0[3] * o0[3])) + ((o1[0] * o1[0] + o1[1] * o1[1]) + (o1[2] * o1[2] + o1[3] * o1[3]));
                        ss[ai][m] = bj == 0 ? q : ss[ai][m] + q;
                        *(v4u*)(XA + off) = pack8(o0 * an0, o1 * an1);
                    }
                    if (m & 1) asm volatile("" ::: "memory");
                }
        }
        if (gnext) {
#pragma unroll
            for (int ai = 0; ai < 2; ++ai)
#pragma unroll
                for (int m = 0; m < 4; ++m) {
                    const float q = xsum16_32(ss[ai][m]);
                    if (fq == 0) PSS[(unsigned)(row0 + ai * 128 + m * 16) * 16 + u.pn * 4 + wc] = q;
                }
        }
    }
};
struct EpiRes3 {
    static constexpr bool PERM = true, AFTER_DRAIN = false, HAS_TAB = false;
    const float* in_ctx; const float* in_lat; unsigned char* ws; const float* gnext; int gate_off, sc_off; float gs;
    __device__ __forceinline__ void operator()(const f32x4 (&acc)[2][2][4][2], const pg8::Unit& u, int wr, int wc, int fr, int fq) const {
        float* out = (float*)(ws + WS_X); bf16* XA = (bf16*)(ws + WS_H); float* PSS = (float*)(ws + WS_PSS);
        const float* gp0 = (const float*)(ws + WS_MOD) + gate_off;
        const float* scp0 = (const float*)(ws + WS_MOD) + sc_off;
        const int rb0 = u.pm * 192 + wr * 48, col0 = u.pn * 256 + wc * 32 + 8 * fq;
        float ss[2][3];
#pragma unroll
        for (int bj = 0; bj < 2; ++bj) {
            const int cb = col0 + bj * 128;
            f32x4 gn0 = (f32x4){0.f, 0.f, 0.f, 0.f}, gn1 = gn0;
            if (gnext) { gn0 = *(const f32x4*)(gnext + cb); gn1 = *(const f32x4*)(gnext + cb + 4); }
#pragma unroll
            for (int ai = 0; ai < 2; ++ai)
#pragma unroll
                for (int m = 0; m < 3; ++m) {
                    const int rb = rb0 + ai * 96 + m * 16;
                    const int cond = rb < M_CTX ? 0 : 1 + ((rb - M_CTX) >> 10);
                    const float* base = rb < M_CTX ? in_ctx : in_lat;
                    const float* gp = gp0 + (unsigned)(cond * NMOD + cb);
                    const f32x4 gv0 = *(const f32x4*)gp * gs, gv1 = *(const f32x4*)(gp + 4) * gs;
                    const unsigned off = (unsigned)((rb + fr) * D + cb);
                    const f32x4 b0 = *(const f32x4*)(base + off), b1 = *(const f32x4*)(base + off + 4);
                    const f32x4 o0 = b0 + gv0 * acc[ai][bj][m][0], o1 = b1 + gv1 * acc[ai][bj][m][1];
                    *(f32x4*)(out + off) = o0; *(f32x4*)(out + off + 4) = o1;
                    if (gnext) {
                        const float* sp = scp0 + (unsigned)(cond * NMOD + cb);
                        const f32x4 an0 = gn0 * (*(const f32x4*)sp + 1.f), an1 = gn1 * (*(const f32x4*)(sp + 4) + 1.f);
                        const float q = ((o0[0] * o0[0] + o0[1] * o0[1]) + (o0[2] * o0[2] + o0[3] * o0[3])) + ((o1[0] * o1[0] + o1[1] * o1[1]) + (o1[2] * o1[2] + o1[3] * o1[3]));
                        ss[ai][m] = bj == 0 ? q : ss[ai][m] + q;
                        *(v4u*)(XA + off) = pack8(o0 * an0, o1 * an1);
                    }
                }
        }
        if (gnext) {
#pragma unroll
            for (int ai = 0; ai < 2; ++ai)
#pragma unroll
                for (int m = 0; m < 3; ++m) {
                    const float q = xsum16_32(ss[ai][m]);
                    if (fq == 0) PSS[(unsigned)(rb0 + ai * 96 + m * 16 + fr) * 16 + u.pn * 4 + wc] = q;
                }
        }
    }
};
struct EpiWin {
    static constexpr bool PERM = true, AFTER_DRAIN = false, HAS_TAB = true; static constexpr int TABSZ = 512;
    typedef TabPre Pre;
    unsigned char* ws; float* newk; int layer;
    __device__ __forceinline__ Pre pre_load(const pg8::Unit& u, int tid) const { return tab_pre_load(ws, layer * 9 * NBIAS + BOFF_IN, u, tid); }
    __device__ __forceinline__ void pre_store(const Pre& p, LAS float* tab, int tid) const { tab_pre_store(p, tab, tid); }
    __device__ __forceinline__ void operator()(const f32x4 (&acc)[2][2][4][2], const pg8::Unit& u, int wr, int wc, int fr, int fq, const LAS float* tab) const {
        bf16* Z = (bf16*)(ws + WS_ACT); float* newv = newk + 16 * 2 * 4 * 256 * 128;
        const float* rc = (const float*)(ws + WS_ROPE); const float* rs = rc + 1024;
        const int pn = u.pn, pm = u.pm; const bool lat = pm >= 16;
        const int row0 = pm * 256 + wr * 64 + fr;
        const LAS float* bp = tab + 256 + wc * 32 + 8 * fq;
        const LAS float* rp = tab + wr * 64 + fr;
#define WIN_BV() const f32x4 bv00 = *(const LAS f32x4*)bp, bv01 = *(const LAS f32x4*)(bp + 4), bv10 = *(const LAS f32x4*)(bp + 128), bv11 = *(const LAS f32x4*)(bp + 132)
        if (pn < 4) {
            const int lc = 256 * pn + 64 * wc + 8 * fq;
#pragma unroll
            for (int ai = 0; ai < 2; ++ai)
#pragma unroll
                for (int m = 0; m < 4; ++m) {
                    const int row = row0 + ai * 128 + m * 16; const float r = rp[ai * 128 + m * 16]; WIN_BV();
                    f32x4 a0 = acc[ai][0][m][0] * r + bv00, a1 = acc[ai][0][m][1] * r + bv01, b0 = acc[ai][1][m][0] * r + bv10, b1 = acc[ai][1][m][1] * r + bv11;
                    if (lat) {
                        const int t = (row - M_CTX) & 1023; const int pos = fq < 2 ? (t >> 6) : (t & 63);
                        const float* cp = rc + pos * 16 + 8 * (fq & 1); const float* sp = rs + pos * 16 + 8 * (fq & 1);
                        const f32x4 c0 = *(const f32x4*)cp, c1 = *(const f32x4*)(cp + 4), s0 = *(const f32x4*)sp, s1 = *(const f32x4*)(sp + 4);
                        const f32x4 na0 = a0 * c0 - b0 * s0, na1 = a1 * c1 - b1 * s1, nb0 = b0 * c0 + a0 * s0, nb1 = b1 * c1 + a1 * s1;
                        a0 = na0; a1 = na1; b0 = nb0; b1 = nb1;
                    }
                    bf16* zp = Z + (unsigned)(row * NIN + lc);
                    *(v4u*)zp = pack8(a0, a1); *(v4u*)(zp + 32) = pack8(b0, b1);
                    if (!lat && pn >= 2) {
                        const int kc = lc - 512, hh = kc >> 7, dd = kc & 127;
                        float* kp = newk + (unsigned)((((pm * 2 + layer) * 4 + hh) * 256 + (row & 255)) * 128 + dd);
                        *(f32x4*)kp = a0; *(f32x4*)(kp + 4) = a1; *(f32x4*)(kp + 32) = b0; *(f32x4*)(kp + 36) = b1;
                    }
                    asm volatile("" ::: "memory");
                }
        } else {
            const int col = 256 * pn + 32 * wc + 8 * fq;
#pragma unroll
            for (int ai = 0; ai < 2; ++ai)
#pragma unroll
                for (int m = 0; m < 4; ++m) {
                    const int row = row0 + ai * 128 + m * 16; const float r = rp[ai * 128 + m * 16]; WIN_BV();
                    const f32x4 a0 = acc[ai][0][m][0] * r + bv00, a1 = acc[ai][0][m][1] * r + bv01, b0 = acc[ai][1][m][0] * r + bv10, b1 = acc[ai][1][m][1] * r + bv11;
                    bf16* zp = Z + (unsigned)(row * NIN + col);
                    *(v4u*)zp = pack8(a0, a1); *(v4u*)(zp + 128) = pack8(b0, b1);
                    if (!lat && pn < 6) {
                        const int vc = col - 1024, hh = vc >> 7, dd = vc & 127;
                        float* vp = newv + (unsigned)((((pm * 2 + layer) * 4 + hh) * 256 + (row & 255)) * 128 + dd);
                        *(f32x4*)vp = a0; *(f32x4*)(vp + 4) = a1; *(f32x4*)(vp + 256 * 128) = b0; *(f32x4*)(vp + 256 * 128 + 4) = b1;
                    }
                    asm volatile("" ::: "memory");
                }
        }
    }
};

__device__ __forceinline__ TabPre tab_pre_load3(const unsigned char* ws, int bias_off, const pg8::Unit& u, int tid) {
    TabPre p;
    if (tid < 256) { const int t = tid < 192 ? tid : 191; const f32x4* pp = (const f32x4*)((const float*)(ws + WS_PSS) + (unsigned)(u.pm * 192 + t) * 16); p.a = pp[0]; p.b = pp[1]; p.c = pp[2]; p.d = pp[3]; }
    else { const float* bb = (const float*)(ws + WS_BIAS) + (unsigned)(bias_off + u.pn * 256 + (tid - 256));
        p.a[0] = bb[(unsigned)(cond_of_row(u.pm * 192) * NBIAS)]; p.b = p.a; p.b[0] = bb[(unsigned)(cond_of_row(u.pm * 192 + 191) * NBIAS)]; p.c = p.a; p.d = p.a; }
    return p;
}
__device__ __forceinline__ void tab_pre_store3(const TabPre& p, LAS float* tab, int tid) {
    if (tid < 256) { if (tid < 192) { const f32x4 t = (p.a + p.b) + (p.c + p.d); tab[tid] = 1.f / sqrtf(((t[0] + t[1]) + (t[2] + t[3])) * (1.f / D) + 1e-6f); } }
    else { tab[tid] = p.a[0]; tab[tid + 256] = p.b[0]; }
}
struct EpiWin3 {
    static constexpr bool PERM = true, AFTER_DRAIN = false, HAS_TAB = true; static constexpr int TABSZ = 768;
    typedef TabPre Pre;
    unsigned char* ws; float* newk; int layer;
    __device__ __forceinline__ Pre pre_load(const pg8::Unit& u, int tid) const { return tab_pre_load3(ws, layer * 9 * NBIAS + BOFF_IN, u, tid); }
    __device__ __forceinline__ void pre_store(const Pre& p, LAS float* tab, int tid) const { tab_pre_store3(p, tab, tid); }
    __device__ __forceinline__ void operator()(const f32x4 (&acc)[2][2][4][2], const pg8::Unit& u, int wr, int wc, int fr, int fq, const LAS float* tab) const {
        bf16* Z = (bf16*)(ws + WS_ACT); float* newv = newk + 16 * 2 * 4 * 256 * 128;
        const float* rc = (const float*)(ws + WS_ROPE); const float* rs = rc + 1024;
        const int pn = u.pn;
        const int rb0 = u.pm * 192 + wr * 48, cond_lo = cond_of_row(u.pm * 192);
        const LAS float* bp0 = tab + 256 + wc * 32 + 8 * fq;
        const LAS float* rp = tab + wr * 48 + fr;
#define WIN3_BV() const LAS float* bp = bp0 + (cond_of_row(rb) != cond_lo ? 256 : 0); const f32x4 bv00 = *(const LAS f32x4*)bp, bv01 = *(const LAS f32x4*)(bp + 4), bv10 = *(const LAS f32x4*)(bp + 128), bv11 = *(const LAS f32x4*)(bp + 132)
        if (pn < 4) {
            const int lc = 256 * pn + 64 * wc + 8 * fq;
#pragma unroll
            for (int ai = 0; ai < 2; ++ai)
#pragma unroll
                for (int m = 0; m < 3; ++m) {
                    const int rb = rb0 + ai * 96 + m * 16, row = rb + fr; const bool lat = rb >= M_CTX;
                    const float r = rp[ai * 96 + m * 16]; WIN3_BV();
                    f32x4 a0 = acc[ai][0][m][0] * r + bv00, a1 = acc[ai][0][m][1] * r + bv01, b0 = acc[ai][1][m][0] * r + bv10, b1 = acc[ai][1][m][1] * r + bv11;
                    if (lat) {
                        const int t = (row - M_CTX) & 1023; const int pos = fq < 2 ? (t >> 6) : (t & 63);
                        const float* cp = rc + pos * 16 + 8 * (fq & 1); const float* sp = rs + pos * 16 + 8 * (fq & 1);
                        const f32x4 c0 = *(const f32x4*)cp, c1 = *(const f32x4*)(cp + 4), s0 = *(const f32x4*)sp, s1 = *(const f32x4*)(sp + 4);
                        const f32x4 na0 = a0 * c0 - b0 * s0, na1 = a1 * c1 - b1 * s1, nb0 = b0 * c0 + a0 * s0, nb1 = b1 * c1 + a1 * s1;
                        a0 = na0; a1 = na1; b0 = nb0; b1 = nb1;
                    }
                    bf16* zp = Z + (unsigned)(row * NIN + lc);
                    *(v4u*)zp = pack8(a0, a1); *(v4u*)(zp + 32) = pack8(b0, b1);
                    if (!lat && pn >= 2) {
                        const int kc = lc - 512, hh = kc >> 7, dd = kc & 127;
                        float* kp = newk + (unsigned)(((((row >> 8) * 2 + layer) * 4 + hh) * 256 + (row & 255)) * 128 + dd);
                        *(f32x4*)kp = a0; *(f32x4*)(kp + 4) = a1; *(f32x4*)(kp + 32) = b0; *(f32x4*)(kp + 36) = b1;
                    }
                    asm volatile("" ::: "memory");
                }
        } else {
            const int col = 256 * pn + 32 * wc + 8 * fq;
#pragma unroll
            for (int ai = 0; ai < 2; ++ai)
#pragma unroll
                for (int m = 0; m < 3; ++m) {
                    const int rb = rb0 + ai * 96 + m * 16, row = rb + fr; const bool lat = rb >= M_CTX;
                    const float r = rp[ai * 96 + m * 16]; WIN3_BV();
                    const f32x4 a0 = acc[ai][0][m][0] * r + bv00, a1 = acc[ai][0][m][1] * r + bv01, b0 = acc[ai][1][m][0] * r + bv10, b1 = acc[ai][1][m][1] * r + bv11;
                    bf16* zp = Z + (unsigned)(row * NIN + col);
                    *(v4u*)zp = pack8(a0, a1); *(v4u*)(zp + 128) = pack8(b0, b1);
                    if (!lat && pn < 6) {
                        const int vc = col - 1024, hh = vc >> 7, dd = vc & 127;
                        float* vp = newv + (unsigned)(((((row >> 8) * 2 + layer) * 4 + hh) * 256 + (row & 255)) * 128 + dd);
                        *(f32x4*)vp = a0; *(f32x4*)(vp + 4) = a1; *(f32x4*)(vp + 256 * 128) = b0; *(f32x4*)(vp + 256 * 128 + 4) = b1;
                    }
                    asm volatile("" ::: "memory");
                }
        }
#undef WIN3_BV
    }
};

__device__ __forceinline__ void p0_mod(LAS unsigned char* lds, KArgs A, int tid) {
    LAS float* sc = (LAS float*)lds;
    LAS float* red = (LAS float*)(lds + 36864);
    for (int idx = tid; idx < 9 * 1024; idx += NTHREADS) { const int c = idx >> 10, k = idx & 1023; const float x = c == 0 ? A->in[5][k] : A->in[4][(c - 1) * 1024 + k]; sc[idx] = x / (1.f + __expf(-x)); }
    __syncthreads();
    float* MOD = (float*)(A->ws + WS_MOD);
    for (int it = blockIdx.x; it < 256; it += gridDim.x) {
        const int l = it >> 7, col0 = (it & 127) * 72;
        if (tid < 504) {
            const int kg = tid / 18, c4 = tid % 18;
            f32x4 acc[9];
#pragma unroll
            for (int c = 0; c < 9; ++c) acc[c] = (f32x4){0.f, 0.f, 0.f, 0.f};
            const float* wp = A->in[6] + (size_t)l * 1024 * NMOD + col0 + 4 * c4;
#pragma unroll 4
            for (int k = kg; k < 1024; k += 28) {
                const f32x4 w = *(const f32x4*)(wp + (size_t)k * NMOD);
#pragma unroll
                for (int c = 0; c < 9; ++c) acc[c] += w * sc[c * 1024 + k];
            }
#pragma unroll
            for (int c = 0; c < 9; ++c)
#pragma unroll
                for (int e = 0; e < 4; ++e) red[(kg * 9 + c) * 72 + 4 * c4 + e] = acc[c][e];
        }
        __syncthreads();
        for (int idx = tid; idx < 648; idx += NTHREADS) {
            const int c = idx / 72, j = idx % 72; float s = A->in[7][l * NMOD + col0 + j];
            for (int kg = 0; kg < 28; ++kg) s += red[(kg * 9 + c) * 72 + j];
            MOD[(size_t)(l * 9 + c) * NMOD + col0 + j] = s;
        }
        __syncthreads();
    }
}
__device__ __forceinline__ void transpose_item(const float* W, int K, int N, bf16* WT, LAS float* scr, int item, int lane, int kind) {
    const int nblk = N / 32, kb = item / nblk, nb = item % nblk, k0 = 64 * kb, n0 = 32 * nb;
    int ln0 = n0;
    if (kind == 1) { const int pn = n0 >> 8, w = n0 & 255; ln0 = (w >> 7) * FF + 128 * pn + (w & 127); }
    else if (kind == 2 && n0 < 1024) { const int pn = n0 >> 8, w = n0 & 255; ln0 = 256 * pn + 64 * ((w & 127) >> 5) + 32 * (w >> 7); }
#pragma unroll 8
    for (int i = 0; i < 32; ++i) { const int kk = 2 * i + (lane >> 5); scr[kk * 33 + (lane & 31)] = W[(size_t)(k0 + kk) * N + ln0 + (lane & 31)]; }
    asm volatile("s_waitcnt lgkmcnt(0)" ::: "memory");
    const int c = lane & 7;
#pragma unroll
    for (int j = 0; j < 4; ++j) { const int n = (lane >> 3) + 8 * j; const LAS float* s = scr + (8 * c) * 33 + n;
        v4u o; o.x = pk2(s[0 * 33], s[1 * 33]); o.y = pk2(s[2 * 33], s[3 * 33]); o.z = pk2(s[4 * 33], s[5 * 33]); o.w = pk2(s[6 * 33], s[7 * 33]);
        *(v4u*)(WT + (size_t)(n0 + n) * K + k0 + 8 * c) = o; }
    asm volatile("s_waitcnt lgkmcnt(0)" ::: "memory");
}
__device__ __forceinline__ void p0_weights(LAS unsigned char* lds, KArgs A, int gw, int NGW, int wave, int lane) {
    LAS float* scr = (LAS float*)(lds + wave * 16384);
    constexpr int I_GU = 16 * 176, I_D = 44 * 32, I_IN = 16 * 88, I_OUT = 16 * 32, I_LAYER = 2 * I_GU + 2 * I_D + I_IN + I_OUT;
    for (int it = gw; it < 2 * I_LAYER; it += NGW) {
        const int l = it / I_LAYER; int r = it % I_LAYER;
        unsigned char* wl = A->ws + WS_W + (size_t)l * W_LAYER;
        if (r < I_GU) { transpose_item(A->in[9] + (size_t)l * D * NGU, D, NGU, (bf16*)(wl + W_GU1), scr, r, lane, 1); continue; } r -= I_GU;
        if (r < I_D) { transpose_item(A->in[10] + (size_t)l * FF * D, FF, D, (bf16*)(wl + W_D1), scr, r, lane, 0); continue; } r -= I_D;
        if (r < I_IN) { transpose_item(A->in[13] + (size_t)l * D * NIN, D, NIN, (bf16*)(wl + W_IN), scr, r, lane, 2); continue; } r -= I_IN;
        if (r < I_OUT) { transpose_item(A->in[14] + (size_t)l * D * D, D, D, (bf16*)(wl + W_OUT), scr, r, lane, 0); continue; } r -= I_OUT;
        if (r < I_GU) { transpose_item(A->in[11] + (size_t)l * D * NGU, D, NGU, (bf16*)(wl + W_GU2), scr, r, lane, 1); continue; } r -= I_GU;
        transpose_item(A->in[12] + (size_t)l * FF * D, FF, D, (bf16*)(wl + W_D2), scr, r, lane, 0);
    }
}

__device__ __forceinline__ void xa_phase(const float* in_ctx, const float* in_lat, const float* g, const float* modl, int isc, bf16* XA, float* PSS, int gw, int NGW, int lane) {
    asm volatile("" : "+v"(lane));
    for (int m = gw; m < M; m += NGW) {
        const float* xrow = (m < M_CTX ? in_ctx : in_lat) + (size_t)m * D;
        const int cond = m < M_CTX ? 0 : 1 + ((m - M_CTX) >> 10);
        const f32x4* sc4 = (const f32x4*)(modl + (size_t)cond * NMOD + isc * 1024);
        const f32x4* g4 = (const f32x4*)g; const f32x4* x4 = (const f32x4*)xrow;
        f32x4 v[4]; float ss = 0.f;
#pragma unroll
        for (int j = 0; j < 4; ++j) { v[j] = x4[lane + 64 * j]; ss += (v[j].x * v[j].x + v[j].y * v[j].y) + (v[j].z * v[j].z + v[j].w * v[j].w); }
        ss = wave_sum(ss);
        if (lane < 16) PSS[(size_t)m * 16 + lane] = lane == 0 ? ss : 0.f;
        v2u* o = (v2u*)(XA + (size_t)m * D);
#pragma unroll
        for (int j = 0; j < 4; ++j) {
            const int k4 = lane + 64 * j;
            const f32x4 r = v[j] * g4[k4] * (sc4[k4] + 1.f);
            v2u w; w.x = pk2(r.x, r.y); w.y = pk2(r.z, r.w); o[k4] = w;
        }
    }
}
__device__ __forceinline__ void bias_phase(LAS unsigned char* lds, KArgs A, int bxv, int G, int tid, int wave, int lane) {
    const int combo = bxv % 6, l = combo / 3, sidx = combo % 3;
    const int N = sidx == 1 ? NIN : NGU;
    const int boff = sidx == 0 ? BOFF_GU1 : (sidx == 1 ? BOFF_IN : BOFF_GU2);
    const bf16* Wt = (const bf16*)(A->ws + WS_W + (size_t)l * W_LAYER + (sidx == 0 ? W_GU1 : (sidx == 1 ? W_IN : W_GU2)));
    const float* MOD = (const float*)(A->ws + WS_MOD) + (size_t)l * 9 * NMOD + sidx * 3 * 1024;
    float* BIAS = (float*)(A->ws + WS_BIAS) + (size_t)l * 9 * NBIAS + boff;
    LAS bf16* shh = (LAS bf16*)lds;
    LAS bf16* shl = (LAS bf16*)(lds + 32768);
    __syncthreads();
    for (int idx = tid; idx < 16 * 1024; idx += NTHREADS) {
        const int c = idx >> 10, k = idx & 1023;
        const float v = c < 9 ? MOD[(size_t)c * NMOD + k] : 0.f;
        const unsigned hi = pk2(v, 0.f) & 0xffffu; const float r = v - __uint_as_float(hi << 16);
        shh[idx] = (bf16)hi; shl[idx] = (bf16)(pk2(r, 0.f) & 0xffffu);
    }
    __syncthreads();
    const int i16 = lane & 15, kg = lane >> 4;
    const int nwg = (G - combo + 5) / 6;
    const int wslot = (bxv / 6) * 8 + wave, nslots = nwg * 8;
    for (int task = wslot; task < N / 16; task += nslots) {
        const bf16* wp = Wt + (size_t)(task * 16 + i16) * D + 8 * kg;
        f32x4 acc = (f32x4){0.f, 0.f, 0.f, 0.f};
#pragma unroll 8
        for (int ks = 0; ks < 32; ++ks) {
            const bf16x8 a = *(const bf16x8*)(wp + 32 * ks);
            const bf16x8 bh = *(const LAS bf16x8*)(shh + i16 * 1024 + 32 * ks + 8 * kg), bl = *(const LAS bf16x8*)(shl + i16 * 1024 + 32 * ks + 8 * kg);
            acc = __builtin_amdgcn_mfma_f32_16x16x32_bf16(a, bh, acc, 0, 0, 0);
            acc = __builtin_amdgcn_mfma_f32_16x16x32_bf16(a, bl, acc, 0, 0, 0);
        }
        if (i16 < 9) *(f32x4*)(BIAS + (size_t)i16 * NBIAS + task * 16 + 4 * kg) = acc;
    }
    __syncthreads();
}
__device__ __forceinline__ void final_norm(const float* X, const float* g, float* out, int gw, int NGW, int lane) {
    for (int m = gw; m < M; m += NGW) {
        const f32x4* x4 = (const f32x4*)(X + (size_t)m * D); const f32x4* g4 = (const f32x4*)g;
        f32x4 v[4]; float ss = 0.f;
#pragma unroll
        for (int j = 0; j < 4; ++j) { v[j] = x4[lane + 64 * j]; ss += (v[j].x * v[j].x + v[j].y * v[j].y) + (v[j].z * v[j].z + v[j].w * v[j].w); }
        const float rstd = 1.f / sqrtf(wave_sum(ss) * (1.f / D) + 1e-6f);
        f32x4* o = (f32x4*)(out + (size_t)m * D);
#pragma unroll
        for (int j = 0; j < 4; ++j) o[lane + 64 * j] = v[j] * rstd * g4[lane + 64 * j];
    }
}

__device__ __forceinline__ unsigned off_b(unsigned row, unsigned ch) { return 256u * row + 16u * (ch ^ (((row & 3u) << 2) | ((0u - (row >> 2)) & 3u))); }
__device__ __forceinline__ s16x4 vtr(const LAS unsigned char* p) { return __builtin_bit_cast(s16x4, __builtin_amdgcn_ds_read_tr16_b64_v4i16((LAS s16x4*)p)); }

__device__ __forceinline__ void attn_item(LAS unsigned char* lds, KArgs A, int l, bool isLat, int b, int h, int qb, float lam, float oml, int tid, int wave, int lane) {
    const bf16* Z = (const bf16*)(A->ws + WS_ACT);
    bf16* Y = (bf16*)(A->ws + WS_Y);
    const int i16 = lane & 15, kg = lane >> 4;
    const int seq0 = isLat ? M_CTX + b * 1024 : b * 256;
    const int qrow = seq0 + qb * 128 + wave * 16 + i16;
    bf16x8 qf[4];
#pragma unroll
    for (int s = 0; s < 4; ++s) qf[s] = *(const bf16x8*)(Z + (size_t)qrow * NIN + h * 128 + 32 * s + 8 * kg);
    const int NT = isLat ? 20 : 4;
    const size_t coff = (size_t)((b * 2 + l) * 4 + h) * 256 * 128;
    const float* ck = A->in[2] + coff; const float* cv = A->in[3] + coff;
    const int sr = tid >> 4, sch = tid & 15;
    const unsigned sd0 = off_b(sr, sch), sd1 = off_b(sr + 32, sch);
    unsigned koff[4], voff[8];
#pragma unroll
    for (int s = 0; s < 4; ++s) koff[s] = off_b(i16, 4 * s + kg);
    { const int q_ = i16 >> 2, p = lane & 3;
#pragma unroll
      for (int c = 0; c < 8; ++c) voff[c] = 32768u + off_b(4 * kg + q_, 2 * c + (p >> 1)) + 8 * (p & 1); }
    v4u kreg[2], vreg[2];
#define ATT_LOAD(t) do { \
        if (isLat && (t) < 4) { \
            _Pragma("unroll") for (int i_ = 0; i_ < 2; ++i_) { const int key = 64 * (t) + sr + 32 * i_; \
                const float* pk = ck + key * 128 + sch * 8; const float* pv = cv + key * 128 + sch * 8; \
                kreg[i_] = pack8(*(const f32x4*)pk, *(const f32x4*)(pk + 4)); vreg[i_] = pack8(*(const f32x4*)pv, *(const f32x4*)(pv + 4)); } \
        } else { \
            _Pragma("unroll") for (int i_ = 0; i_ < 2; ++i_) { const size_t row = seq0 + 64 * (isLat ? (t) - 4 : (t)) + sr + 32 * i_; \
                kreg[i_] = *(const v4u*)(Z + row * NIN + 512 + h * 128 + sch * 8); vreg[i_] = *(const v4u*)(Z + row * NIN + 1024 + h * 128 + sch * 8); } \
        } } while (0)
#define ATT_STORE(bi) do { \
        *(LAS v4u*)(lds + (bi) * 16384 + sd0) = kreg[0]; *(LAS v4u*)(lds + (bi) * 16384 + sd1) = kreg[1]; \
        *(LAS v4u*)(lds + 32768 + (bi) * 16384 + sd0) = vreg[0]; *(LAS v4u*)(lds + 32768 + (bi) * 16384 + sd1) = vreg[1]; } while (0)
    f32x4 O[2][8];
#pragma unroll
    for (int mp = 0; mp < 2; ++mp)
#pragma unroll
        for (int c = 0; c < 8; ++c) O[mp][c] = (f32x4){0.f, 0.f, 0.f, 0.f};
    float mrun[2] = {-INFINITY, -INFINITY}, lsum[2] = {0.f, 0.f};
    const float c2 = 0.125f * 1.4426950408889634f;
    ATT_LOAD(0); ATT_STORE(0); __syncthreads();
    for (int t = 0; t < NT; ++t) {
        const int bi = t & 1;
        if (t + 1 < NT) ATT_LOAD(t + 1);
        const LAS unsigned char* kb_ = lds + bi * 16384;
        const LAS unsigned char* vb_ = lds + bi * 16384;
        bf16x8 kf[4][4];
#pragma unroll
        for (int kb = 0; kb < 4; ++kb)
#pragma unroll
            for (int s = 0; s < 4; ++s) kf[kb][s] = *(const LAS bf16x8*)(kb_ + kb * 4096 + koff[s]);
        __builtin_amdgcn_sched_barrier(0);
        f32x4 S[2][4];
#pragma unroll
        for (int mp = 0; mp < 2; ++mp)
#pragma unroll
            for (int kb = 0; kb < 4; ++kb) {
                S[mp][kb] = __builtin_amdgcn_mfma_f32_16x16x32_bf16(kf[kb][2 * mp], qf[2 * mp], (f32x4){0.f, 0.f, 0.f, 0.f}, 0, 0, 0);
                S[mp][kb] = __builtin_amdgcn_mfma_f32_16x16x32_bf16(kf[kb][2 * mp + 1], qf[2 * mp + 1], S[mp][kb], 0, 0, 0);
            }
        s16x4 va[8][2], vc[8][2];
#pragma unroll
        for (int c = 0; c < 8; ++c) { va[c][0] = vtr(vb_ + voff[c]); va[c][1] = vtr(vb_ + 256 * 16 + voff[c]); }
        __builtin_amdgcn_sched_barrier(0);
        bf16x8 pb[2][2];
#pragma unroll
        for (int mp = 0; mp < 2; ++mp) {
            float mx = fmaxf(fmaxf(S[mp][0][0], S[mp][0][1]), fmaxf(S[mp][0][2], S[mp][0][3]));
#pragma unroll
            for (int kb = 1; kb < 4; ++kb) mx = fmaxf(mx, fmaxf(fmaxf(S[mp][kb][0], S[mp][kb][1]), fmaxf(S[mp][kb][2], S[mp][kb][3])));
            mx = xmax16_32(mx);
            const float tm = mx * c2;
            if (__builtin_amdgcn_ballot_w64(tm > mrun[mp] + 8.f) != 0ull) {
                const float mnew = fmaxf(mrun[mp], tm);
                const float alpha = __builtin_amdgcn_exp2f(mrun[mp] - mnew);
                mrun[mp] = mnew; lsum[mp] *= alpha;
#pragma unroll
                for (int c = 0; c < 8; ++c) O[mp][c] *= alpha;
            }
            const float mref = mrun[mp];
            float ps = 0.f;
#pragma unroll
            for (int kb = 0; kb < 4; ++kb)
#pragma unroll
                for (int e = 0; e < 4; ++e) { S[mp][kb][e] = __builtin_amdgcn_exp2f(S[mp][kb][e] * c2 - mref); ps += S[mp][kb][e]; }
            lsum[mp] += ps;
#pragma unroll
            for (int ks = 0; ks < 2; ++ks) { const v4u w = pack8(S[mp][2 * ks], S[mp][2 * ks + 1]); pb[mp][ks] = __builtin_bit_cast(bf16x8, w); }
        }
        __builtin_amdgcn_sched_barrier(0);
#pragma unroll
        for (int c = 0; c < 8; ++c) { vc[c][0] = vtr(vb_ + 256 * 32 + voff[c]); vc[c][1] = vtr(vb_ + 256 * 48 + voff[c]); }
#pragma unroll
        for (int c = 0; c < 8; ++c) {
            const bf16x8 vf = (bf16x8){va[c][0][0], va[c][0][1], va[c][0][2], va[c][0][3], va[c][1][0], va[c][1][1], va[c][1][2], va[c][1][3]};
            O[0][c] = __builtin_amdgcn_mfma_f32_16x16x32_bf16(vf, pb[0][0], O[0][c], 0, 0, 0);
            O[1][c] = __builtin_amdgcn_mfma_f32_16x16x32_bf16(vf, pb[1][0], O[1][c], 0, 0, 0);
        }
        __builtin_amdgcn_sched_barrier(0);
#pragma unroll
        for (int c = 0; c < 8; ++c) {
            const bf16x8 vf = (bf16x8){vc[c][0][0], vc[c][0][1], vc[c][0][2], vc[c][0][3], vc[c][1][0], vc[c][1][1], vc[c][1][2], vc[c][1][3]};
            O[0][c] = __builtin_amdgcn_mfma_f32_16x16x32_bf16(vf, pb[0][1], O[0][c], 0, 0, 0);
            O[1][c] = __builtin_amdgcn_mfma_f32_16x16x32_bf16(vf, pb[1][1], O[1][c], 0, 0, 0);
        }
        __builtin_amdgcn_sched_barrier(0);
        if (t + 1 < NT) ATT_STORE(bi ^ 1);
        __syncthreads();
    }
#undef ATT_LOAD
#undef ATT_STORE
    float l1 = lsum[0], l2 = lsum[1];
    l1 += __shfl_xor(l1, 16); l1 += __shfl_xor(l1, 32); l2 += __shfl_xor(l2, 16); l2 += __shfl_xor(l2, 32);
    const float r1 = 1.f / l1, r2 = lam / l2;
    float ss = 0.f;
#pragma unroll
    for (int c = 0; c < 8; ++c) { O[0][c] = O[0][c] * r1 - O[1][c] * r2; ss += (O[0][c][0] * O[0][c][0] + O[0][c][1] * O[0][c][1]) + (O[0][c][2] * O[0][c][2] + O[0][c][3] * O[0][c][3]); }
    ss += __shfl_xor(ss, 16); ss += __shfl_xor(ss, 32);
    const float rstd = oml / sqrtf(ss * (1.f / 128.f) + 1e-6f);
    const float* gsub = A->in[16] + (size_t)(l * 4 + h) * 128;
    bf16* yp = Y + (size_t)qrow * D + h * 128 + 4 * kg;
#pragma unroll
    for (int c = 0; c < 8; ++c) {
        const f32x4 gv = *(const f32x4*)(gsub + 16 * c + 4 * kg);
        const f32x4 o = O[0][c] * rstd * gv;
        v2u w; w.x = pk2(o[0], o[1]); w.y = pk2(o[2], o[3]);
        *(v2u*)(yp + 16 * c) = w;
    }
}

__device__ __forceinline__ void bc_item(LAS unsigned char* lds, KArgs A, int l, int n, int g, int tid, int wave, int lane) {
    asm volatile("" : "+v"(tid)); asm volatile("" : "+v"(lane));
    const bf16* Z = (const bf16*)(A->ws + WS_ACT);
    bf16* Y = (bf16*)(A->ws + WS_Y);
    LAS unsigned char* VC = lds;
    const int r0 = n * 128;
    const int i16 = lane & 15, kg = lane >> 4;
    v4u vcr[2];
#pragma unroll
    for (int i = 0; i < 2; ++i) { const int idx = tid + NTHREADS * i, q = idx >> 3, ch = idx & 7; vcr[i] = *(const v4u*)(Z + (unsigned)((r0 + q) * NIN + 2560 + g * 64 + ch * 8)); }
    const float* wrow = A->in[18] + (unsigned)(((l * 4 + g) * 128 + 16 * wave + i16) * 128 + 8 * kg);
    f32x4 wr_[4][2];
#pragma unroll
    for (int ks = 0; ks < 4; ++ks) { wr_[ks][0] = *(const f32x4*)(wrow + 32 * ks); wr_[ks][1] = *(const f32x4*)(wrow + 32 * ks + 4); }
    const int rowm = r0 + 16 * wave + i16;
    const float bias = A->in[19][(l * 4 + g) * 128 + 16 * wave + i16];
    v2u uu[4];
#pragma unroll
    for (int cb = 0; cb < 4; ++cb) uu[cb] = *(const v2u*)(Z + (unsigned)(rowm * NIN + 2304 + g * 64 + 16 * cb + 4 * kg));
    const int p = tid >> 2, cq = tid & 3;
    const int rowc = r0 + p; const int cc = g * 64 + cq * 16;
    const int seqlen = n < 32 ? 256 : 1024; const int tpos = n < 32 ? (rowc & 255) : ((rowc - M_CTX) & 1023);
    const bool hasp = tpos > 0, hasn = tpos < seqlen - 1;
    const bf16* zr = Z + (unsigned)(rowc * NIN + cc);
    const bf16* zp = hasp ? zr - NIN : zr; const bf16* zn = hasn ? zr + NIN : zr;
    v4u gb[2], gc0[2], hc0[2], gc1[2], hc1[2], gc2[2], hc2[2];
#pragma unroll
    for (int hf = 0; hf < 2; ++hf) {
        gb[hf] = *(const v4u*)(zr + 1536 + 8 * hf);
        gc1[hf] = *(const v4u*)(zr + 1792 + 8 * hf); hc1[hf] = *(const v4u*)(zr + 2048 + 8 * hf);
        gc0[hf] = *(const v4u*)(zp + 1792 + 8 * hf); hc0[hf] = *(const v4u*)(zp + 2048 + 8 * hf);
        gc2[hf] = *(const v4u*)(zn + 1792 + 8 * hf); hc2[hf] = *(const v4u*)(zn + 2048 + 8 * hf);
    }
#pragma unroll
    for (int i = 0; i < 2; ++i) { const int idx = tid + NTHREADS * i, q = idx >> 3, ch = idx & 7; *(LAS v4u*)(VC + q * 128 + ch * 16) = vcr[i]; }
    bf16x8 wf[4];
#pragma unroll
    for (int ks = 0; ks < 4; ++ks) { const v4u w = pack8(wr_[ks][0], wr_[ks][1]); wf[ks] = __builtin_bit_cast(bf16x8, w); }
    __syncthreads();
    f32x4 acc[4];
#pragma unroll
    for (int cb = 0; cb < 4; ++cb) acc[cb] = (f32x4){0.f, 0.f, 0.f, 0.f};
    const LAS unsigned char* vb = VC + (8 * kg + (i16 >> 2)) * 128 + 8 * (lane & 3);
#pragma unroll
    for (int ks = 0; ks < 4; ++ks)
#pragma unroll
        for (int cb = 0; cb < 4; ++cb) {
            const s16x4 lo = vtr(vb + (32 * ks) * 128 + 32 * cb), hi = vtr(vb + (32 * ks + 4) * 128 + 32 * cb);
            const bf16x8 vf = (bf16x8){lo[0], lo[1], lo[2], lo[3], hi[0], hi[1], hi[2], hi[3]};
            acc[cb] = __builtin_amdgcn_mfma_f32_16x16x32_bf16(vf, wf[ks], acc[cb], 0, 0, 0);
        }
#pragma unroll
    for (int cb = 0; cb < 4; ++cb) {
        v2u o; o.x = pk2(bflo(uu[cb].x) * (acc[cb][0] + bias), bfhi(uu[cb].x) * (acc[cb][1] + bias)); o.y = pk2(bflo(uu[cb].y) * (acc[cb][2] + bias), bfhi(uu[cb].y) * (acc[cb][3] + bias));
        *(v2u*)(Y + (unsigned)(rowm * D + 768 + g * 64 + 16 * cb + 4 * kg)) = o;
    }
    {
        const float* cw = A->in[17] + (unsigned)(l * 3 * 256 + cc);
        const float mp_ = hasp ? 1.f : 0.f, mn_ = hasn ? 1.f : 0.f;
#pragma unroll
        for (int hf = 0; hf < 2; ++hf) {
            const f32x4 w0a = *(const f32x4*)(cw + 8 * hf) * mp_, w0b = *(const f32x4*)(cw + 8 * hf + 4) * mp_;
            const f32x4 w1a = *(const f32x4*)(cw + 256 + 8 * hf), w1b = *(const f32x4*)(cw + 256 + 8 * hf + 4);
            const f32x4 w2a = *(const f32x4*)(cw + 512 + 8 * hf) * mn_, w2b = *(const f32x4*)(cw + 512 + 8 * hf + 4) * mn_;
            v4u o;
#pragma unroll
            for (int e = 0; e < 4; ++e) {
                const float wl0 = e < 2 ? w0a[2 * e] : w0b[2 * e - 4], wh0 = e < 2 ? w0a[2 * e + 1] : w0b[2 * e - 3];
                const float wl1 = e < 2 ? w1a[2 * e] : w1b[2 * e - 4], wh1 = e < 2 ? w1a[2 * e + 1] : w1b[2 * e - 3];
                const float wl2 = e < 2 ? w2a[2 * e] : w2b[2 * e - 4], wh2 = e < 2 ? w2a[2 * e + 1] : w2b[2 * e - 3];
                const float lo = bflo(gb[hf][e]) * (wl0 * bflo(gc0[hf][e]) * bflo(hc0[hf][e]) + wl1 * bflo(gc1[hf][e]) * bflo(hc1[hf][e]) + wl2 * bflo(gc2[hf][e]) * bflo(hc2[hf][e]));
                const float hi = bfhi(gb[hf][e]) * (wh0 * bfhi(gc0[hf][e]) * bfhi(hc0[hf][e]) + wh1 * bfhi(gc1[hf][e]) * bfhi(hc1[hf][e]) + wh2 * bfhi(gc2[hf][e]) * bfhi(hc2[hf][e]));
                o[e] = pk2(lo, hi);
            }
            *(v4u*)(Y + (unsigned)(rowc * D + 512 + cc + 8 * hf)) = o;
        }
    }
    __syncthreads();
}

__device__ __forceinline__ void mixer_phase(LAS unsigned char* lds, KArgs A, int l, int vcu, int G, int tid, int wave, int lane) {
    asm volatile("" : "+v"(tid)); lane = tid & 63; wave = __builtin_amdgcn_readfirstlane(tid >> 6);
    const float lam_init = __uint_as_float(__builtin_amdgcn_readfirstlane(l == 0 ? 0x3e4ccccdu : 0x3eb60549u));
    const float* lp = A->in[15] + (size_t)l * 256;
    const float s01 = wave_sum(lp[lane] * lp[64 + lane]), s23 = wave_sum(lp[128 + lane] * lp[192 + lane]);
    const float lam = __uint_as_float(__builtin_amdgcn_readfirstlane(__float_as_uint(__expf(s01) - __expf(s23) + lam_init)));
    const float oml = __uint_as_float(__builtin_amdgcn_readfirstlane(l == 0 ? 0x3f4ccccdu : 0x3f24fd5cu));
    for (int it = vcu; it < 768; it += G) {
        if (it < 256) attn_item(lds, A, l, true, it >> 5, (it >> 3) & 3, it & 7, lam, oml, tid, wave, lane);
        else if (it < 384) { const int j = it - 256; attn_item(lds, A, l, false, j >> 3, (j >> 1) & 3, j & 1, lam, oml, tid, wave, lane); }
        else { const int j = it - 384; bc_item(lds, A, l, j >> 2, j & 3, tid, wave, lane); }
    }
}

#define XB_TMO      128
#define XB_XCNT(j)  (256  + 64 * (j))
#define XB_XSUB(j)  (1280 + 64 * (j))
#define XB_XGEN(j)  (2304 + 64 * (j))
#define XB_TOP      3328
#define XB_TOPGEN   3392
#define XCD_BAR_WORDS 3456
#define XB_SPIN_CAP (1u << 18)

__device__ __forceinline__ unsigned xb_ld(unsigned* p)              { return __hip_atomic_load(p, __ATOMIC_RELAXED, __HIP_MEMORY_SCOPE_AGENT); }
__device__ __forceinline__ unsigned xb_add(unsigned* p, unsigned v) { return __hip_atomic_fetch_add(p, v, __ATOMIC_RELAXED, __HIP_MEMORY_SCOPE_AGENT); }
__device__ __forceinline__ unsigned xb_xcc_id() { return (unsigned)__builtin_amdgcn_s_getreg((3 << 11) | 20) & 0xFu; }
#define XB_SPIN(cond, bar) do { unsigned _sp = 0; while (cond) { __builtin_amdgcn_s_sleep(1); \
    if ((++_sp & 255u) == 0u) { if (xb_ld(&(bar)[XB_TMO])) break; if (_sp > XB_SPIN_CAP) { atomicAdd(&(bar)[XB_TMO], 1u); break; } } } } while (0)

struct XcdBarrier {
    unsigned* bar; unsigned x;
    volatile LAS unsigned* st;
};

__device__ __forceinline__ XcdBarrier xcd_barrier_post(unsigned* bar, volatile LAS unsigned* st, bool leader) {
    XcdBarrier b; b.bar = bar; b.x = xb_xcc_id(); b.st = st;
    if (leader) (void)xb_add(&bar[XB_XCNT(b.x)], 1u);
    return b;
}
__device__ __forceinline__ void xcd_barrier_complete(unsigned* bar, unsigned x, unsigned& nloc, unsigned& nx) {
    const unsigned G = gridDim.x * gridDim.y * gridDim.z;
    unsigned sum, cnt, mine, sp = 0u;
    for (;;) {
        sum = 0u; cnt = 0u; mine = 0u;
#pragma unroll
        for (unsigned j = 0; j < 16; ++j) { const unsigned c = xb_ld(&bar[XB_XCNT(j)]); sum += c; cnt += (c > 0u) ? 1u : 0u; mine = (j == x) ? c : mine; }
        if (sum == G) break;
        __builtin_amdgcn_s_sleep(1);
        if ((++sp & 255u) == 0u) { if (xb_ld(&bar[XB_TMO])) break; if (sp > XB_SPIN_CAP) { atomicAdd(&bar[XB_TMO], 1u); break; } }
    }
    nloc = mine > 0u ? mine : 1u; nx = cnt > 0u ? cnt : 1u;
}

__device__ __forceinline__ void xcd_barrier(const XcdBarrier& b, bool leader) {
    asm volatile("s_waitcnt vmcnt(0)" ::: "memory");
    __syncthreads();
    if (leader) {
        unsigned* bar = b.bar;
        __builtin_amdgcn_s_waitcnt(0);
        unsigned nloc = b.st[0], nx = b.st[1];
        if (nloc == 0u) { xcd_barrier_complete(bar, b.x, nloc, nx); b.st[0] = nloc; b.st[1] = nx; }
        const unsigned old = xb_add(&bar[XB_XSUB(b.x)], 1u);
        const unsigned gen = old / nloc;
        if (old + 1u == (gen + 1u) * nloc) {
            __builtin_amdgcn_fence(__ATOMIC_RELEASE, "agent");
            asm volatile("s_waitcnt vmcnt(0)" ::: "memory");
            const unsigned og = xb_add(&bar[XB_TOP], 1u);
            const unsigned tg = og / nx;
            if (og + 1u == (tg + 1u) * nx) xb_add(&bar[XB_TOPGEN], 1u);
            else XB_SPIN(xb_ld(&bar[XB_TOPGEN]) == tg, bar);
            __builtin_amdgcn_fence(__ATOMIC_ACQUIRE, "agent");
            xb_add(&bar[XB_XGEN(b.x)], 1u);
            asm volatile("s_waitcnt vmcnt(0)" ::: "memory");
        } else {
            XB_SPIN(xb_ld(&bar[XB_XGEN(b.x)]) == gen, bar);
            __builtin_amdgcn_fence(__ATOMIC_ACQUIRE, "agent");
            asm volatile("s_waitcnt vmcnt(0)" ::: "memory");
        }
    }
    __syncthreads();
}

#ifndef PHMASK
#define PHMASK 0xffff
#endif
#define PH(k) ((PHMASK >> (k)) & 1)
#ifndef PROBE
#define PROBE 0
#endif
#define GSYNC() do { XcdBarrier b_; b_.bar = (unsigned*)kargs()->ws; { unsigned x_ = bar_x; asm volatile("" : "+s"(x_)); b_.x = x_; } b_.st = (volatile LAS unsigned*)(lds + 131072); xcd_barrier(b_, TID() == 0); } while (0)
__global__ void __launch_bounds__(NTHREADS, 2) fwd_megakernel(Args A_byval) {
    extern __shared__ __attribute__((aligned(16))) unsigned char lds_raw[];
    LAS unsigned char* lds = (LAS unsigned char*)lds_raw;
    cg::grid_group grid = cg::this_grid();
    const int wid_s = __builtin_amdgcn_readfirstlane((int)threadIdx.x >> 6);
#define TID() (wid_s * 64 + lane_id_fresh())
    const int G = gridDim.x, bx = blockIdx.x;
    const int vcu = (G % 8 == 0) ? (bx % 8) * (G / 8) + bx / 8 : bx;
#define WAVE() wid_s
#define WSP(off) (kargs()->ws + (off))
#define INP(i) (kargs()->in[i])

    { const int t_ = TID(); if (t_ < 64) ((LAS unsigned*)(lds + 131072))[t_] = 0u; }
    __syncthreads();
    const unsigned bar_x = xcd_barrier_post((unsigned*)WSP(0), (volatile LAS unsigned*)(lds + 131072), TID() == 0).x;
    if (kargs()->ws == nullptr) grid.sync();

    if (PH(0)) p0_mod(lds, kargs(), TID());
    if (bx == G - 1) {
        float* RC = (float*)WSP(WS_ROPE);
        for (int idx = TID(); idx < 1024; idx += NTHREADS) {
            const int pos = idx >> 4, i = idx & 15;
            const float inv = exp2f(-(float)i * (13.287712379549449f / 16.f));
            float rev = (float)pos * inv * 0.15915494309189535f; rev -= floorf(rev);
            RC[idx] = __builtin_amdgcn_cosf(rev); RC[1024 + idx] = __builtin_amdgcn_sinf(rev);
        }
    }
    if (PH(1)) p0_weights(lds, kargs(), vcu * 8 + WAVE(), G * 8, WAVE(), (TID() & 63));
    GSYNC();
    bias_phase(lds, kargs(), bx, G, TID(), WAVE(), (TID() & 63));
    xa_phase(INP(0), INP(1) - (size_t)M_CTX * D, INP(8), (const float*)WSP(WS_MOD), 1, (bf16*)WSP(WS_H), (float*)WSP(WS_PSS), vcu * 8 + WAVE(), G * 8, (TID() & 63));
    GSYNC();

    for (int l = 0; l < 2; ++l) {
        for (int half = 0; half < 2; ++half) {
            if (PH(3)) {   pg8::Gemm g{(const bf16*)WSP(WS_H), (const bf16*)WSP(WS_W + (size_t)l * W_LAYER + (half ? W_GU2 : W_GU1)), M, NGU, D}; pg8::StaticOrder S; S.initmn(GU_MAIN_PANELS, NGU / 256, G, bx);
                EpiSwiglu E{WSP(0), l * 9 * NBIAS + (half ? BOFF_GU2 : BOFF_GU1)};
                pg8::gemm_phase<EpiSwiglu, pg8::StaticOrder, true, true>(lds, g, S, E, TID());
                pg8::Gemm g2{(const bf16*)WSP(WS_H) + (size_t)GU_MAIN_PANELS * 256 * D, g.Bt, M, NGU, D}; pg8::StaticOrder S2; S2.initmn((M - GU_MAIN_PANELS * 256) / (64 * GU_TMB), NGU / 256, G, (bx + 12) % G);
                EpiSwigluT<GU_TMB> E2{WSP(0), l * 9 * NBIAS + (half ? BOFF_GU2 : BOFF_GU1), GU_MAIN_PANELS * 256};
                pg8::gemm_phase<EpiSwigluT<GU_TMB>, pg8::StaticOrder, true, true, GU_TMB>(lds, g2, S2, E2, TID()); }
            GSYNC();
            if (PH(4)) {   const bool first = (l == 0 && half == 0);
                float* X = (float*)WSP(WS_X);
                const float* in_ctx = first ? INP(0) : X;
                const float* in_lat = first ? INP(1) - (size_t)M_CTX * D : X;
                const bool has_next = (half == 0) || (l == 0);
                const int ln = half == 0 ? l : l + 1;
                const float* gnext = has_next ? INP(8) + (size_t)(ln * 3 + (half == 0 ? 1 : 0)) * D : nullptr;
                const int sc_off = ln * 9 * NMOD + (half == 0 ? 4 : 1) * 1024;
                pg8::Gemm g{(const bf16*)WSP(WS_ACT), (const bf16*)WSP(WS_W + (size_t)l * W_LAYER + (half ? W_D2 : W_D1)), M, D, FF}; pg8::StaticOrder S; S.initmn(M / 192, D / 256, G, bx);
                EpiRes3 E{in_ctx, in_lat, WSP(0), gnext, l * 9 * NMOD + (half ? 8 : 2) * 1024, sc_off, 0.5f};
                pg8::gemm_phase<EpiRes3, pg8::StaticOrder, true, true, 3>(lds, g, S, E, TID()); }
            GSYNC();
            if (half == 0) {
                if (PH(5)) {   pg8::Gemm g{(const bf16*)WSP(WS_H), (const bf16*)WSP(WS_W + (size_t)l * W_LAYER + W_IN), M, NIN, D}; pg8::StaticOrder S; S.initmn(M / 192, NIN / 256, G, bx);
                    float* newk = kargs()->out + (size_t)M * D;
                    EpiWin3 E{WSP(0), newk, l};
                    pg8::gemm_phase<EpiWin3, pg8::StaticOrder, true, true, 3>(lds, g, S, E, TID()); }
                GSYNC();
                if (PH(6)) mixer_phase(lds, kargs(), l, vcu, G, TID(), WAVE(), (TID() & 63));
                if (PROBE == 3) mixer_phase(lds, kargs(), l, vcu, G, TID(), WAVE(), (TID() & 63));
                GSYNC();
                if (PH(7)) {   float* X = (float*)WSP(WS_X);
                    pg8::Gemm g{(const bf16*)WSP(WS_Y), (const bf16*)WSP(WS_W + (size_t)l * W_LAYER + W_OUT), M, D, D}; pg8::StaticOrder S; S.initmn(M / 192, D / 256, G, bx);
                    EpiRes3 E{X, X, WSP(0), INP(8) + (size_t)(l * 3 + 2) * D, l * 9 * NMOD + 5 * 1024, l * 9 * NMOD + 7 * 1024, 1.0f};
                    pg8::gemm_phase<EpiRes3, pg8::StaticOrder, true, true, 3>(lds, g, S, E, TID()); }
                GSYNC();
            }
        }
    }
    final_norm((const float*)WSP(WS_X), INP(20), kargs()->out, vcu * 8 + WAVE(), G * 8, (TID() & 63));
}

extern "C" void kernel_launch(void* const* d_in, const int* in_sizes, int n_in, void* d_out, int out_size, void* d_ws, size_t ws_size, hipStream_t stream) {
    static int grid = 0;
    if (grid == 0) {
        if (n_in != 21 || ws_size < WS_END2) { fprintf(stderr, "kernel_launch: need 21 inputs and >= %zu bytes of workspace; got %d, %zu\n", (size_t)WS_END2, n_in, ws_size); grid = -1; return; }
        int dev = 0, cus = 0, per_cu = 0;
        hipGetDevice(&dev);
        hipDeviceGetAttribute(&cus, hipDeviceAttributeMultiprocessorCount, dev);
        if (hipFuncSetAttribute((const void*)fwd_megakernel, hipFuncAttributeMaxDynamicSharedMemorySize, LDS_BYTES) != hipSuccess) { fprintf(stderr, "kernel_launch: hipFuncSetAttribute failed\n"); grid = -1; return; }
        if (hipOccupancyMaxActiveBlocksPerMultiprocessor(&per_cu, (const void*)fwd_megakernel, NTHREADS, LDS_BYTES) != hipSuccess || per_cu < 1) { fprintf(stderr, "kernel_launch: occupancy query gave %d\n", per_cu); per_cu = 1; }
        (void)hipGetLastError();
        grid = cus * per_cu;
    }
    if (grid < 0) return;
    if (hipMemsetAsync(d_ws, 0, 65536, stream) != hipSuccess) { fprintf(stderr, "kernel_launch: memset of barrier words failed\n"); return; }
    Args a{};
    for (int i = 0; i < 21; ++i) a.in[i] = (const float*)d_in[i];
    a.out = (float*)d_out; a.ws = (unsigned char*)d_ws;
    void* args[] = {&a};
    hipError_t e = hipLaunchCooperativeKernel((const void*)fwd_megakernel, dim3(grid), dim3(NTHREADS), args, LDS_BYTES, stream);
    if (e != hipSuccess) fprintf(stderr, "cooperative launch failed: %s (grid %d)\n", hipGetErrorString(e), grid);
}
```

```cpp
#include <hip/hip_runtime.h>
#include <hip/hip_cooperative_groups.h>
#include <cstdio>
#include <cstdint>
namespace cg = cooperative_groups;
namespace pg8 {
#define PG8_LAS __attribute__((address_space(3)))
typedef unsigned short bf16_t;
typedef short bf16x8 __attribute__((ext_vector_type(8)));
typedef float f32x4 __attribute__((ext_vector_type(4)));
typedef unsigned u32x4 __attribute__((ext_vector_type(4)));
constexpr int BM = 256, BK = 64, HALF = 128, HTB = HALF * BK * 2  , STAGE_BYTES = 8 * HTB, NXCD = 8, WGM = 8;

__host__ __device__ __forceinline__ int lds_byte(int r, int c) { const int st = (r >> 4) * 2 + (c >> 5), rr = r & 15, cc = c & 31, ob = rr * 64 + cc * 2; return st * 1024 + (ob ^ (((ob >> 9) & 1) << 5)); }
__host__ __device__ __forceinline__ void stage_rc(int b, int& R, int& C) { const int st = b / 1024, sb = b % 1024, swz = sb ^ (((sb >> 9) & 1) << 5); R = (st >> 1) * 16 + swz / 64; C = (st & 1) * 32 + (swz % 64) / 2; }
__host__ __device__ __forceinline__ int perm32(int rho) { const int n = rho >> 4, i = rho & 15; return 8 * (i >> 2) + 4 * n + (i & 3); }

struct Unit { int pm, pn; };
struct Gemm { const bf16_t* A; const bf16_t* Bt; int M, N, K; };

struct StaticOrder {
    int nM, nN, nwg, G, c;
    __host__ __device__ void init(int M, int N, int G_, int c_) { nM = M / BM; nN = N / BM; nwg = nM * nN; G = G_; c = c_; }
    __host__ __device__ void initmn(int nM_, int nN_, int G_, int c_) { nM = nM_; nN = nN_; nwg = nM * nN; G = G_; c = c_; }
    __host__ __device__ bool next(int i, Unit& u) const {
        const long L = (long)i * G + c; if (L >= nwg) return false;
        int wgid = (int)L; { const int q = nwg / NXCD, r = nwg % NXCD, xcd = wgid % NXCD, off = wgid / NXCD; wgid = (xcd < r ? xcd * (q + 1) : r * (q + 1) + (xcd - r) * q) + off; }
        const int nig = WGM * nN, gid = wgid / nig, fm = gid * WGM, gsz = (nM - fm) < WGM ? (nM - fm) : WGM;
        u.pm = fm + ((wgid % nig) % gsz); u.pn = (wgid % nig) / gsz; return true;
    }
    __device__ __forceinline__ void a_ready(const Unit&) const {}
    __device__ __forceinline__ void done(const Unit&) const {}
};

__device__ __forceinline__ unsigned cvt_pk_bf16(float lo, float hi) { unsigned r; asm volatile("v_cvt_pk_bf16_f32 %0, %1, %2" : "=v"(r) : "v"(lo), "v"(hi)); return r; }
typedef float f32x2 __attribute__((ext_vector_type(2)));
template <class Epi, class Sched, bool ALIGN_EPI = false, bool SP2 = false, int MB = 4>
__device__ __forceinline__ void gemm_phase(PG8_LAS unsigned char* lds, const Gemm g, const Sched& S, const Epi& E, int tid) {
    asm volatile("" : "+v"(tid));
    const int wid = __builtin_amdgcn_readfirstlane(tid >> 6), lane = tid & 63, wr = wid >> 2, wc = wid & 3, fr = lane & 15, fq = lane >> 4;
    const int K = g.K, nt = K / BK;
    const bool lightw = SP2 && MB < 4 && wid >= 2 * MB;
    unsigned voffA[2], voffB[2];
#pragma unroll
    for (int i = 0; i < 2; ++i) { int R, C; stage_rc(tid * 16 + i * 8192, R, C); const int Rb = Epi::PERM ? ((R & ~31) + perm32(R & 31)) : R;
        const int Ra = MB == 4 ? R : R - (64 - 16 * MB) * (R >> 6);
        voffA[i] = (unsigned)(Ra * K + C) * 2u; voffB[i] = (unsigned)(Rb * K + C) * 2u; }
    const size_t kstep = (size_t)(BK * 2);
    const size_t hstep = (size_t)HALF * K * 2;
    const size_t tstep = 2 * hstep;
    const size_t hstepA = (size_t)(32 * MB) * K * 2, tstepA = 2 * hstepA;
    const unsigned ldsw = (unsigned)wid * 1024u;
    const int aoff = lds_byte(wr * 64 + fr, fq * 8), boff = lds_byte(wc * 32 + fr, fq * 8);
#define PG8_SA(b, h) (((b) * 2 + (h)) * HTB)
#define PG8_SB(b, h) ((4 + (b) * 2 + (h)) * HTB)
#define PG8_STAGE(bufoff, gbase, voff) do { _Pragma("unroll") for (int _i = 0; _i < 2; ++_i) \
        __builtin_amdgcn_global_load_lds((const unsigned*)((const char*)(gbase) + (voff)[_i]), (PG8_LAS unsigned*)(lds + (bufoff) + ldsw + _i * 8192), 16, 0, 0); } while (0)
#define PG8_LDA(dst, b, h) do { _Pragma("unroll") for (int m = 0; m < MB; ++m) _Pragma("unroll") for (int k = 0; k < 2; ++k) dst[m][k] = *(const PG8_LAS bf16x8*)(lds + PG8_SA(b, h) + aoff + m * 2048 + k * 1024); } while (0)
#define PG8_LDB(dst, b, h) do { _Pragma("unroll") for (int n = 0; n < 2; ++n) _Pragma("unroll") for (int k = 0; k < 2; ++k) dst[n][k] = *(const PG8_LAS bf16x8*)(lds + PG8_SB(b, h) + boff + n * 2048 + k * 1024); } while (0)
#define PG8_MMA(ai, bj, At, Bt) do { __builtin_amdgcn_s_setprio(1); _Pragma("unroll") for (int m = 0; m < MB; ++m) _Pragma("unroll") for (int n = 0; n < 2; ++n) _Pragma("unroll") for (int k = 0; k < 2; ++k) \
        acc[ai][bj][m][n] = __builtin_amdgcn_mfma_f32_16x16x32_bf16(Bt[n][k], At[m][k], acc[ai][bj][m][n], 0, 0, 0); __builtin_amdgcn_s_setprio(0); } while (0)
#define PG8_WAIT_V(n) asm volatile("s_waitcnt vmcnt(" #n ")" ::: "memory")
#define PG8_STAGE_A(bufoff, gbase, voff) do { if (!lightw) PG8_STAGE(bufoff, gbase, voff); } while (0)
#define PG8_WAIT_VL(n, nl) do { if (lightw) asm volatile("s_waitcnt vmcnt(" #nl ")" ::: "memory"); else asm volatile("s_waitcnt vmcnt(" #n ")" ::: "memory"); } while (0)
#define PG8_WAIT_L(n) asm volatile("s_waitcnt lgkmcnt(" #n ")" ::: "memory")
#define PG8_BAR __builtin_amdgcn_s_barrier()
#define PG8_SCHED __builtin_amdgcn_sched_barrier(0)
    Unit cur, nxt; int ui = 0;
    if (!S.next(0, cur)) return;
    PG8_LAS float* tabs = (PG8_LAS float*)(lds + STAGE_BYTES + 1024);
    if constexpr (Epi::HAS_TAB) { typename Epi::Pre p0_ = E.pre_load(cur, tid); E.pre_store(p0_, tabs, tid); }
    f32x4 acc[2][2][4][2];
#pragma unroll
    for (int a = 0; a < 2; ++a)
#pragma unroll
        for (int b = 0; b < 2; ++b)
#pragma unroll
            for (int m = 0; m < 4; ++m)
#pragma unroll
                for (int n = 0; n < 2; ++n) acc[a][b][m][n] = (f32x4){0.f, 0.f, 0.f, 0.f};
    bf16x8 At[4][2], B0[2][2], B1[2][2];
    const char* cA = (const char*)g.A + (size_t)cur.pm * tstepA; const char* cB = (const char*)g.Bt + (size_t)cur.pn * tstep;
    S.a_ready(cur);
    if constexpr (SP2) {
        PG8_STAGE(PG8_SB(0, 0), cB, voffB); PG8_STAGE(PG8_SB(0, 1), cB + hstep, voffB); PG8_STAGE_A(PG8_SA(0, 0), cA, voffA); PG8_STAGE_A(PG8_SA(0, 1), cA + hstepA, voffA);
        if (wr == 1) PG8_BAR;
        PG8_WAIT_VL(2, 0); PG8_BAR;
        PG8_STAGE(PG8_SB(1, 0), cB + kstep, voffB); PG8_STAGE_A(PG8_SA(1, 0), cA + kstep, voffA); PG8_STAGE(PG8_SB(1, 1), cB + hstep + kstep, voffB);
        PG8_WAIT_VL(6, 4); PG8_BAR;
    } else {
        PG8_STAGE(PG8_SB(0, 0), cB, voffB); PG8_STAGE(PG8_SA(0, 0), cA, voffA); PG8_STAGE(PG8_SB(0, 1), cB + hstep, voffB); PG8_STAGE(PG8_SA(0, 1), cA + hstepA, voffA);
        if (wr == 1) PG8_BAR;
        PG8_WAIT_V(4); PG8_BAR;
        PG8_STAGE(PG8_SB(1, 0), cB + kstep, voffB); PG8_STAGE(PG8_SA(1, 0), cA + kstep, voffA); PG8_STAGE(PG8_SB(1, 1), cB + hstep + kstep, voffB);
        PG8_WAIT_V(6); PG8_BAR;
    }
    for (;;) {
        const bool has_next = S.next(ui + 1, nxt);
        const char* nA = has_next ? (const char*)g.A + (size_t)nxt.pm * tstepA : cA; const char* nB = has_next ? (const char*)g.Bt + (size_t)nxt.pn * tstep : cB;
        for (int t = 0; t < nt; t += 2) {
            const bool last = (t == nt - 2);
            const char* a1 = cA + (size_t)(t + 1) * kstep;
            const char* a2 = last ? nA : cA + (size_t)(t + 2) * kstep; const char* b2 = last ? nB : cB + (size_t)(t + 2) * kstep;
            const char* a3 = a2 + kstep; const char* b3 = b2 + kstep;
            if (last && has_next) S.a_ready(nxt);
            if constexpr (SP2) {
            PG8_LDB(B0, 0, 0); PG8_LDB(B1, 0, 1); PG8_SCHED; PG8_LDA(At, 0, 0); PG8_STAGE_A(PG8_SA(1, 1), a1 + hstepA, voffA);
            PG8_WAIT_VL(8, 4); PG8_WAIT_L(0); PG8_BAR; PG8_MMA(0, 0, At, B0); PG8_MMA(0, 1, At, B1); PG8_BAR; PG8_SCHED;
            PG8_LDA(At, 0, 1); PG8_STAGE(PG8_SB(0, 0), b2, voffB); PG8_STAGE(PG8_SB(0, 1), b2 + hstep, voffB); PG8_STAGE_A(PG8_SA(0, 0), a2, voffA);
            PG8_WAIT_VL(8, 4); PG8_WAIT_L(0); PG8_BAR; PG8_MMA(1, 0, At, B0); PG8_MMA(1, 1, At, B1); PG8_BAR; PG8_SCHED;
            PG8_LDB(B0, 1, 0); PG8_LDB(B1, 1, 1); PG8_SCHED; PG8_LDA(At, 1, 0); PG8_STAGE_A(PG8_SA(0, 1), a2 + hstepA, voffA);
            PG8_WAIT_VL(8, 4); PG8_WAIT_L(0); PG8_BAR; PG8_MMA(0, 0, At, B0); PG8_MMA(0, 1, At, B1); PG8_BAR; PG8_SCHED;
            PG8_LDA(At, 1, 1); PG8_STAGE(PG8_SB(1, 0), b3, voffB); PG8_STAGE(PG8_SB(1, 1), b3 + hstep, voffB); PG8_STAGE_A(PG8_SA(1, 0), a3, voffA);
            PG8_WAIT_VL(8, 4); PG8_WAIT_L(0); PG8_BAR; PG8_MMA(1, 0, At, B0); PG8_MMA(1, 1, At, B1); PG8_BAR; PG8_SCHED;
            } else {
            PG8_LDB(B0, 0, 0); PG8_SCHED; PG8_LDA(At, 0, 0); PG8_STAGE(PG8_SA(1, 1), a1 + hstepA, voffA);
            PG8_WAIT_L(8); PG8_BAR; PG8_WAIT_L(0); PG8_MMA(0, 0, At, B0); PG8_BAR; PG8_SCHED;
            PG8_LDB(B1, 0, 1); PG8_STAGE(PG8_SB(0, 0), b2, voffB);
            PG8_BAR; PG8_WAIT_L(0); PG8_MMA(0, 1, At, B1); PG8_BAR;
            PG8_LDA(At, 0, 1); PG8_STAGE(PG8_SA(0, 0), a2, voffA);
            PG8_BAR; PG8_WAIT_L(0); PG8_MMA(1, 0, At, B0); PG8_BAR; PG8_SCHED;
            PG8_STAGE(PG8_SB(0, 1), b2 + hstep, voffB);
            PG8_WAIT_V(6); PG8_BAR; PG8_MMA(1, 1, At, B1); PG8_BAR;
            PG8_LDB(B0, 1, 0); PG8_SCHED; PG8_LDA(At, 1, 0); PG8_STAGE(PG8_SA(0, 1), a2 + hstepA, voffA);
            PG8_WAIT_L(8); PG8_BAR; PG8_WAIT_L(0); PG8_MMA(0, 0, At, B0); PG8_BAR; PG8_SCHED;
            PG8_LDB(B1, 1, 1); PG8_STAGE(PG8_SB(1, 0), b3, voffB);
            PG8_BAR; PG8_WAIT_L(0); PG8_MMA(0, 1, At, B1); PG8_BAR;
            PG8_LDA(At, 1, 1); PG8_STAGE(PG8_SA(1, 0), a3, voffA);
            PG8_BAR; PG8_WAIT_L(0); PG8_MMA(1, 0, At, B0); PG8_BAR; PG8_SCHED;
            PG8_STAGE(PG8_SB(1, 1), b3 + hstep, voffB);
            PG8_WAIT_V(6); PG8_BAR; PG8_MMA(1, 1, At, B1); PG8_BAR;
            }
        }
        if constexpr (ALIGN_EPI) { if (wr == 0) PG8_BAR; }
        if constexpr (Epi::HAS_TAB) {
            typename Epi::Pre pn_; if (has_next) pn_ = E.pre_load(nxt, tid);
            E(acc, cur, wr, wc, fr, fq, tabs + (ui & 1) * Epi::TABSZ);
            if (has_next) E.pre_store(pn_, tabs + ((ui + 1) & 1) * Epi::TABSZ, tid);
            S.done(cur);
        } else
        if constexpr (!Epi::AFTER_DRAIN) { E(acc, cur, wr, wc, fr, fq); S.done(cur); }
        if (!has_next) break;
#pragma unroll
        for (int a = 0; a < 2; ++a)
#pragma unroll
            for (int b = 0; b < 2; ++b)
#pragma unroll
                for (int m = 0; m < 4; ++m)
#pragma unroll
                    for (int n = 0; n < 2; ++n) acc[a][b][m][n] = (f32x4){0.f, 0.f, 0.f, 0.f};
        cur = nxt; cA = nA; cB = nB; ++ui;
        if constexpr (ALIGN_EPI) { if (wr == 1) PG8_BAR; }
    }
    PG8_WAIT_V(0);
    if constexpr (!ALIGN_EPI) { if (wr == 0) PG8_BAR; }
    PG8_BAR;
    if constexpr (Epi::AFTER_DRAIN) { E.fused(acc, cur, wr, wc, fr, fq, lds, wid, lane); S.done(cur); }
#undef PG8_SA
#undef PG8_SB
#undef PG8_STAGE
#undef PG8_LDA
#undef PG8_LDB
#undef PG8_MMA
#undef PG8_WAIT_V
#undef PG8_WAIT_VL
#undef PG8_STAGE_A
#undef PG8_WAIT_L
#undef PG8_BAR
#undef PG8_SCHED
}
}

constexpr int D = 1024, FF = 2816, NGU = 5632, NIN = 2816;
constexpr int M_CTX = 4096, M = 12288;
constexpr int NMOD = 9216;
constexpr size_t MiB = 1u << 20;
constexpr size_t WS_MOD = 1 * MiB, WS_ROPE = 1 * MiB + 768 * 1024, WS_W = 2 * MiB;
constexpr size_t W_GU1 = 0, W_D1 = 11534336, W_IN = 17301504, W_OUT = 23068672, W_GU2 = 25165824, W_D2 = 36700160, W_LAYER = 42467328;
constexpr size_t WS_X = WS_W + 2 * W_LAYER;
constexpr size_t WS_H = WS_X + (size_t)M * D * 4;
constexpr size_t WS_Y = WS_H + (size_t)M * D * 2;
constexpr size_t WS_ACT = WS_Y + (size_t)M * D * 2;
constexpr size_t WS_END = WS_ACT + (size_t)M * FF * 2;
constexpr size_t WS_BIAS = WS_END;
constexpr int NBIAS = NGU + NIN + NGU, BOFF_GU1 = 0, BOFF_IN = NGU, BOFF_GU2 = NGU + NIN;
constexpr size_t WS_PSS = WS_BIAS + (size_t)2 * 9 * NBIAS * 4;
constexpr size_t WS_END2 = WS_PSS + (size_t)M * 16 * 4;
constexpr int LDS_BYTES = 147456;
constexpr int GU_MAIN_PANELS = 46, GU_TMB = 1;
constexpr int NTHREADS = 512;

#define LAS __attribute__((address_space(3)))
typedef unsigned short bf16;
typedef unsigned v4u __attribute__((ext_vector_type(4)));
typedef unsigned v2u __attribute__((ext_vector_type(2)));
typedef float f32x4 __attribute__((ext_vector_type(4)));
typedef short bf16x8 __attribute__((ext_vector_type(8)));
typedef short s16x4 __attribute__((ext_vector_type(4)));

struct Args { const float* in[21]; float* out; unsigned char* ws; };
typedef const __attribute__((address_space(4))) Args* KArgs;
__device__ __forceinline__ int lane_id_fresh() { int l; asm volatile("v_mbcnt_lo_u32_b32 %0, -1, 0\n\tv_mbcnt_hi_u32_b32 %0, -1, %0" : "=v"(l)); return l; }
__device__ __forceinline__ KArgs kargs() { KArgs p = (KArgs)__builtin_amdgcn_kernarg_segment_ptr(); asm volatile("" : "+s"(p)); return p; }

__device__ __forceinline__ unsigned pk2(float lo, float hi) { return pg8::cvt_pk_bf16(lo, hi); }
__device__ __forceinline__ v4u pack8(f32x4 a, f32x4 b) { v4u w; w.x = pk2(a[0], a[1]); w.y = pk2(a[2], a[3]); w.z = pk2(b[0], b[1]); w.w = pk2(b[2], b[3]); return w; }
__device__ __forceinline__ float bflo(unsigned u) { return __uint_as_float(u << 16); }
__device__ __forceinline__ float bfhi(unsigned u) { return __uint_as_float(u & 0xffff0000u); }
__device__ __forceinline__ float wave_sum(float v) {
#pragma unroll
    for (int o = 1; o < 64; o <<= 1) v += __shfl_xor(v, o);
    return v;
}
__device__ __forceinline__ float xmax16_32(float v) {
    auto a = __builtin_amdgcn_permlane16_swap(__float_as_uint(v), __float_as_uint(v), false, false); v = fmaxf(__uint_as_float(a[0]), __uint_as_float(a[1]));
    auto b = __builtin_amdgcn_permlane32_swap(__float_as_uint(v), __float_as_uint(v), false, false); return fmaxf(__uint_as_float(b[0]), __uint_as_float(b[1]));
}
__device__ __forceinline__ float xsum16_32(float v) {
    auto a = __builtin_amdgcn_permlane16_swap(__float_as_uint(v), __float_as_uint(v), false, false); v = __uint_as_float(a[0]) + __uint_as_float(a[1]);
    auto b = __builtin_amdgcn_permlane32_swap(__float_as_uint(v), __float_as_uint(v), false, false); return __uint_as_float(b[0]) + __uint_as_float(b[1]);
}
__device__ __forceinline__ float silu_f(float x) { return x * __builtin_amdgcn_rcpf(1.f + __builtin_amdgcn_exp2f(-1.4426950408889634f * x)); }

__device__ __forceinline__ void load_rstd(const float* PSS, int row0, int fq, float (&rstd)[2][4]) {
#pragma unroll
    for (int ai = 0; ai < 2; ++ai)
#pragma unroll
        for (int m = 0; m < 4; ++m) {
            const f32x4 t = *((const f32x4*)(PSS + (unsigned)(row0 + ai * 128 + m * 16) * 16) + fq);
            rstd[ai][m] = (t[0] + t[1]) + (t[2] + t[3]);
        }
#pragma unroll
    for (int ai = 0; ai < 2; ++ai)
#pragma unroll
        for (int m = 0; m < 4; ++m) {
            float q = rstd[ai][m]; q += __shfl_xor(q, 16); q += __shfl_xor(q, 32);
            rstd[ai][m] = 1.f / sqrtf(q * (1.f / D) + 1e-6f);
        }
}
struct TabPre { f32x4 a, b, c, d; };
__device__ __forceinline__ TabPre tab_pre_load(const unsigned char* ws, int bias_off, const pg8::Unit& u, int tid) {
    TabPre p;
    if (tid < 256) { const f32x4* pp = (const f32x4*)((const float*)(ws + WS_PSS) + (unsigned)(u.pm * 256 + tid) * 16); p.a = pp[0]; p.b = pp[1]; p.c = pp[2]; p.d = pp[3]; }
    else { const int cond = u.pm < 16 ? 0 : 1 + ((u.pm - 16) >> 2);
        p.a[0] = ((const float*)(ws + WS_BIAS))[(unsigned)(bias_off + cond * NBIAS + u.pn * 256 + (tid - 256))]; p.b = p.a; p.c = p.a; p.d = p.a; }
    return p;
}
__device__ __forceinline__ void tab_pre_store(const TabPre& p, LAS float* tab, int tid) {
    if (tid < 256) { const f32x4 t = (p.a + p.b) + (p.c + p.d); tab[tid] = 1.f / sqrtf(((t[0] + t[1]) + (t[2] + t[3])) * (1.f / D) + 1e-6f); }
    else tab[tid] = p.a[0];
}
struct EpiSwiglu {
    static constexpr bool PERM = true, AFTER_DRAIN = false, HAS_TAB = true; static constexpr int TABSZ = 512;
    typedef TabPre Pre;
    unsigned char* ws; int bias_off;
    __device__ __forceinline__ Pre pre_load(const pg8::Unit& u, int tid) const { return tab_pre_load(ws, bias_off, u, tid); }
    __device__ __forceinline__ void pre_store(const Pre& p, LAS float* tab, int tid) const { tab_pre_store(p, tab, tid); }
    __device__ __forceinline__ void operator()(const f32x4 (&acc)[2][2][4][2], const pg8::Unit& u, int wr, int wc, int fr, int fq, const LAS float* tab) const {
        bf16* ACT = (bf16*)(ws + WS_ACT);
        const int row0 = u.pm * 256 + wr * 64 + fr, j0 = u.pn * 128 + wc * 32 + 8 * fq;
        const LAS float* bp = tab + 256 + wc * 32 + 8 * fq;
        const f32x4 bg0 = *(const LAS f32x4*)bp, bg1 = *(const LAS f32x4*)(bp + 4), bu0 = *(const LAS f32x4*)(bp + 128), bu1 = *(const LAS f32x4*)(bp + 132);
#pragma unroll
        for (int ai = 0; ai < 2; ++ai)
#pragma unroll
            for (int m = 0; m < 4; ++m) {
                bf16* p = ACT + (unsigned)((row0 + ai * 128 + m * 16) * FF + j0);
                const float r = tab[wr * 64 + ai * 128 + m * 16 + fr];
                const f32x4 g0 = acc[ai][0][m][0] * r + bg0, g1 = acc[ai][0][m][1] * r + bg1, u0 = acc[ai][1][m][0] * r + bu0, u1 = acc[ai][1][m][1] * r + bu1;
                f32x4 t0 = g0 * (-1.4426950408889634f), t1 = g1 * (-1.4426950408889634f);
#pragma unroll
                for (int e = 0; e < 4; ++e) { t0[e] = __builtin_amdgcn_exp2f(t0[e]); t1[e] = __builtin_amdgcn_exp2f(t1[e]); }
                t0 = t0 + 1.f; t1 = t1 + 1.f;
#pragma unroll
                for (int e = 0; e < 4; ++e) { t0[e] = __builtin_amdgcn_rcpf(t0[e]); t1[e] = __builtin_amdgcn_rcpf(t1[e]); }
                const f32x4 o0 = (g0 * u0) * t0, o1 = (g1 * u1) * t1;
                *(v4u*)p = pack8(o0, o1);
            }
    }
};
__device__ __forceinline__ int cond_of_row(int r) { return r < M_CTX ? 0 : 1 + ((r - M_CTX) >> 10); }
template <int TMB> struct EpiSwigluT {
    static constexpr bool PERM = true, AFTER_DRAIN = false, HAS_TAB = true; static constexpr int TABSZ = 512;
    typedef TabPre Pre;
    unsigned char* ws; int bias_off; int row_base;
    __device__ __forceinline__ Pre pre_load(const pg8::Unit& u, int tid) const {
        TabPre p; const int r0 = row_base + 64 * TMB * u.pm;
        if (tid < 256) { const int t = tid < 64 * TMB ? tid : 64 * TMB - 1; const f32x4* pp = (const f32x4*)((const float*)(ws + WS_PSS) + (unsigned)(r0 + t) * 16); p.a = pp[0]; p.b = pp[1]; p.c = pp[2]; p.d = pp[3]; }
        else { p.a[0] = ((const float*)(ws + WS_BIAS))[(unsigned)(bias_off + cond_of_row(r0) * NBIAS + u.pn * 256 + (tid - 256))]; p.b = p.a; p.c = p.a; p.d = p.a; }
        return p;
    }
    __device__ __forceinline__ void pre_store(const Pre& p, LAS float* tab, int tid) const {
        if (tid < 256) { if (tid < 64 * TMB) { const f32x4 t = (p.a + p.b) + (p.c + p.d); tab[tid] = 1.f / sqrtf(((t[0] + t[1]) + (t[2] + t[3])) * (1.f / D) + 1e-6f); } }
        else tab[tid] = p.a[0];
    }
    __device__ __forceinline__ void operator()(const f32x4 (&acc)[2][2][4][2], const pg8::Unit& u, int wr, int wc, int fr, int fq, const LAS float* tab) const {
        bf16* ACT = (bf16*)(ws + WS_ACT);
        const int rl0 = wr * 16 * TMB + fr, j0 = u.pn * 128 + wc * 32 + 8 * fq;
        const int r0 = row_base + 64 * TMB * u.pm;
        const LAS float* bp = tab + 256 + wc * 32 + 8 * fq;
        const f32x4 bg0 = *(const LAS f32x4*)bp, bg1 = *(const LAS f32x4*)(bp + 4), bu0 = *(const LAS f32x4*)(bp + 128), bu1 = *(const LAS f32x4*)(bp + 132);
#pragma unroll
        for (int ai = 0; ai < 2; ++ai)
#pragma unroll
            for (int m = 0; m < TMB; ++m) {
                const int rl = rl0 + ai * 32 * TMB + m * 16;
                bf16* p = ACT + (unsigned)((r0 + rl) * FF + j0);
                const float r = tab[rl];
                const f32x4 g0 = acc[ai][0][m][0] * r + bg0, g1 = acc[ai][0][m][1] * r + bg1, u0 = acc[ai][1][m][0] * r + bu0, u1 = acc[ai][1][m][1] * r + bu1;
                f32x4 t0 = g0 * (-1.4426950408889634f), t1 = g1 * (-1.4426950408889634f);
#pragma unroll
                for (int e = 0; e < 4; ++e) { t0[e] = __builtin_amdgcn_exp2f(t0[e]); t1[e] = __builtin_amdgcn_exp2f(t1[e]); }
                t0 = t0 + 1.f; t1 = t1 + 1.f;
#pragma unroll
                for (int e = 0; e < 4; ++e) { t0[e] = __builtin_amdgcn_rcpf(t0[e]); t1[e] = __builtin_amdgcn_rcpf(t1[e]); }
                const f32x4 o0 = (g0 * u0) * t0, o1 = (g1 * u1) * t1;
                *(v4u*)p = pack8(o0, o1);
            }
    }
};
struct EpiRes {
    static constexpr bool PERM = true, AFTER_DRAIN = false, HAS_TAB = false;
    const float* in_ctx; const float* in_lat; unsigned char* ws; const float* gnext; int gate_off, sc_off; float gs;
    __device__ __forceinline__ void operator()(const f32x4 (&acc)[2][2][4][2], const pg8::Unit& u, int wr, int wc, int fr, int fq) const {
        const int cond = u.pm < 16 ? 0 : 1 + ((u.pm - 16) >> 2);
        float* out = (float*)(ws + WS_X); bf16* XA = (bf16*)(ws + WS_H); float* PSS = (float*)(ws + WS_PSS);
        const float* gp = (const float*)(ws + WS_MOD) + gate_off + (unsigned)cond * NMOD;
        const float* scp = (const float*)(ws + WS_MOD) + sc_off + (unsigned)cond * NMOD;
        const float* base = u.pm < 16 ? in_ctx : in_lat;
        const int row0 = u.pm * 256 + wr * 64 + fr, col0 = u.pn * 256 + wc * 32 + 8 * fq;
        float ss[2][4];
#pragma unroll
        for (int bj = 0; bj < 2; ++bj) {
            const int cb = col0 + bj * 128;
            const f32x4 gv0 = *(const f32x4*)(gp + cb) * gs, gv1 = *(const f32x4*)(gp + cb + 4) * gs;
            f32x4 an0 = (f32x4){0.f, 0.f, 0.f, 0.f}, an1 = an0;
            if (gnext) { an0 = *(const f32x4*)(gnext + cb) * (*(const f32x4*)(scp + cb) + 1.f); an1 = *(const f32x4*)(gnext + cb + 4) * (*(const f32x4*)(scp + cb + 4) + 1.f); }
#pragma unroll
            for (int ai = 0; ai < 2; ++ai)
#pragma unroll
                for (int m = 0; m < 4; ++m) {
                    const unsigned off = (unsigned)(row0 + ai * 128 + m * 16) * D + cb;
                    const f32x4 b0 = *(const f32x4*)(base + off), b1 = *(const f32x4*)(base + off + 4);
                    const f32x4 o0 = b0 + gv0 * acc[ai][bj][m][0], o1 = b1 + gv1 * acc[ai][bj][m][1];
                    *(f32x4*)(out + off) = o0; *(f32x4*)(out + off + 4) = o1;
                    if (gnext) {
                        const float q = ((o0[0] * o0[0] + o0[1] * o0[1]) + (o0[2] * o0[2] + o0[3] * o0[3])) + ((o1[0] * o1[0] + o1[1] * o1[1]) + (o1[2] * o1[2] + o1[3] * o1[3]));
                        ss[ai][m] = bj == 0 ? q : ss[ai][m] + q;
                        *(v4u*)(XA + off) = pack8(o0 * an0, o1 * an1);
                    }
                    if (m & 1) asm volatile("" ::: "memory");
                }
        }
        if (gnext) {
#pragma unroll
            for (int ai = 0; ai < 2; ++ai)
#pragma unroll
                for (int m = 0; m < 4; ++m) {
                    const float q = xsum16_32(ss[ai][m]);
                    if (fq == 0) PSS[(unsigned)(row0 + ai * 128 + m * 16) * 16 + u.pn * 4 + wc] = q;
                }
        }
    }
};
struct EpiRes3 {
    static constexpr bool PERM = true, AFTER_DRAIN = false, HAS_TAB = false;
    const float* in_ctx; const float* in_lat; unsigned char* ws; const float* gnext; int gate_off, sc_off; float gs;
    __device__ __forceinline__ void operator()(const f32x4 (&acc)[2][2][4][2], const pg8::Unit& u, int wr, int wc, int fr, int fq) const {
        float* out = (float*)(ws + WS_X); bf16* XA = (bf16*)(ws + WS_H); float* PSS = (float*)(ws + WS_PSS);
        const float* gp0 = (const float*)(ws + WS_MOD) + gate_off;
        const float* scp0 = (const float*)(ws + WS_MOD) + sc_off;
        const int rb0 = u.pm * 192 + wr * 48, col0 = u.pn * 256 + wc * 32 + 8 * fq;
        const int cond_lo = cond_of_row(u.pm * 192), cond_hi = cond_of_row(u.pm * 192 + 191);
        float ss[2][3];
#pragma unroll
        for (int bj = 0; bj < 2; ++bj) {
            const int cb = col0 + bj * 128;
            f32x4 bs[2][3][2];
#pragma unroll
            for (int ai = 0; ai < 2; ++ai)
#pragma unroll
                for (int m = 0; m < 3; ++m) {
                    const int rb = rb0 + ai * 96 + m * 16;
                    const float* base = rb < M_CTX ? in_ctx : in_lat;
                    const unsigned off = (unsigned)((rb + fr) * D + cb);
                    bs[ai][m][0] = *(const f32x4*)(base + off); bs[ai][m][1] = *(const f32x4*)(base + off + 4);
                }
            const float* gl = gp0 + (unsigned)(cond_lo * NMOD + cb); const float* gh = gp0 + (unsigned)(cond_hi * NMOD + cb);
            const f32x4 gvl0 = *(const f32x4*)gl * gs, gvl1 = *(const f32x4*)(gl + 4) * gs, gvh0 = *(const f32x4*)gh * gs, gvh1 = *(const f32x4*)(gh + 4) * gs;
            f32x4 anl0 = (f32x4){0.f, 0.f, 0.f, 0.f}, anl1 = anl0, anh0 = anl0, anh1 = anl0;
            if (gnext) {
                const f32x4 gn0 = *(const f32x4*)(gnext + cb), gn1 = *(const f32x4*)(gnext + cb + 4);
                const float* sl = scp0 + (unsigned)(cond_lo * NMOD + cb); const float* sh = scp0 + (unsigned)(cond_hi * NMOD + cb);
                anl0 = gn0 * (*(const f32x4*)sl + 1.f); anl1 = gn1 * (*(const f32x4*)(sl + 4) + 1.f);
                anh0 = gn0 * (*(const f32x4*)sh + 1.f); anh1 = gn1 * (*(const f32x4*)(sh + 4) + 1.f);
            }
#pragma unroll
            for (int ai = 0; ai < 2; ++ai)
#pragma unroll
                for (int m = 0; m < 3; ++m) {
                    const int rb = rb0 + ai * 96 + m * 16;
                    const bool hi = cond_of_row(rb) != cond_lo;
                    const f32x4 gv0 = hi ? gvh0 : gvl0, gv1 = hi ? gvh1 : gvl1;
                    const unsigned off = (unsigned)((rb + fr) * D + cb);
                    const f32x4 o0 = bs[ai][m][0] + gv0 * acc[ai][bj][m][0], o1 = bs[ai][m][1] + gv1 * acc[ai][bj][m][1];
                    *(f32x4*)(out + off) = o0; *(f32x4*)(out + off + 4) = o1;
                    if (gnext) {
                        const f32x4 an0 = hi ? anh0 : anl0, an1 = hi ? anh1 : anl1;
                        const float q = ((o0[0] * o0[0] + o0[1] * o0[1]) + (o0[2] * o0[2] + o0[3] * o0[3])) + ((o1[0] * o1[0] + o1[1] * o1[1]) + (o1[2] * o1[2] + o1[3] * o1[3]));
                        ss[ai][m] = bj == 0 ? q : ss[ai][m] + q;
                        *(v4u*)(XA + off) = pack8(o0 * an0, o1 * an1);
                    }
                }
        }
        if (gnext) {
#pragma unroll
            for (int ai = 0; ai < 2; ++ai)
#pragma unroll
                for (int m = 0; m < 3; ++m) {
                    const float q = xsum16_32(ss[ai][m]);
                    if (fq == 0) PSS[(unsigned)(rb0 + ai * 96 + m * 16 + fr) * 16 + u.pn * 4 + wc] = q;
                }
        }
    }
};
struct EpiWin {
    static constexpr bool PERM = true, AFTER_DRAIN = false, HAS_TAB = true; static constexpr int TABSZ = 512;
    typedef TabPre Pre;
    unsigned char* ws; float* newk; int layer;
    __device__ __forceinline__ Pre pre_load(const pg8::Unit& u, int tid) const { return tab_pre_load(ws, layer * 9 * NBIAS + BOFF_IN, u, tid); }
    __device__ __forceinline__ void pre_store(const Pre& p, LAS float* tab, int tid) const { tab_pre_store(p, tab, tid); }
    __device__ __forceinline__ void operator()(const f32x4 (&acc)[2][2][4][2], const pg8::Unit& u, int wr, int wc, int fr, int fq, const LAS float* tab) const {
        bf16* Z = (bf16*)(ws + WS_ACT); float* newv = newk + 16 * 2 * 4 * 256 * 128;
        const float* rc = (const float*)(ws + WS_ROPE); const float* rs = rc + 1024;
        const int pn = u.pn, pm = u.pm; const bool lat = pm >= 16;
        const int row0 = pm * 256 + wr * 64 + fr;
        const LAS float* bp = tab + 256 + wc * 32 + 8 * fq;
        const LAS float* rp = tab + wr * 64 + fr;
#define WIN_BV() const f32x4 bv00 = *(const LAS f32x4*)bp, bv01 = *(const LAS f32x4*)(bp + 4), bv10 = *(const LAS f32x4*)(bp + 128), bv11 = *(const LAS f32x4*)(bp + 132)
        if (pn < 4) {
            const int lc = 256 * pn + 64 * wc + 8 * fq;
#pragma unroll
            for (int ai = 0; ai < 2; ++ai)
#pragma unroll
                for (int m = 0; m < 4; ++m) {
                    const int row = row0 + ai * 128 + m * 16; const float r = rp[ai * 128 + m * 16]; WIN_BV();
                    f32x4 a0 = acc[ai][0][m][0] * r + bv00, a1 = acc[ai][0][m][1] * r + bv01, b0 = acc[ai][1][m][0] * r + bv10, b1 = acc[ai][1][m][1] * r + bv11;
                    if (lat) {
                        const int t = (row - M_CTX) & 1023; const int pos = fq < 2 ? (t >> 6) : (t & 63);
                        const float* cp = rc + pos * 16 + 8 * (fq & 1); const float* sp = rs + pos * 16 + 8 * (fq & 1);
                        const f32x4 c0 = *(const f32x4*)cp, c1 = *(const f32x4*)(cp + 4), s0 = *(const f32x4*)sp, s1 = *(const f32x4*)(sp + 4);
                        const f32x4 na0 = a0 * c0 - b0 * s0, na1 = a1 * c1 - b1 * s1, nb0 = b0 * c0 + a0 * s0, nb1 = b1 * c1 + a1 * s1;
                        a0 = na0; a1 = na1; b0 = nb0; b1 = nb1;
                    }
                    bf16* zp = Z + (unsigned)(row * NIN + lc);
                    *(v4u*)zp = pack8(a0, a1); *(v4u*)(zp + 32) = pack8(b0, b1);
                    if (!lat && pn >= 2) {
                        const int kc = lc - 512, hh = kc >> 7, dd = kc & 127;
                        float* kp = newk + (unsigned)((((pm * 2 + layer) * 4 + hh) * 256 + (row & 255)) * 128 + dd);
                        *(f32x4*)kp = a0; *(f32x4*)(kp + 4) = a1; *(f32x4*)(kp + 32) = b0; *(f32x4*)(kp + 36) = b1;
                    }
                    asm volatile("" ::: "memory");
                }
        } else {
            const int col = 256 * pn + 32 * wc + 8 * fq;
#pragma unroll
            for (int ai = 0; ai < 2; ++ai)
#pragma unroll
                for (int m = 0; m < 4; ++m) {
                    const int row = row0 + ai * 128 + m * 16; const float r = rp[ai * 128 + m * 16]; WIN_BV();
                    const f32x4 a0 = acc[ai][0][m][0] * r + bv00, a1 = acc[ai][0][m][1] * r + bv01, b0 = acc[ai][1][m][0] * r + bv10, b1 = acc[ai][1][m][1] * r + bv11;
                    bf16* zp = Z + (unsigned)(row * NIN + col);
                    *(v4u*)zp = pack8(a0, a1); *(v4u*)(zp + 128) = pack8(b0, b1);
                    if (!lat && pn < 6) {
                        const int vc = col - 1024, hh = vc >> 7, dd = vc & 127;
                        float* vp = newv + (unsigned)((((pm * 2 + layer) * 4 + hh) * 256 + (row & 255)) * 128 + dd);
                        *(f32x4*)vp = a0; *(f32x4*)(vp + 4) = a1; *(f32x4*)(vp + 256 * 128) = b0; *(f32x4*)(vp + 256 * 128 + 4) = b1;
                    }
                    asm volatile("" ::: "memory");
                }
        }
    }
};

__device__ __forceinline__ TabPre tab_pre_load3(const unsigned char* ws, int bias_off, const pg8::Unit& u, int tid) {
    TabPre p;
    if (tid < 256) { const int t = tid < 192 ? tid : 191; const f32x4* pp = (const f32x4*)((const float*)(ws + WS_PSS) + (unsigned)(u.pm * 192 + t) * 16); p.a = pp[0]; p.b = pp[1]; p.c = pp[2]; p.d = pp[3]; }
    else { const float* bb = (const float*)(ws + WS_BIAS) + (unsigned)(bias_off + u.pn * 256 + (tid - 256));
        p.a[0] = bb[(unsigned)(cond_of_row(u.pm * 192) * NBIAS)]; p.b = p.a; p.b[0] = bb[(unsigned)(cond_of_row(u.pm * 192 + 191) * NBIAS)]; p.c = p.a; p.d = p.a; }
    return p;
}
__device__ __forceinline__ void tab_pre_store3(const TabPre& p, LAS float* tab, int tid) {
    if (tid < 256) { if (tid < 192) { const f32x4 t = (p.a + p.b) + (p.c + p.d); tab[tid] = 1.f / sqrtf(((t[0] + t[1]) + (t[2] + t[3])) * (1.f / D) + 1e-6f); } }
    else { tab[tid] = p.a[0]; tab[tid + 256] = p.b[0]; }
}
struct EpiWin3 {
    static constexpr bool PERM = true, AFTER_DRAIN = false, HAS_TAB = true; static constexpr int TABSZ = 768;
    typedef TabPre Pre;
    unsigned char* ws; float* newk; int layer;
    __device__ __forceinline__ Pre pre_load(const pg8::Unit& u, int tid) const { return tab_pre_load3(ws, layer * 9 * NBIAS + BOFF_IN, u, tid); }
    __device__ __forceinline__ void pre_store(const Pre& p, LAS float* tab, int tid) const { tab_pre_store3(p, tab, tid); }
    __device__ __forceinline__ void operator()(const f32x4 (&acc)[2][2][4][2], const pg8::Unit& u, int wr, int wc, int fr, int fq, const LAS float* tab) const {
        bf16* Z = (bf16*)(ws + WS_ACT); float* newv = newk + 16 * 2 * 4 * 256 * 128;
        const float* rc = (const float*)(ws + WS_ROPE); const float* rs = rc + 1024;
        const int pn = u.pn;
        const int rb0 = u.pm * 192 + wr * 48, cond_lo = cond_of_row(u.pm * 192);
        const LAS float* bp0 = tab + 256 + wc * 32 + 8 * fq;
        const LAS float* rp = tab + wr * 48 + fr;
#define WIN3_BV() const LAS float* bp = bp0 + (cond_of_row(rb) != cond_lo ? 256 : 0); const f32x4 bv00 = *(const LAS f32x4*)bp, bv01 = *(const LAS f32x4*)(bp + 4), bv10 = *(const LAS f32x4*)(bp + 128), bv11 = *(const LAS f32x4*)(bp + 132)
        if (pn < 4) {
            const int lc = 256 * pn + 64 * wc + 8 * fq;
#pragma unroll
            for (int ai = 0; ai < 2; ++ai)
#pragma unroll
                for (int m = 0; m < 3; ++m) {
                    const int rb = rb0 + ai * 96 + m * 16, row = rb + fr; const bool lat = rb >= M_CTX;
                    const float r = rp[ai * 96 + m * 16]; WIN3_BV();
                    f32x4 a0 = acc[ai][0][m][0] * r + bv00, a1 = acc[ai][0][m][1] * r + bv01, b0 = acc[ai][1][m][0] * r + bv10, b1 = acc[ai][1][m][1] * r + bv11;
                    if (lat) {
                        const int t = (row - M_CTX) & 1023; const int pos = fq < 2 ? (t >> 6) : (t & 63);
                        const float* cp = rc + pos * 16 + 8 * (fq & 1); const float* sp = rs + pos * 16 + 8 * (fq & 1);
                        const f32x4 c0 = *(const f32x4*)cp, c1 = *(const f32x4*)(cp + 4), s0 = *(const f32x4*)sp, s1 = *(const f32x4*)(sp + 4);
                        const f32x4 na0 = a0 * c0 - b0 * s0, na1 = a1 * c1 - b1 * s1, nb0 = b0 * c0 + a0 * s0, nb1 = b1 * c1 + a1 * s1;
                        a0 = na0; a1 = na1; b0 = nb0; b1 = nb1;
                    }
                    bf16* zp = Z + (unsigned)(row * NIN + lc);
                    *(v4u*)zp = pack8(a0, a1); *(v4u*)(zp + 32) = pack8(b0, b1);
                    if (!lat && pn >= 2) {
                        const int kc = lc - 512, hh = kc >> 7, dd = kc & 127;
                        float* kp = newk + (unsigned)(((((row >> 8) * 2 + layer) * 4 + hh) * 256 + (row & 255)) * 128 + dd);
                        *(f32x4*)kp = a0; *(f32x4*)(kp + 4) = a1; *(f32x4*)(kp + 32) = b0; *(f32x4*)(kp + 36) = b1;
                    }
                    asm volatile("" ::: "memory");
                }
        } else {
            const int col = 256 * pn + 32 * wc + 8 * fq;
#pragma unroll
            for (int ai = 0; ai < 2; ++ai)
#pragma unroll
                for (int m = 0; m < 3; ++m) {
                    const int rb = rb0 + ai * 96 + m * 16, row = rb + fr; const bool lat = rb >= M_CTX;
                    const float r = rp[ai * 96 + m * 16]; WIN3_BV();
                    const f32x4 a0 = acc[ai][0][m][0] * r + bv00, a1 = acc[ai][0][m][1] * r + bv01, b0 = acc[ai][1][m][0] * r + bv10, b1 = acc[ai][1][m][1] * r + bv11;
                    bf16* zp = Z + (unsigned)(row * NIN + col);
                    *(v4u*)zp = pack8(a0, a1); *(v4u*)(zp + 128) = pack8(b0, b1);
                    if (!lat && pn < 6) {
                        const int vc = col - 1024, hh = vc >> 7, dd = vc & 127;
                        float* vp = newv + (unsigned)(((((row >> 8) * 2 + layer) * 4 + hh) * 256 + (row & 255)) * 128 + dd);
                        *(f32x4*)vp = a0; *(f32x4*)(vp + 4) = a1; *(f32x4*)(vp + 256 * 128) = b0; *(f32x4*)(vp + 256 * 128 + 4) = b1;
                    }
                    asm volatile("" ::: "memory");
                }
        }
#undef WIN3_BV
    }
};

__device__ __forceinline__ void p0_mod(LAS unsigned char* lds, KArgs A, int tid) {
    LAS float* sc = (LAS float*)lds;
    LAS float* red = (LAS float*)(lds + 36864);
    for (int idx = tid; idx < 9 * 1024; idx += NTHREADS) { const int c = idx >> 10, k = idx & 1023; const float x = c == 0 ? A->in[5][k] : A->in[4][(c - 1) * 1024 + k]; sc[idx] = x / (1.f + __expf(-x)); }
    __syncthreads();
    float* MOD = (float*)(A->ws + WS_MOD);
    for (int it = blockIdx.x; it < 256; it += gridDim.x) {
        const int l = it >> 7, col0 = (it & 127) * 72;
        if (tid < 504) {
            const int kg = tid / 18, c4 = tid % 18;
            f32x4 acc[9];
#pragma unroll
            for (int c = 0; c < 9; ++c) acc[c] = (f32x4){0.f, 0.f, 0.f, 0.f};
            const float* wp = A->in[6] + (size_t)l * 1024 * NMOD + col0 + 4 * c4;
#pragma unroll 4
            for (int k = kg; k < 1024; k += 28) {
                const f32x4 w = *(const f32x4*)(wp + (size_t)k * NMOD);
#pragma unroll
                for (int c = 0; c < 9; ++c) acc[c] += w * sc[c * 1024 + k];
            }
#pragma unroll
            for (int c = 0; c < 9; ++c)
#pragma unroll
                for (int e = 0; e < 4; ++e) red[(kg * 9 + c) * 72 + 4 * c4 + e] = acc[c][e];
        }
        __syncthreads();
        for (int idx = tid; idx < 648; idx += NTHREADS) {
            const int c = idx / 72, j = idx % 72; float s = A->in[7][l * NMOD + col0 + j];
            for (int kg = 0; kg < 28; ++kg) s += red[(kg * 9 + c) * 72 + j];
            MOD[(size_t)(l * 9 + c) * NMOD + col0 + j] = s;
        }
        __syncthreads();
    }
}
__device__ __forceinline__ void transpose_item(const float* W, int K, int N, bf16* WT, LAS float* scr, int item, int lane, int kind) {
    const int nblk = N / 32, kb = item / nblk, nb = item % nblk, k0 = 64 * kb, n0 = 32 * nb;
    int ln0 = n0;
    if (kind == 1) { const int pn = n0 >> 8, w = n0 & 255; ln0 = (w >> 7) * FF + 128 * pn + (w & 127); }
    else if (kind == 2 && n0 < 1024) { const int pn = n0 >> 8, w = n0 & 255; ln0 = 256 * pn + 64 * ((w & 127) >> 5) + 32 * (w >> 7); }
#pragma unroll 8
    for (int i = 0; i < 32; ++i) { const int kk = 2 * i + (lane >> 5); scr[kk * 33 + (lane & 31)] = W[(size_t)(k0 + kk) * N + ln0 + (lane & 31)]; }
    asm volatile("s_waitcnt lgkmcnt(0)" ::: "memory");
    const int c = lane & 7;
#pragma unroll
    for (int j = 0; j < 4; ++j) { const int n = (lane >> 3) + 8 * j; const LAS float* s = scr + (8 * c) * 33 + n;
        v4u o; o.x = pk2(s[0 * 33], s[1 * 33]); o.y = pk2(s[2 * 33], s[3 * 33]); o.z = pk2(s[4 * 33], s[5 * 33]); o.w = pk2(s[6 * 33], s[7 * 33]);
        *(v4u*)(WT + (size_t)(n0 + n) * K + k0 + 8 * c) = o; }
    asm volatile("s_waitcnt lgkmcnt(0)" ::: "memory");
}
__device__ __forceinline__ void p0_weights(LAS unsigned char* lds, KArgs A, int gw, int NGW, int wave, int lane) {
    LAS float* scr = (LAS float*)(lds + wave * 16384);
    constexpr int I_GU = 16 * 176, I_D = 44 * 32, I_IN = 16 * 88, I_OUT = 16 * 32, I_LAYER = 2 * I_GU + 2 * I_D + I_IN + I_OUT;
    for (int it = gw; it < 2 * I_LAYER; it += NGW) {
        const int l = it / I_LAYER; int r = it % I_LAYER;
        unsigned char* wl = A->ws + WS_W + (size_t)l * W_LAYER;
        if (r < I_GU) { transpose_item(A->in[9] + (size_t)l * D * NGU, D, NGU, (bf16*)(wl + W_GU1), scr, r, lane, 1); continue; } r -= I_GU;
        if (r < I_D) { transpose_item(A->in[10] + (size_t)l * FF * D, FF, D, (bf16*)(wl + W_D1), scr, r, lane, 0); continue; } r -= I_D;
        if (r < I_IN) { transpose_item(A->in[13] + (size_t)l * D * NIN, D, NIN, (bf16*)(wl + W_IN), scr, r, lane, 2); continue; } r -= I_IN;
        if (r < I_OUT) { transpose_item(A->in[14] + (size_t)l * D * D, D, D, (bf16*)(wl + W_OUT), scr, r, lane, 0); continue; } r -= I_OUT;
        if (r < I_GU) { transpose_item(A->in[11] + (size_t)l * D * NGU, D, NGU, (bf16*)(wl + W_GU2), scr, r, lane, 1); continue; } r -= I_GU;
        transpose_item(A->in[12] + (size_t)l * FF * D, FF, D, (bf16*)(wl + W_D2), scr, r, lane, 0);
    }
}

__device__ __forceinline__ void xa_phase(const float* in_ctx, const float* in_lat, const float* g, const float* modl, int isc, bf16* XA, float* PSS, int gw, int NGW, int lane) {
    asm volatile("" : "+v"(lane));
    for (int m = gw; m < M; m += NGW) {
        const float* xrow = (m < M_CTX ? in_ctx : in_lat) + (size_t)m * D;
        const int cond = m < M_CTX ? 0 : 1 + ((m - M_CTX) >> 10);
        const f32x4* sc4 = (const f32x4*)(modl + (size_t)cond * NMOD + isc * 1024);
        const f32x4* g4 = (const f32x4*)g; const f32x4* x4 = (const f32x4*)xrow;
        f32x4 v[4]; float ss = 0.f;
#pragma unroll
        for (int j = 0; j < 4; ++j) { v[j] = x4[lane + 64 * j]; ss += (v[j].x * v[j].x + v[j].y * v[j].y) + (v[j].z * v[j].z + v[j].w * v[j].w); }
        ss = wave_sum(ss);
        if (lane < 16) PSS[(size_t)m * 16 + lane] = lane == 0 ? ss : 0.f;
        v2u* o = (v2u*)(XA + (size_t)m * D);
#pragma unroll
        for (int j = 0; j < 4; ++j) {
            const int k4 = lane + 64 * j;
            const f32x4 r = v[j] * g4[k4] * (sc4[k4] + 1.f);
            v2u w; w.x = pk2(r.x, r.y); w.y = pk2(r.z, r.w); o[k4] = w;
        }
    }
}
__device__ __forceinline__ void bias_phase(LAS unsigned char* lds, KArgs A, int bxv, int G, int tid, int wave, int lane) {
    const int combo = bxv % 6, l = combo / 3, sidx = combo % 3;
    const int N = sidx == 1 ? NIN : NGU;
    const int boff = sidx == 0 ? BOFF_GU1 : (sidx == 1 ? BOFF_IN : BOFF_GU2);
    const bf16* Wt = (const bf16*)(A->ws + WS_W + (size_t)l * W_LAYER + (sidx == 0 ? W_GU1 : (sidx == 1 ? W_IN : W_GU2)));
    const float* MOD = (const float*)(A->ws + WS_MOD) + (size_t)l * 9 * NMOD + sidx * 3 * 1024;
    float* BIAS = (float*)(A->ws + WS_BIAS) + (size_t)l * 9 * NBIAS + boff;
    LAS bf16* shh = (LAS bf16*)lds;
    LAS bf16* shl = (LAS bf16*)(lds + 32768);
    __syncthreads();
    for (int idx = tid; idx < 16 * 1024; idx += NTHREADS) {
        const int c = idx >> 10, k = idx & 1023;
        const float v = c < 9 ? MOD[(size_t)c * NMOD + k] : 0.f;
        const unsigned hi = pk2(v, 0.f) & 0xffffu; const float r = v - __uint_as_float(hi << 16);
        shh[idx] = (bf16)hi; shl[idx] = (bf16)(pk2(r, 0.f) & 0xffffu);
    }
    __syncthreads();
    const int i16 = lane & 15, kg = lane >> 4;
    const int nwg = (G - combo + 5) / 6;
    const int wslot = (bxv / 6) * 8 + wave, nslots = nwg * 8;
    for (int task = wslot; task < N / 16; task += nslots) {
        const bf16* wp = Wt + (size_t)(task * 16 + i16) * D + 8 * kg;
        f32x4 acc = (f32x4){0.f, 0.f, 0.f, 0.f};
#pragma unroll 8
        for (int ks = 0; ks < 32; ++ks) {
            const bf16x8 a = *(const bf16x8*)(wp + 32 * ks);
            const bf16x8 bh = *(const LAS bf16x8*)(shh + i16 * 1024 + 32 * ks + 8 * kg), bl = *(const LAS bf16x8*)(shl + i16 * 1024 + 32 * ks + 8 * kg);
            acc = __builtin_amdgcn_mfma_f32_16x16x32_bf16(a, bh, acc, 0, 0, 0);
            acc = __builtin_amdgcn_mfma_f32_16x16x32_bf16(a, bl, acc, 0, 0, 0);
        }
        if (i16 < 9) *(f32x4*)(BIAS + (size_t)i16 * NBIAS + task * 16 + 4 * kg) = acc;
    }
    __syncthreads();
}
__device__ __forceinline__ void final_norm(const float* X, const float* g, float* out, int gw, int NGW, int lane) {
    for (int m = gw; m < M; m += NGW) {
        const f32x4* x4 = (const f32x4*)(X + (size_t)m * D); const f32x4* g4 = (const f32x4*)g;
        f32x4 v[4]; float ss = 0.f;
#pragma unroll
        for (int j = 0; j < 4; ++j) { v[j] = x4[lane + 64 * j]; ss += (v[j].x * v[j].x + v[j].y * v[j].y) + (v[j].z * v[j].z + v[j].w * v[j].w); }
        const float rstd = 1.f / sqrtf(wave_sum(ss) * (1.f / D) + 1e-6f);
        f32x4* o = (f32x4*)(out + (size_t)m * D);
#pragma unroll
        for (int j = 0; j < 4; ++j) o[lane + 64 * j] = v[j] * rstd * g4[lane + 64 * j];
    }
}

__device__ __forceinline__ unsigned off_b(unsigned row, unsigned ch) { return 256u * row + 16u * (ch ^ (((row & 3u) << 2) | ((0u - (row >> 2)) & 3u))); }
__device__ __forceinline__ s16x4 vtr(const LAS unsigned char* p) { return __builtin_bit_cast(s16x4, __builtin_amdgcn_ds_read_tr16_b64_v4i16((LAS s16x4*)p)); }

__device__ __forceinline__ void attn_item(LAS unsigned char* lds, KArgs A, int l, bool isLat, int b, int h, int qb, float lam, float oml, int tid, int wave, int lane) {
    const bf16* Z = (const bf16*)(A->ws + WS_ACT);
    bf16* Y = (bf16*)(A->ws + WS_Y);
    const int i16 = lane & 15, kg = lane >> 4;
    const int seq0 = isLat ? M_CTX + b * 1024 : b * 256;
    const int qrow = seq0 + qb * 128 + wave * 16 + i16;
    bf16x8 qf[4];
#pragma unroll
    for (int s = 0; s < 4; ++s) qf[s] = *(const bf16x8*)(Z + (size_t)qrow * NIN + h * 128 + 32 * s + 8 * kg);
    const int NT = isLat ? 20 : 4;
    const size_t coff = (size_t)((b * 2 + l) * 4 + h) * 256 * 128;
    const float* ck = A->in[2] + coff; const float* cv = A->in[3] + coff;
    const int sr = tid >> 4, sch = tid & 15;
    const unsigned sd0 = off_b(sr, sch), sd1 = off_b(sr + 32, sch);
    unsigned koff[4], voff[8];
#pragma unroll
    for (int s = 0; s < 4; ++s) koff[s] = off_b(i16, 4 * s + kg);
    { const int q_ = i16 >> 2, p = lane & 3;
#pragma unroll
      for (int c = 0; c < 8; ++c) voff[c] = 32768u + off_b(4 * kg + q_, 2 * c + (p >> 1)) + 8 * (p & 1); }
    v4u kreg[2], vreg[2];
#define ATT_LOAD(t) do { \
        if (isLat && (t) < 4) { \
            _Pragma("unroll") for (int i_ = 0; i_ < 2; ++i_) { const int key = 64 * (t) + sr + 32 * i_; \
                const float* pk = ck + key * 128 + sch * 8; const float* pv = cv + key * 128 + sch * 8; \
                kreg[i_] = pack8(*(const f32x4*)pk, *(const f32x4*)(pk + 4)); vreg[i_] = pack8(*(const f32x4*)pv, *(const f32x4*)(pv + 4)); } \
        } else { \
            _Pragma("unroll") for (int i_ = 0; i_ < 2; ++i_) { const size_t row = seq0 + 64 * (isLat ? (t) - 4 : (t)) + sr + 32 * i_; \
                kreg[i_] = *(const v4u*)(Z + row * NIN + 512 + h * 128 + sch * 8); vreg[i_] = *(const v4u*)(Z + row * NIN + 1024 + h * 128 + sch * 8); } \
        } } while (0)
#define ATT_STORE(bi) do { \
        *(LAS v4u*)(lds + (bi) * 16384 + sd0) = kreg[0]; *(LAS v4u*)(lds + (bi) * 16384 + sd1) = kreg[1]; \
        *(LAS v4u*)(lds + 32768 + (bi) * 16384 + sd0) = vreg[0]; *(LAS v4u*)(lds + 32768 + (bi) * 16384 + sd1) = vreg[1]; } while (0)
    f32x4 O[2][8];
#pragma unroll
    for (int mp = 0; mp < 2; ++mp)
#pragma unroll
        for (int c = 0; c < 8; ++c) O[mp][c] = (f32x4){0.f, 0.f, 0.f, 0.f};
    float mrun[2] = {-INFINITY, -INFINITY}, lsum[2] = {0.f, 0.f};
    const float c2 = 0.125f * 1.4426950408889634f;
    ATT_LOAD(0); ATT_STORE(0); __syncthreads();
    for (int t = 0; t < NT; ++t) {
        const int bi = t & 1;
        if (t + 1 < NT) ATT_LOAD(t + 1);
        const LAS unsigned char* kb_ = lds + bi * 16384;
        const LAS unsigned char* vb_ = lds + bi * 16384;
        bf16x8 kf[4][4];
#pragma unroll
        for (int kb = 0; kb < 4; ++kb)
#pragma unroll
            for (int s = 0; s < 4; ++s) kf[kb][s] = *(const LAS bf16x8*)(kb_ + kb * 4096 + koff[s]);
        __builtin_amdgcn_sched_barrier(0);
        f32x4 S[2][4];
#pragma unroll
        for (int mp = 0; mp < 2; ++mp)
#pragma unroll
            for (int kb = 0; kb < 4; ++kb) {
                S[mp][kb] = __builtin_amdgcn_mfma_f32_16x16x32_bf16(kf[kb][2 * mp], qf[2 * mp], (f32x4){0.f, 0.f, 0.f, 0.f}, 0, 0, 0);
                S[mp][kb] = __builtin_amdgcn_mfma_f32_16x16x32_bf16(kf[kb][2 * mp + 1], qf[2 * mp + 1], S[mp][kb], 0, 0, 0);
            }
        s16x4 va[8][2], vc[8][2];
#pragma unroll
        for (int c = 0; c < 8; ++c) { va[c][0] = vtr(vb_ + voff[c]); va[c][1] = vtr(vb_ + 256 * 16 + voff[c]); }
        __builtin_amdgcn_sched_barrier(0);
        bf16x8 pb[2][2];
#pragma unroll
        for (int mp = 0; mp < 2; ++mp) {
            float mx = fmaxf(fmaxf(S[mp][0][0], S[mp][0][1]), fmaxf(S[mp][0][2], S[mp][0][3]));
#pragma unroll
            for (int kb = 1; kb < 4; ++kb) mx = fmaxf(mx, fmaxf(fmaxf(S[mp][kb][0], S[mp][kb][1]), fmaxf(S[mp][kb][2], S[mp][kb][3])));
            mx = xmax16_32(mx);
            const float tm = mx * c2;
            if (__builtin_amdgcn_ballot_w64(tm > mrun[mp] + 8.f) != 0ull) {
                const float mnew = fmaxf(mrun[mp], tm);
                const float alpha = __builtin_amdgcn_exp2f(mrun[mp] - mnew);
                mrun[mp] = mnew; lsum[mp] *= alpha;
#pragma unroll
                for (int c = 0; c < 8; ++c) O[mp][c] *= alpha;
            }
            const float mref = mrun[mp];
            float ps = 0.f;
#pragma unroll
            for (int kb = 0; kb < 4; ++kb)
#pragma unroll
                for (int e = 0; e < 4; ++e) { S[mp][kb][e] = __builtin_amdgcn_exp2f(S[mp][kb][e] * c2 - mref); ps += S[mp][kb][e]; }
            lsum[mp] += ps;
#pragma unroll
            for (int ks = 0; ks < 2; ++ks) { const v4u w = pack8(S[mp][2 * ks], S[mp][2 * ks + 1]); pb[mp][ks] = __builtin_bit_cast(bf16x8, w); }
        }
        __builtin_amdgcn_sched_barrier(0);
#pragma unroll
        for (int c = 0; c < 8; ++c) { vc[c][0] = vtr(vb_ + 256 * 32 + voff[c]); vc[c][1] = vtr(vb_ + 256 * 48 + voff[c]); }
#pragma unroll
        for (int c = 0; c < 8; ++c) {
            const bf16x8 vf = (bf16x8){va[c][0][0], va[c][0][1], va[c][0][2], va[c][0][3], va[c][1][0], va[c][1][1], va[c][1][2], va[c][1][3]};
            O[0][c] = __builtin_amdgcn_mfma_f32_16x16x32_bf16(vf, pb[0][0], O[0][c], 0, 0, 0);
            O[1][c] = __builtin_amdgcn_mfma_f32_16x16x32_bf16(vf, pb[1][0], O[1][c], 0, 0, 0);
        }
        __builtin_amdgcn_sched_barrier(0);
#pragma unroll
        for (int c = 0; c < 8; ++c) {
            const bf16x8 vf = (bf16x8){vc[c][0][0], vc[c][0][1], vc[c][0][2], vc[c][0][3], vc[c][1][0], vc[c][1][1], vc[c][1][2], vc[c][1][3]};
            O[0][c] = __builtin_amdgcn_mfma_f32_16x16x32_bf16(vf, pb[0][1], O[0][c], 0, 0, 0);
            O[1][c] = __builtin_amdgcn_mfma_f32_16x16x32_bf16(vf, pb[1][1], O[1][c], 0, 0, 0);
        }
        __builtin_amdgcn_sched_barrier(0);
        if (t + 1 < NT) ATT_STORE(bi ^ 1);
        __syncthreads();
    }
#undef ATT_LOAD
#undef ATT_STORE
    float l1 = lsum[0], l2 = lsum[1];
    l1 += __shfl_xor(l1, 16); l1 += __shfl_xor(l1, 32); l2 += __shfl_xor(l2, 16); l2 += __shfl_xor(l2, 32);
    const float r1 = 1.f / l1, r2 = lam / l2;
    float ss = 0.f;
#pragma unroll
    for (int c = 0; c < 8; ++c) { O[0][c] = O[0][c] * r1 - O[1][c] * r2; ss += (O[0][c][0] * O[0][c][0] + O[0][c][1] * O[0][c][1]) + (O[0][c][2] * O[0][c][2] + O[0][c][3] * O[0][c][3]); }
    ss += __shfl_xor(ss, 16); ss += __shfl_xor(ss, 32);
    const float rstd = oml / sqrtf(ss * (1.f / 128.f) + 1e-6f);
    const float* gsub = A->in[16] + (size_t)(l * 4 + h) * 128;
    bf16* yp = Y + (size_t)qrow * D + h * 128 + 4 * kg;
#pragma unroll
    for (int c = 0; c < 8; ++c) {
        const f32x4 gv = *(const f32x4*)(gsub + 16 * c + 4 * kg);
        const f32x4 o = O[0][c] * rstd * gv;
        v2u w; w.x = pk2(o[0], o[1]); w.y = pk2(o[2], o[3]);
        *(v2u*)(yp + 16 * c) = w;
    }
}

__device__ __forceinline__ void bc_item(LAS unsigned char* lds, KArgs A, int l, int n, int g, int tid, int wave, int lane) {
    asm volatile("" : "+v"(tid)); asm volatile("" : "+v"(lane));
    const bf16* Z = (const bf16*)(A->ws + WS_ACT);
    bf16* Y = (bf16*)(A->ws + WS_Y);
    LAS unsigned char* VC = lds;
    const int r0 = n * 128;
    const int i16 = lane & 15, kg = lane >> 4;
    v4u vcr[2];
#pragma unroll
    for (int i = 0; i < 2; ++i) { const int idx = tid + NTHREADS * i, q = idx >> 3, ch = idx & 7; vcr[i] = *(const v4u*)(Z + (unsigned)((r0 + q) * NIN + 2560 + g * 64 + ch * 8)); }
    const float* wrow = A->in[18] + (unsigned)(((l * 4 + g) * 128 + 16 * wave + i16) * 128 + 8 * kg);
    f32x4 wr_[4][2];
#pragma unroll
    for (int ks = 0; ks < 4; ++ks) { wr_[ks][0] = *(const f32x4*)(wrow + 32 * ks); wr_[ks][1] = *(const f32x4*)(wrow + 32 * ks + 4); }
    const int rowm = r0 + 16 * wave + i16;
    const float bias = A->in[19][(l * 4 + g) * 128 + 16 * wave + i16];
    v2u uu[4];
#pragma unroll
    for (int cb = 0; cb < 4; ++cb) uu[cb] = *(const v2u*)(Z + (unsigned)(rowm * NIN + 2304 + g * 64 + 16 * cb + 4 * kg));
    const int p = tid >> 2, cq = tid & 3;
    const int rowc = r0 + p; const int cc = g * 64 + cq * 16;
    const int seqlen = n < 32 ? 256 : 1024; const int tpos = n < 32 ? (rowc & 255) : ((rowc - M_CTX) & 1023);
    const bool hasp = tpos > 0, hasn = tpos < seqlen - 1;
    const bf16* zr = Z + (unsigned)(rowc * NIN + cc);
    const bf16* zp = hasp ? zr - NIN : zr; const bf16* zn = hasn ? zr + NIN : zr;
    v4u gb[2], gc0[2], hc0[2], gc1[2], hc1[2], gc2[2], hc2[2];
#pragma unroll
    for (int hf = 0; hf < 2; ++hf) {
        gb[hf] = *(const v4u*)(zr + 1536 + 8 * hf);
        gc1[hf] = *(const v4u*)(zr + 1792 + 8 * hf); hc1[hf] = *(const v4u*)(zr + 2048 + 8 * hf);
        gc0[hf] = *(const v4u*)(zp + 1792 + 8 * hf); hc0[hf] = *(const v4u*)(zp + 2048 + 8 * hf);
        gc2[hf] = *(const v4u*)(zn + 1792 + 8 * hf); hc2[hf] = *(const v4u*)(zn + 2048 + 8 * hf);
    }
#pragma unroll
    for (int i = 0; i < 2; ++i) { const int idx = tid + NTHREADS * i, q = idx >> 3, ch = idx & 7; *(LAS v4u*)(VC + q * 128 + ch * 16) = vcr[i]; }
    bf16x8 wf[4];
#pragma unroll
    for (int ks = 0; ks < 4; ++ks) { const v4u w = pack8(wr_[ks][0], wr_[ks][1]); wf[ks] = __builtin_bit_cast(bf16x8, w); }
    __syncthreads();
    f32x4 acc[4];
#pragma unroll
    for (int cb = 0; cb < 4; ++cb) acc[cb] = (f32x4){0.f, 0.f, 0.f, 0.f};
    const LAS unsigned char* vb = VC + (8 * kg + (i16 >> 2)) * 128 + 8 * (lane & 3);
#pragma unroll
    for (int ks = 0; ks < 4; ++ks)
#pragma unroll
        for (int cb = 0; cb < 4; ++cb) {
            const s16x4 lo = vtr(vb + (32 * ks) * 128 + 32 * cb), hi = vtr(vb + (32 * ks + 4) * 128 + 32 * cb);
            const bf16x8 vf = (bf16x8){lo[0], lo[1], lo[2], lo[3], hi[0], hi[1], hi[2], hi[3]};
            acc[cb] = __builtin_amdgcn_mfma_f32_16x16x32_bf16(vf, wf[ks], acc[cb], 0, 0, 0);
        }
#pragma unroll
    for (int cb = 0; cb < 4; ++cb) {
        v2u o; o.x = pk2(bflo(uu[cb].x) * (acc[cb][0] + bias), bfhi(uu[cb].x) * (acc[cb][1] + bias)); o.y = pk2(bflo(uu[cb].y) * (acc[cb][2] + bias), bfhi(uu[cb].y) * (acc[cb][3] + bias));
        *(v2u*)(Y + (unsigned)(rowm * D + 768 + g * 64 + 16 * cb + 4 * kg)) = o;
    }
    {
        const float* cw = A->in[17] + (unsigned)(l * 3 * 256 + cc);
        const float mp_ = hasp ? 1.f : 0.f, mn_ = hasn ? 1.f : 0.f;
#pragma unroll
        for (int hf = 0; hf < 2; ++hf) {
            const f32x4 w0a = *(const f32x4*)(cw + 8 * hf) * mp_, w0b = *(const f32x4*)(cw + 8 * hf + 4) * mp_;
            const f32x4 w1a = *(const f32x4*)(cw + 256 + 8 * hf), w1b = *(const f32x4*)(cw + 256 + 8 * hf + 4);
            const f32x4 w2a = *(const f32x4*)(cw + 512 + 8 * hf) * mn_, w2b = *(const f32x4*)(cw + 512 + 8 * hf + 4) * mn_;
            v4u o;
#pragma unroll
            for (int e = 0; e < 4; ++e) {
                const float wl0 = e < 2 ? w0a[2 * e] : w0b[2 * e - 4], wh0 = e < 2 ? w0a[2 * e + 1] : w0b[2 * e - 3];
                const float wl1 = e < 2 ? w1a[2 * e] : w1b[2 * e - 4], wh1 = e < 2 ? w1a[2 * e + 1] : w1b[2 * e - 3];
                const float wl2 = e < 2 ? w2a[2 * e] : w2b[2 * e - 4], wh2 = e < 2 ? w2a[2 * e + 1] : w2b[2 * e - 3];
                const float lo = bflo(gb[hf][e]) * (wl0 * bflo(gc0[hf][e]) * bflo(hc0[hf][e]) + wl1 * bflo(gc1[hf][e]) * bflo(hc1[hf][e]) + wl2 * bflo(gc2[hf][e]) * bflo(hc2[hf][e]));
                const float hi = bfhi(gb[hf][e]) * (wh0 * bfhi(gc0[hf][e]) * bfhi(hc0[hf][e]) + wh1 * bfhi(gc1[hf][e]) * bfhi(hc1[hf][e]) + wh2 * bfhi(gc2[hf][e]) * bfhi(hc2[hf][e]));
                o[e] = pk2(lo, hi);
            }
            *(v4u*)(Y + (unsigned)(rowc * D + 512 + cc + 8 * hf)) = o;
        }
    }
    __syncthreads();
}

__device__ __forceinline__ void mixer_phase(LAS unsigned char* lds, KArgs A, int l, int vcu, int G, int tid, int wave, int lane) {
    asm volatile("" : "+v"(tid)); lane = tid & 63; wave = __builtin_amdgcn_readfirstlane(tid >> 6);
    const float lam_init = __uint_as_float(__builtin_amdgcn_readfirstlane(l == 0 ? 0x3e4ccccdu : 0x3eb60549u));
    const float* lp = A->in[15] + (size_t)l * 256;
    const float s01 = wave_sum(lp[lane] * lp[64 + lane]), s23 = wave_sum(lp[128 + lane] * lp[192 + lane]);
    const float lam = __uint_as_float(__builtin_amdgcn_readfirstlane(__float_as_uint(__expf(s01) - __expf(s23) + lam_init)));
    const float oml = __uint_as_float(__builtin_amdgcn_readfirstlane(l == 0 ? 0x3f4ccccdu : 0x3f24fd5cu));
    for (int it = vcu; it < 768; it += G) {
        if (it < 256) attn_item(lds, A, l, true, it >> 5, (it >> 3) & 3, it & 7, lam, oml, tid, wave, lane);
        else if (it < 384) { const int j = it - 256; attn_item(lds, A, l, false, j >> 3, (j >> 1) & 3, j & 1, lam, oml, tid, wave, lane); }
        else { const int j = it - 384; bc_item(lds, A, l, j >> 2, j & 3, tid, wave, lane); }
    }
}

#define XB_TMO      128
#define XB_XCNT(j)  (256  + 64 * (j))
#define XB_XSUB(j)  (1280 + 64 * (j))
#define XB_XGEN(j)  (2304 + 64 * (j))
#define XB_TOP      3328
#define XB_TOPGEN   3392
#define XCD_BAR_WORDS 3456
#define XB_SPIN_CAP (1u << 18)

__device__ __forceinline__ unsigned xb_ld(unsigned* p)              { return __hip_atomic_load(p, __ATOMIC_RELAXED, __HIP_MEMORY_SCOPE_AGENT); }
__device__ __forceinline__ unsigned xb_add(unsigned* p, unsigned v) { return __hip_atomic_fetch_add(p, v, __ATOMIC_RELAXED, __HIP_MEMORY_SCOPE_AGENT); }
__device__ __forceinline__ unsigned xb_xcc_id() { return (unsigned)__builtin_amdgcn_s_getreg((3 << 11) | 20) & 0xFu; }
#define XB_SPIN(cond, bar) do { unsigned _sp = 0; while (cond) { __builtin_amdgcn_s_sleep(1); \
    if ((++_sp & 255u) == 0u) { if (xb_ld(&(bar)[XB_TMO])) break; if (_sp > XB_SPIN_CAP) { atomicAdd(&(bar)[XB_TMO], 1u); break; } } } } while (0)

struct XcdBarrier {
    unsigned* bar; unsigned x;
    volatile LAS unsigned* st;
};

__device__ __forceinline__ XcdBarrier xcd_barrier_post(unsigned* bar, volatile LAS unsigned* st, bool leader) {
    XcdBarrier b; b.bar = bar; b.x = xb_xcc_id(); b.st = st;
    if (leader) (void)xb_add(&bar[XB_XCNT(b.x)], 1u);
    return b;
}
__device__ __forceinline__ void xcd_barrier_complete(unsigned* bar, unsigned x, unsigned& nloc, unsigned& nx) {
    const unsigned G = gridDim.x * gridDim.y * gridDim.z;
    unsigned sum, cnt, mine, sp = 0u;
    for (;;) {
        sum = 0u; cnt = 0u; mine = 0u;
#pragma unroll
        for (unsigned j = 0; j < 16; ++j) { const unsigned c = xb_ld(&bar[XB_XCNT(j)]); sum += c; cnt += (c > 0u) ? 1u : 0u; mine = (j == x) ? c : mine; }
        if (sum == G) break;
        __builtin_amdgcn_s_sleep(1);
        if ((++sp & 255u) == 0u) { if (xb_ld(&bar[XB_TMO])) break; if (sp > XB_SPIN_CAP) { atomicAdd(&bar[XB_TMO], 1u); break; } }
    }
    nloc = mine > 0u ? mine : 1u; nx = cnt > 0u ? cnt : 1u;
}

__device__ __forceinline__ void xcd_barrier(const XcdBarrier& b, bool leader) {
    asm volatile("s_waitcnt vmcnt(0)" ::: "memory");
    __syncthreads();
    if (leader) {
        unsigned* bar = b.bar;
        __builtin_amdgcn_s_waitcnt(0);
        unsigned nloc = b.st[0], nx = b.st[1];
        if (nloc == 0u) { xcd_barrier_complete(bar, b.x, nloc, nx); b.st[0] = nloc; b.st[1] = nx; }
        const unsigned old = xb_add(&bar[XB_XSUB(b.x)], 1u);
        const unsigned gen = old / nloc;
        if (old + 1u == (gen + 1u) * nloc) {
            __builtin_amdgcn_fence(__ATOMIC_RELEASE, "agent");
            asm volatile("s_waitcnt vmcnt(0)" ::: "memory");
            const unsigned og = xb_add(&bar[XB_TOP], 1u);
            const unsigned tg = og / nx;
            if (og + 1u == (tg + 1u) * nx) xb_add(&bar[XB_TOPGEN], 1u);
            else XB_SPIN(xb_ld(&bar[XB_TOPGEN]) == tg, bar);
            __builtin_amdgcn_fence(__ATOMIC_ACQUIRE, "agent");
            xb_add(&bar[XB_XGEN(b.x)], 1u);
            asm volatile("s_waitcnt vmcnt(0)" ::: "memory");
        } else {
            XB_SPIN(xb_ld(&bar[XB_XGEN(b.x)]) == gen, bar);
            __builtin_amdgcn_fence(__ATOMIC_ACQUIRE, "agent");
            asm volatile("s_waitcnt vmcnt(0)" ::: "memory");
        }
    }
    __syncthreads();
}

#ifndef PHMASK
#define PHMASK 0xffff
#endif
#define PH(k) ((PHMASK >> (k)) & 1)
#ifndef PROBE
#define PROBE 0
#endif
#define GSYNC() do { XcdBarrier b_; b_.bar = (unsigned*)kargs()->ws; { unsigned x_ = bar_x; asm volatile("" : "+s"(x_)); b_.x = x_; } b_.st = (volatile LAS unsigned*)(lds + 131072); xcd_barrier(b_, TID() == 0); } while (0)
__global__ void __launch_bounds__(NTHREADS, 2) fwd_megakernel(Args A_byval) {
    extern __shared__ __attribute__((aligned(16))) unsigned char lds_raw[];
    LAS unsigned char* lds = (LAS unsigned char*)lds_raw;
    cg::grid_group grid = cg::this_grid();
    const int wid_s = __builtin_amdgcn_readfirstlane((int)threadIdx.x >> 6);
#define TID() (wid_s * 64 + lane_id_fresh())
    const int G = gridDim.x, bx = blockIdx.x;
    const int vcu = (G % 8 == 0) ? (bx % 8) * (G / 8) + bx / 8 : bx;
#define WAVE() wid_s
#define WSP(off) (kargs()->ws + (off))
#define INP(i) (kargs()->in[i])

    { const int t_ = TID(); if (t_ < 64) ((LAS unsigned*)(lds + 131072))[t_] = 0u; }
    __syncthreads();
    const unsigned bar_x = xcd_barrier_post((unsigned*)WSP(0), (volatile LAS unsigned*)(lds + 131072), TID() == 0).x;
    if (kargs()->ws == nullptr) grid.sync();

    if (PH(0)) p0_mod(lds, kargs(), TID());
    if (bx == G - 1) {
        float* RC = (float*)WSP(WS_ROPE);
        for (int idx = TID(); idx < 1024; idx += NTHREADS) {
            const int pos = idx >> 4, i = idx & 15;
            const float inv = exp2f(-(float)i * (13.287712379549449f / 16.f));
            float rev = (float)pos * inv * 0.15915494309189535f; rev -= floorf(rev);
            RC[idx] = __builtin_amdgcn_cosf(rev); RC[1024 + idx] = __builtin_amdgcn_sinf(rev);
        }
    }
    if (PH(1)) p0_weights(lds, kargs(), vcu * 8 + WAVE(), G * 8, WAVE(), (TID() & 63));
    GSYNC();
    bias_phase(lds, kargs(), bx, G, TID(), WAVE(), (TID() & 63));
    xa_phase(INP(0), INP(1) - (size_t)M_CTX * D, INP(8), (const float*)WSP(WS_MOD), 1, (bf16*)WSP(WS_H), (float*)WSP(WS_PSS), vcu * 8 + WAVE(), G * 8, (TID() & 63));
    GSYNC();

    for (int l = 0; l < 2; ++l) {
        for (int half = 0; half < 2; ++half) {
            if (PH(3)) {   pg8::Gemm g{(const bf16*)WSP(WS_H), (const bf16*)WSP(WS_W + (size_t)l * W_LAYER + (half ? W_GU2 : W_GU1)), M, NGU, D}; pg8::StaticOrder S; S.initmn(GU_MAIN_PANELS, NGU / 256, G, bx);
                EpiSwiglu E{WSP(0), l * 9 * NBIAS + (half ? BOFF_GU2 : BOFF_GU1)};
                pg8::gemm_phase<EpiSwiglu, pg8::StaticOrder, true, true>(lds, g, S, E, TID());
                pg8::Gemm g2{(const bf16*)WSP(WS_H) + (size_t)GU_MAIN_PANELS * 256 * D, g.Bt, M, NGU, D}; pg8::StaticOrder S2; S2.initmn((M - GU_MAIN_PANELS * 256) / (64 * GU_TMB), NGU / 256, G, (bx + 12) % G);
                EpiSwigluT<GU_TMB> E2{WSP(0), l * 9 * NBIAS + (half ? BOFF_GU2 : BOFF_GU1), GU_MAIN_PANELS * 256};
                pg8::gemm_phase<EpiSwigluT<GU_TMB>, pg8::StaticOrder, true, true, GU_TMB>(lds, g2, S2, E2, TID()); }
            GSYNC();
            if (PH(4)) {   const bool first = (l == 0 && half == 0);
                float* X = (float*)WSP(WS_X);
                const float* in_ctx = first ? INP(0) : X;
                const float* in_lat = first ? INP(1) - (size_t)M_CTX * D : X;
                const bool has_next = (half == 0) || (l == 0);
                const int ln = half == 0 ? l : l + 1;
                const float* gnext = has_next ? INP(8) + (size_t)(ln * 3 + (half == 0 ? 1 : 0)) * D : nullptr;
                const int sc_off = ln * 9 * NMOD + (half == 0 ? 4 : 1) * 1024;
                pg8::Gemm g{(const bf16*)WSP(WS_ACT), (const bf16*)WSP(WS_W + (size_t)l * W_LAYER + (half ? W_D2 : W_D1)), M, D, FF}; pg8::StaticOrder S; S.initmn(M / 192, D / 256, G, bx);
                EpiRes3 E{in_ctx, in_lat, WSP(0), gnext, l * 9 * NMOD + (half ? 8 : 2) * 1024, sc_off, 0.5f};
                pg8::gemm_phase<EpiRes3, pg8::StaticOrder, true, true, 3>(lds, g, S, E, TID()); }
            GSYNC();
            if (half == 0) {
                if (PH(5)) {   pg8::Gemm g{(const bf16*)WSP(WS_H), (const bf16*)WSP(WS_W + (size_t)l * W_LAYER + W_IN), M, NIN, D}; pg8::StaticOrder S; S.initmn(M / 192, NIN / 256, G, bx);
                    float* newk = kargs()->out + (size_t)M * D;
                    EpiWin3 E{WSP(0), newk, l};
                    pg8::gemm_phase<EpiWin3, pg8::StaticOrder, true, true, 3>(lds, g, S, E, TID()); }
                GSYNC();
                if (PH(6)) mixer_phase(lds, kargs(), l, vcu, G, TID(), WAVE(), (TID() & 63));
                if (PROBE == 3) mixer_phase(lds, kargs(), l, vcu, G, TID(), WAVE(), (TID() & 63));
                GSYNC();
                if (PH(7)) {   float* X = (float*)WSP(WS_X);
                    pg8::Gemm g{(const bf16*)WSP(WS_Y), (const bf16*)WSP(WS_W + (size_t)l * W_LAYER + W_OUT), M, D, D}; pg8::StaticOrder S; S.initmn(M / 192, D / 256, G, bx);
                    EpiRes3 E{X, X, WSP(0), INP(8) + (size_t)(l * 3 + 2) * D, l * 9 * NMOD + 5 * 1024, l * 9 * NMOD + 7 * 1024, 1.0f};
                    pg8::gemm_phase<EpiRes3, pg8::StaticOrder, true, true, 3>(lds, g, S, E, TID()); }
                GSYNC();
            }
        }
    }
    final_norm((const float*)WSP(WS_X), INP(20), kargs()->out, vcu * 8 + WAVE(), G * 8, (TID() & 63));
}

extern "C" void kernel_launch(void* const* d_in, const int* in_sizes, int n_in, void* d_out, int out_size, void* d_ws, size_t ws_size, hipStream_t stream) {
    static int grid = 0;
    if (grid == 0) {
        if (n_in != 21 || ws_size < WS_END2) { fprintf(stderr, "kernel_launch: need 21 inputs and >= %zu bytes of workspace; got %d, %zu\n", (size_t)WS_END2, n_in, ws_size); grid = -1; return; }
        int dev = 0, cus = 0, per_cu = 0;
        hipGetDevice(&dev);
        hipDeviceGetAttribute(&cus, hipDeviceAttributeMultiprocessorCount, dev);
        if (hipFuncSetAttribute((const void*)fwd_megakernel, hipFuncAttributeMaxDynamicSharedMemorySize, LDS_BYTES) != hipSuccess) { fprintf(stderr, "kernel_launch: hipFuncSetAttribute failed\n"); grid = -1; return; }
        if (hipOccupancyMaxActiveBlocksPerMultiprocessor(&per_cu, (const void*)fwd_megakernel, NTHREADS, LDS_BYTES) != hipSuccess || per_cu < 1) { fprintf(stderr, "kernel_launch: occupancy query gave %d\n", per_cu); per_cu = 1; }
        (void)hipGetLastError();
        grid = cus * per_cu;
    }
    if (grid < 0) return;
    if (hipMemsetAsync(d_ws, 0, 65536, stream) != hipSuccess) { fprintf(stderr, "kernel_launch: memset of barrier words failed\n"); return; }
    Args a{};
    for (int i = 0; i < 21; ++i) a.in[i] = (const float*)d_in[i];
    a.out = (float*)d_out; a.ws = (unsigned char*)d_ws;
    void* args[] = {&a};
    hipError_t e = hipLaunchCooperativeKernel((const void*)fwd_megakernel, dim3(grid), dim3(NTHREADS), args, LDS_BYTES, stream);
    if (e != hipSuccess) fprintf(stderr, "cooperative launch failed: %s (grid %d)\n", hipGetErrorString(e), grid);
}
```
